# Optimizing an MI355X kernel written in HIP

```python
import jax, jax.numpy as jnp
from jax import lax
import numpy as np

D_MODEL = 1024
BATCH = 16
SEQ = 2048
DEPTH = 2

HEAD_DIM = 64
N_FOX_HEADS = 8
N_SB_HEADS = 8
FOX_WIDTH = N_FOX_HEADS * HEAD_DIM
SB_WIDTH = N_SB_HEADS * HEAD_DIM
LRU_WIDTH = D_MODEL
LRU_BLOCKS = 16
LRU_BLOCK_DIM = LRU_WIDTH // LRU_BLOCKS
CONV_WIDTH = 4
LRU_C = 8.0
N_BRANCHES = 3
N_EXPERTS = 32
TOP_K = 4
D_EXPERT = D_MODEL
SWIGLU_LIMIT = 7.0
SWIGLU_ALPHA = 1.702
Q_BLOCK = 128
EXPERT_BLOCK = 256
LN_EPS = 1e-5
DEEPNORM_ALPHA = (2.0 * DEPTH) ** 0.25
DEEPNORM_BETA = (8.0 * DEPTH) ** -0.25
IN_SIZES = (FOX_WIDTH, FOX_WIDTH, FOX_WIDTH, N_FOX_HEADS, SB_WIDTH, SB_WIDTH, SB_WIDTH, LRU_WIDTH, LRU_WIDTH)
IN_SPLITS = tuple(sum(IN_SIZES[:i + 1]) for i in range(len(IN_SIZES) - 1))
D_IN = sum(IN_SIZES)

kernel_name = 'hybrid_fox_stickbreak_rglru_moe_deepnorm'


def layer_norm(x, g, b):
    xf = x.astype(jnp.float32)
    mu = jnp.mean(xf, axis=-1, keepdims=True)
    var = jnp.mean(jnp.square(xf - mu), axis=-1, keepdims=True)
    y = (xf - mu) * lax.rsqrt(var + LN_EPS)
    return (y * g + b).astype(x.dtype)


def _to_blocks(t):
    b, s = t.shape[0], t.shape[1]
    return jnp.moveaxis(t.reshape((b, s // Q_BLOCK, Q_BLOCK) + t.shape[2:]), 1, 0)


def _from_blocks(o):
    o = jnp.moveaxis(o, 0, 1)
    b, nb, qb, h, d = o.shape
    return o.reshape(b, nb * qb, h * d)


def fox_attention(q, k, v, logf):
    s_len, dh = q.shape[1], q.shape[3]
    nb = s_len // Q_BLOCK
    F = jnp.cumsum(logf.astype(jnp.float32), axis=1)
    Fk = jnp.transpose(F, (0, 2, 1))
    key_pos = jnp.arange(s_len)
    scale = dh ** -0.5

    def block(args):
        qb, Fq, i = args
        q_pos = i * Q_BLOCK + jnp.arange(Q_BLOCK)
        s = jnp.einsum('bqhd,bkhd->bhqk', qb, k, preferred_element_type=jnp.float32) * scale
        s = s + jnp.transpose(Fq, (0, 2, 1))[..., None] - Fk[:, :, None, :]
        s = jnp.where(key_pos[None, :] <= q_pos[:, None], s, -jnp.inf)
        p = jax.nn.softmax(s, axis=-1)
        return jnp.einsum('bhqk,bkhd->bqhd', p.astype(v.dtype), v)

    out = lax.map(block, (_to_blocks(q), _to_blocks(F), jnp.arange(nb)))
    return _from_blocks(out)


def stick_breaking_attention(q, k, v):
    s_len, dh = q.shape[1], q.shape[3]
    nb = s_len // Q_BLOCK
    key_pos = jnp.arange(s_len)
    scale = dh ** -0.5

    def block(args):
        qb, i = args
        q_pos = i * Q_BLOCK + jnp.arange(Q_BLOCK)
        z = jnp.einsum('bqhd,bkhd->bhqk', qb, k, preferred_element_type=jnp.float32) * scale
        strict = key_pos[None, :] < q_pos[:, None]
        log_keep = jnp.where(strict, jax.nn.log_sigmoid(-z), 0.0)
        cs = jnp.cumsum(log_keep, axis=-1)
        after = jnp.minimum(cs[..., -1:] - cs, 0.0)
        w = jnp.where(strict, jnp.exp(jax.nn.log_sigmoid(z) + after), 0.0)
        return jnp.einsum('bhqk,bkhd->bqhd', w.astype(v.dtype), v)

    out = lax.map(block, (_to_blocks(q), jnp.arange(nb)))
    return _from_blocks(out)


def rg_lru_branch(xc, gc, conv_w, conv_b, wa, ba, wx, bx, lam):
    b, s, w = xc.shape
    xconv = lax.conv_general_dilated(
        xc, conv_w[:, None, :], window_strides=(1,), padding=[(CONV_WIDTH - 1, 0)],
        dimension_numbers=('NWC', 'WIO', 'NWC'), feature_group_count=w) + conv_b
    xf = xconv.astype(jnp.float32)
    xb = xf.reshape(b, s, LRU_BLOCKS, LRU_BLOCK_DIM)
    r = jax.nn.sigmoid(jnp.einsum('bsnc,ncd->bsnd', xb, wa.astype(jnp.float32)).reshape(b, s, w) + ba.astype(jnp.float32))
    i_gate = jax.nn.sigmoid(jnp.einsum('bsnc,ncd->bsnd', xb, wx.astype(jnp.float32)).reshape(b, s, w) + bx.astype(jnp.float32))
    log_a = -LRU_C * jax.nn.softplus(-lam.astype(jnp.float32)) * r
    a = jnp.exp(log_a)
    u = jnp.sqrt(-jnp.expm1(2.0 * log_a)) * (i_gate * xf)

    def combine(left, right):
        a_l, b_l = left
        a_r, b_r = right
        return a_l * a_r, a_r * b_l + b_r

    _, h = lax.associative_scan(combine, (a, u), axis=1)
    return (h * jax.nn.gelu(gc.astype(jnp.float32))).astype(xc.dtype)


def token_mixer(h, w_in, b_f, conv_w, conv_b, lru_wa, lru_ba, lru_wx, lru_bx, lru_lambda,
                w_gate, b_gate, w_pa, w_pb, w_pc, w_o):
    b, s, d = h.shape
    z = h @ w_in
    qa, ka, va, fa, qb, kb, vb, xc, gc = jnp.split(z, IN_SPLITS, axis=-1)
    fox_h = lambda t: t.reshape(b, s, N_FOX_HEADS, HEAD_DIM)
    sb_h = lambda t: t.reshape(b, s, N_SB_HEADS, HEAD_DIM)
    logf = jax.nn.log_sigmoid(fa.astype(jnp.float32) + b_f.astype(jnp.float32))
    o_a = fox_attention(fox_h(qa), fox_h(ka), fox_h(va), logf)
    o_b = stick_breaking_attention(sb_h(qb), sb_h(kb), sb_h(vb))
    o_c = rg_lru_branch(xc, gc, conv_w, conv_b, lru_wa, lru_ba, lru_wx, lru_bx, lru_lambda)
    g = jax.nn.sigmoid((h @ w_gate + b_gate).astype(jnp.float32)).astype(h.dtype)
    g = g.reshape(b, s, N_BRANCHES, d)
    merged = g[:, :, 0] * (o_a @ w_pa) + g[:, :, 1] * (o_b @ w_pb) + g[:, :, 2] * (o_c @ w_pc)
    return merged @ w_o


def moe_ffn(h, w_router, b_router, w_gu, b_gu, w_down, b_down):
    b, s, d = h.shape
    t = b * s
    hf = h.reshape(t, d)
    logits = (hf @ w_router).astype(jnp.float32) + b_router.astype(jnp.float32)
    top_v, top_i = lax.top_k(logits, TOP_K)
    gates = jax.nn.softmax(top_v, axis=-1)
    n = t * TOP_K
    flat_e = top_i.reshape(n)
    order = jnp.argsort(flat_e)
    e_sorted = flat_e[order]
    tok_sorted = order // TOP_K
    gate_sorted = gates.reshape(n)[order]
    counts = jnp.bincount(flat_e, length=N_EXPERTS)
    padded = (counts + EXPERT_BLOCK - 1) // EXPERT_BLOCK * EXPERT_BLOCK
    pad_end = jnp.cumsum(padded)
    pad_start = pad_end - padded
    start = jnp.cumsum(counts) - counts
    dest = pad_start[e_sorted] + jnp.arange(n) - start[e_sorted]
    n_blocks = -(-n // EXPERT_BLOCK) + N_EXPERTS
    x_buf = jnp.zeros((n_blocks * EXPERT_BLOCK, d), hf.dtype).at[dest].set(hf[tok_sorted])
    block_e = jnp.minimum(jnp.searchsorted(pad_end, jnp.arange(n_blocks) * EXPERT_BLOCK, side='right'),
                          N_EXPERTS - 1)

    def expert_block(args):
        xb, e = args
        gu = xb @ w_gu[e] + b_gu[e]
        gate, up = jnp.split(gu, 2, axis=-1)
        gate = jnp.minimum(gate, SWIGLU_LIMIT)
        up = jnp.clip(up, -SWIGLU_LIMIT, SWIGLU_LIMIT)
        act = (up + 1.0) * (gate * jax.nn.sigmoid(SWIGLU_ALPHA * gate))
        return act @ w_down[e] + b_down[e]

    y_buf = lax.map(expert_block, (x_buf.reshape(n_blocks, EXPERT_BLOCK, d), block_e)).reshape(-1, d)
    y_tok = y_buf[dest] * gate_sorted[:, None].astype(y_buf.dtype)
    y = jnp.zeros((t, d), h.dtype).at[tok_sorted].add(y_tok.astype(h.dtype))
    return y.reshape(b, s, d)


def setup_inputs(seed: int = 0) -> dict:
    key = jax.random.key(seed)
    ks = jax.random.split(key, 32)
    f32 = jnp.float32
    nrm = lambda k, shape, sc: jax.random.normal(k, shape, f32) * sc
    L, D = DEPTH, D_MODEL
    a0 = jax.random.uniform(ks[14], (L, LRU_WIDTH), f32, minval=0.9, maxval=0.999)
    p0 = a0 ** (1.0 / LRU_C)
    lru_lambda = jnp.log(p0) - jnp.log1p(-p0)
    return {
        'x': nrm(ks[0], (BATCH, SEQ, D), 1.0),
        'c': nrm(ks[1], (BATCH, D), 1.0),
        'w_ada': nrm(ks[2], (L, D, 6 * D), 0.2 * D ** -0.5),
        'b_ada': nrm(ks[3], (L, 6 * D), 0.01),
        'ln1_g': 1.0 + nrm(ks[4], (L, D), 0.02),
        'ln1_b': nrm(ks[5], (L, D), 0.02),
        'w_in': nrm(ks[6], (L, D, D_IN), D ** -0.5),
        'b_f': jax.random.uniform(ks[7], (L, N_FOX_HEADS), f32, minval=1.0, maxval=4.0),
        'conv_w': nrm(ks[8], (L, CONV_WIDTH, LRU_WIDTH), CONV_WIDTH ** -0.5),
        'conv_b': nrm(ks[9], (L, LRU_WIDTH), 0.01),
        'lru_wa': nrm(ks[10], (L, LRU_BLOCKS, LRU_BLOCK_DIM, LRU_BLOCK_DIM), LRU_BLOCK_DIM ** -0.5),
        'lru_ba': nrm(ks[11], (L, LRU_WIDTH), 0.01),
        'lru_wx': nrm(ks[12], (L, LRU_BLOCKS, LRU_BLOCK_DIM, LRU_BLOCK_DIM), LRU_BLOCK_DIM ** -0.5),
        'lru_bx': nrm(ks[13], (L, LRU_WIDTH), 0.01),
        'lru_lambda': lru_lambda,
        'w_gate': nrm(ks[15], (L, D, N_BRANCHES * D), D ** -0.5),
        'b_gate': nrm(ks[16], (L, N_BRANCHES * D), 0.01),
        'w_pa': nrm(ks[17], (L, FOX_WIDTH, D), FOX_WIDTH ** -0.5),
        'w_pb': nrm(ks[18], (L, SB_WIDTH, D), SB_WIDTH ** -0.5),
        'w_pc': nrm(ks[19], (L, LRU_WIDTH, D), LRU_WIDTH ** -0.5),
        'w_o': nrm(ks[20], (L, D, D), DEEPNORM_BETA * D ** -0.5),
        'ln2_g': 1.0 + nrm(ks[21], (L, D), 0.02),
        'ln2_b': nrm(ks[22], (L, D), 0.02),
        'w_router': nrm(ks[23], (L, D, N_EXPERTS), D ** -0.5),
        'b_router': nrm(ks[24], (L, N_EXPERTS), 0.01),
        'w_gu': nrm(ks[25], (L, N_EXPERTS, D, 2 * D_EXPERT), D ** -0.5),
        'b_gu': nrm(ks[26], (L, N_EXPERTS, 2 * D_EXPERT), 0.01),
        'w_down': nrm(ks[27], (L, N_EXPERTS, D_EXPERT, D), DEEPNORM_BETA * D_EXPERT ** -0.5),
        'b_down': nrm(ks[28], (L, N_EXPERTS, D), 0.01),
    }


def reference(x, c, w_ada, b_ada, ln1_g, ln1_b, w_in, b_f, conv_w, conv_b, lru_wa, lru_ba, lru_wx,
              lru_bx, lru_lambda, w_gate, b_gate, w_pa, w_pb, w_pc, w_o, ln2_g, ln2_b, w_router,
              b_router, w_gu, b_gu, w_down, b_down):
    cond = jax.nn.silu(c)
    for l in range(DEPTH):
        ada = (cond @ w_ada[l] + b_ada[l])[:, None, :]
        shift1, scale1, gate1, shift2, scale2, gate2 = jnp.split(ada, 6, axis=-1)
        h = x * (1.0 + scale1) + shift1
        y = token_mixer(h, w_in[l], b_f[l], conv_w[l], conv_b[l], lru_wa[l], lru_ba[l], lru_wx[l],
                        lru_bx[l], lru_lambda[l], w_gate[l], b_gate[l], w_pa[l], w_pb[l], w_pc[l], w_o[l])
        x = layer_norm(DEEPNORM_ALPHA * x + (1.0 + gate1) * y, ln1_g[l], ln1_b[l])
        h = x * (1.0 + scale2) + shift2
        y = moe_ffn(h, w_router[l], b_router[l], w_gu[l], b_gu[l], w_down[l], b_down[l])
        x = layer_norm(DEEPNORM_ALPHA * x + (1.0 + gate2) * y, ln2_g[l], ln2_b[l])
    return x
```

```cpp
#include <hip/hip_runtime.h>
#include <cstdio>
#include <cstdint>

#ifndef CHK
#define CHK 0
#endif
#ifndef CHK_STOP
#define CHK_STOP 99
#endif

#define LAS __attribute__((address_space(3)))
#define GAS __attribute__((address_space(1)))
typedef unsigned short bf16_t;
typedef short bf16x8 __attribute__((ext_vector_type(8)));
typedef short s16x4 __attribute__((ext_vector_type(4)));
typedef float f32x4 __attribute__((ext_vector_type(4)));
typedef float f32x2 __attribute__((ext_vector_type(2)));
typedef float f32x16 __attribute__((ext_vector_type(16)));
typedef unsigned u32x4 __attribute__((ext_vector_type(4)));
typedef unsigned u32x2 __attribute__((ext_vector_type(2)));
typedef GAS unsigned gu32;

constexpr int D = 1024, BATCH = 16, SEQ = 2048, M = BATCH * SEQ, DEPTH = 2;
constexpr int NEXP = 32, TOPK = 4, DIN = 5128;
constexpr int ZP = 8192;
constexpr int ZC_QA = 0, ZC_KA = 512, ZC_VA = 1024, ZC_QB = 1536, ZC_KB = 2048, ZC_VB = 2560, ZC_XC = 3072, ZC_GC = 4096, ZC_G = 5120;
constexpr int OP = 2048;
constexpr float LN_EPS = 1e-5f;
constexpr float DN_ALPHA = 1.41421356237f;
constexpr float LOG2E = 1.4426950408889634f;
constexpr float C2 = 0.125f * 1.4426950408889634f;
constexpr int MAXBLK = M * TOPK / 256 + NEXP;
constexpr int ECAP = 32768;

constexpr size_t MiB = 1u << 20;
constexpr size_t WS_CTL = 0, CTL_ZERO_BYTES = 1 * MiB;
constexpr size_t WS_ADA = 1 * MiB;
constexpr size_t WS_LOGF = 2 * MiB;
constexpr size_t WS_F2 = 3 * MiB;
constexpr size_t WS_TOKER = 4 * MiB;
constexpr size_t WS_GATE = 4 * MiB + 512 * 1024;
constexpr size_t WS_SLOTTOK = 5 * MiB;
constexpr size_t WS_W = 16 * MiB;
constexpr size_t WL_IN = 0, WL_P = 16 * MiB, WL_O = 20 * MiB, WL_GU = 22 * MiB, WL_DN = 150 * MiB, WL_SIZE = 214 * MiB;
constexpr size_t WS_H = 448 * MiB;
constexpr size_t WS_Z = 512 * MiB;
constexpr size_t WS_ACT = 512 * MiB;
constexpr size_t WS_O = 1024 * MiB;
constexpr size_t WS_MB = 1152 * MiB;
constexpr size_t WS_MG = 1280 * MiB;
constexpr size_t WS_Y = 1344 * MiB;
constexpr size_t WS_X1 = 1472 * MiB;
constexpr size_t WS_XL = 1600 * MiB;
constexpr size_t WS_YB = 1728 * MiB;
constexpr size_t WS_END = 2000 * MiB;
static_assert((size_t)MAXBLK * 256 * 1024 * 2 <= 272 * MiB, "act / y_buf size");

constexpr int CW_TMO = 0, CW_CODE = 1;
constexpr int CW_BAR = 4096;
constexpr int CW_GCNT = 8192;
constexpr int CW_CHK = 16384;

constexpr int RING_BYTES = 131072;
constexpr int MISC_OFF = RING_BYTES;
constexpr int LDS_BYTES = 147456;
constexpr int MO_BAR = 0;
constexpr int MO_CNT = 64;
constexpr int MO_BS = 64 + 128;
constexpr int MO_BE = 64 + 128 + 136;
constexpr int MO_LCNT = 1024;
constexpr int MO_LBASE = 1024 + 128;
constexpr int MO_REC = 2048;
constexpr int MO_GT = 4096;
constexpr int MO_LG = 6144;
constexpr int MO_CAR = 2048;

namespace pg8 {
constexpr int BM = 256, BK = 64, HALF = 128, HTB = HALF * BK * 2, STAGE_BYTES = 8 * HTB, NXCD = 8, WGM = 8;
__host__ __device__ __forceinline__ int lds_byte(int r, int c) { const int st = (r >> 4) * 2 + (c >> 5), rr = r & 15, cc = c & 31, ob = rr * 64 + cc * 2; return st * 1024 + (ob ^ (((ob >> 9) & 1) << 5)); }
__host__ __device__ __forceinline__ void stage_rc(int b, int& R, int& C) { const int st = b / 1024, sb = b % 1024, swz = sb ^ (((sb >> 9) & 1) << 5); R = (st >> 1) * 16 + swz / 64; C = (st & 1) * 32 + (swz % 64) / 2; }
__host__ __device__ __forceinline__ int perm32(int rho) { const int n = rho >> 4, i = rho & 15; return 8 * (i >> 2) + 4 * n + (i & 3); }

struct Unit { int pm, pn, aux; };

struct TileOrder {
    int nM, nN, nwg, G, c;
    __device__ __forceinline__ void init(int nM_, int nN_, int G_, int c_) { nM = nM_; nN = nN_; nwg = nM * nN; G = G_; c = c_; }
    __device__ __forceinline__ bool tile(int i, int& pm, int& pn) const {
        const long L = (long)i * G + c; if (L >= nwg) return false;
        int wgid = (int)L; { const int q = nwg / NXCD, r = nwg % NXCD, xcd = wgid % NXCD, off = wgid / NXCD; wgid = (xcd < r ? xcd * (q + 1) : r * (q + 1) + (xcd - r) * q) + off; }
        const int nig = WGM * nN, gid = wgid / nig, fm = gid * WGM, gsz = (nM - fm) < WGM ? (nM - fm) : WGM;
        pm = fm + ((wgid % nig) % gsz); pn = (wgid % nig) / gsz; return true;
    }
};

__device__ __forceinline__ unsigned cvt_pk_bf16(float lo, float hi) { unsigned r; asm volatile("v_cvt_pk_bf16_f32 %0, %1, %2" : "=v"(r) : "v"(lo), "v"(hi)); return r; }

template <class Epi, class Sched, bool GATHER>
__device__ __forceinline__ void gemm_phase(LAS unsigned char* lds, const int lda, const int ldb, const Sched& S, const Epi& E) {
    int tid_ = threadIdx.x; asm volatile("" : "+v"(tid_));
    const int tid = tid_, wid = __builtin_amdgcn_readfirstlane(tid >> 6), lane = tid & 63, wr = wid >> 2, wc = wid & 3, fr = lane & 15, fq = lane >> 4;
    unsigned voffA[2], voffB[2]; int RR[2], CC[2];
#pragma unroll
    for (int i = 0; i < 2; ++i) { int R, C; stage_rc(tid * 16 + i * 8192, R, C); const int Rb = Epi::PERM ? ((R & ~31) + perm32(R & 31)) : R;
        RR[i] = R; CC[i] = C; voffA[i] = (unsigned)(R * lda + C) * 2u; voffB[i] = (unsigned)(Rb * ldb + C) * 2u; }
    const size_t kstep = (size_t)(BK * 2);
    const size_t hstepA = (size_t)HALF * lda * 2, hstepB = (size_t)HALF * ldb * 2;
    const unsigned ldsw = (unsigned)wid * 1024u;
    const int aoff = lds_byte(wr * 64 + fr, fq * 8), boff = lds_byte(wc * 32 + fr, fq * 8);
#define PG8_SA(b, h) (((b) * 2 + (h)) * HTB)
#define PG8_SB(b, h) ((4 + (b) * 2 + (h)) * HTB)
#define PG8_STG(bufoff, ptr, vo, _i) __builtin_amdgcn_global_load_lds((const unsigned*)((const char*)(ptr) + (vo)), (LAS unsigned*)(lds + (bufoff) + ldsw + (_i) * 8192), 16, 0, 0)
#define PG8_STAGE_B(bufoff, gbase) do { PG8_STG(bufoff, gbase, voffB[0], 0); PG8_STG(bufoff, gbase, voffB[1], 1); } while (0)
#define PG8_STAGE_A(bufoff, gbase, h, VG) do { if constexpr (GATHER) { PG8_STG(bufoff, gbase, VG[h][0], 0); PG8_STG(bufoff, gbase, VG[h][1], 1); } \
        else { PG8_STG(bufoff, (gbase) + (h) * hstepA, voffA[0], 0); PG8_STG(bufoff, (gbase) + (h) * hstepA, voffA[1], 1); } } while (0)
#define PG8_LDA(dst, b, h) do { _Pragma("unroll") for (int m = 0; m < 4; ++m) _Pragma("unroll") for (int k = 0; k < 2; ++k) dst[m][k] = *(const LAS bf16x8*)(lds + PG8_SA(b, h) + aoff + m * 2048 + k * 1024); } while (0)
#define PG8_LDB(dst, b, h) do { _Pragma("unroll") for (int n = 0; n < 2; ++n) _Pragma("unroll") for (int k = 0; k < 2; ++k) dst[n][k] = *(const LAS bf16x8*)(lds + PG8_SB(b, h) + boff + n * 2048 + k * 1024); } while (0)
#define PG8_MMA(ai, bj, At, Bt) do { __builtin_amdgcn_s_setprio(1); _Pragma("unroll") for (int m = 0; m < 4; ++m) _Pragma("unroll") for (int n = 0; n < 2; ++n) _Pragma("unroll") for (int k = 0; k < 2; ++k) \
        acc[ai][bj][m][n] = __builtin_amdgcn_mfma_f32_16x16x32_bf16(Bt[n][k], At[m][k], acc[ai][bj][m][n], 0, 0, 0); __builtin_amdgcn_s_setprio(0); } while (0)
#define PG8_WAIT_V(n) asm volatile("s_waitcnt vmcnt(" #n ")" ::: "memory")
#define PG8_WAIT_L(n) asm volatile("s_waitcnt lgkmcnt(" #n ")" ::: "memory")
#define PG8_BAR __builtin_amdgcn_s_barrier()
#define PG8_SCHED __builtin_amdgcn_sched_barrier(0)
    Unit cur, nxt; int ui = 0;
    if (!S.next(0, cur)) return;
    f32x4 acc[2][2][4][2];
#pragma unroll
    for (int a = 0; a < 2; ++a)
#pragma unroll
        for (int b = 0; b < 2; ++b)
#pragma unroll
            for (int m = 0; m < 4; ++m)
#pragma unroll
                for (int n = 0; n < 2; ++n) acc[a][b][m][n] = (f32x4){0.f, 0.f, 0.f, 0.f};
    bf16x8 At[4][2], B0[2][2], B1[2][2];
    const char* cA; const char* cB; int nt;
    S.operands(cur, cA, cB, nt);
    unsigned vgc[2][2] = {{0u, 0u}, {0u, 0u}}, vgn[2][2] = {{0u, 0u}, {0u, 0u}};
    if constexpr (GATHER) S.gather(cur, RR, CC, vgc);
    PG8_STAGE_B(PG8_SB(0, 0), cB); PG8_STAGE_B(PG8_SB(0, 1), cB + hstepB); PG8_STAGE_A(PG8_SA(0, 0), cA, 0, vgc); PG8_STAGE_A(PG8_SA(0, 1), cA, 1, vgc);
    if (wr == 1) PG8_BAR;
    PG8_WAIT_V(2); PG8_BAR;
    PG8_STAGE_B(PG8_SB(1, 0), cB + kstep); PG8_STAGE_A(PG8_SA(1, 0), cA + kstep, 0, vgc); PG8_STAGE_B(PG8_SB(1, 1), cB + hstepB + kstep);
    PG8_WAIT_V(6); PG8_BAR;
    for (;;) {
        const bool has_next = S.next(ui + 1, nxt);
        const char* nA = cA; const char* nB = cB; int nnt = nt;
        if (has_next) { S.operands(nxt, nA, nB, nnt); if constexpr (GATHER) S.gather(nxt, RR, CC, vgn); }
        else { if constexpr (GATHER) { vgn[0][0] = vgc[0][0]; vgn[0][1] = vgc[0][1]; vgn[1][0] = vgc[1][0]; vgn[1][1] = vgc[1][1]; } }
        for (int t = 0; t < nt; t += 2) {
            const bool last = (t == nt - 2);
            const char* a1 = cA + (size_t)(t + 1) * kstep;
            const char* a2 = last ? nA : cA + (size_t)(t + 2) * kstep; const char* b2 = last ? nB : cB + (size_t)(t + 2) * kstep;
            const char* a3 = a2 + kstep; const char* b3 = b2 + kstep;
            unsigned v2[2][2];
            if constexpr (GATHER) { v2[0][0] = last ? vgn[0][0] : vgc[0][0]; v2[0][1] = last ? vgn[0][1] : vgc[0][1]; v2[1][0] = last ? vgn[1][0] : vgc[1][0]; v2[1][1] = last ? vgn[1][1] : vgc[1][1]; }
            else { v2[0][0] = v2[0][1] = v2[1][0] = v2[1][1] = 0u; }
            PG8_LDB(B0, 0, 0); PG8_LDB(B1, 0, 1); PG8_SCHED; PG8_LDA(At, 0, 0); PG8_STAGE_A(PG8_SA(1, 1), a1, 1, vgc);
            PG8_WAIT_V(8); PG8_WAIT_L(0); PG8_BAR; PG8_MMA(0, 0, At, B0); PG8_MMA(0, 1, At, B1); PG8_BAR; PG8_SCHED;
            PG8_LDA(At, 0, 1); PG8_STAGE_B(PG8_SB(0, 0), b2); PG8_STAGE_B(PG8_SB(0, 1), b2 + hstepB); PG8_STAGE_A(PG8_SA(0, 0), a2, 0, v2);
            PG8_WAIT_V(8); PG8_WAIT_L(0); PG8_BAR; PG8_MMA(1, 0, At, B0); PG8_MMA(1, 1, At, B1); PG8_BAR; PG8_SCHED;
            PG8_LDB(B0, 1, 0); PG8_LDB(B1, 1, 1); PG8_SCHED; PG8_LDA(At, 1, 0); PG8_STAGE_A(PG8_SA(0, 1), a2, 1, v2);
            PG8_WAIT_V(8); PG8_WAIT_L(0); PG8_BAR; PG8_MMA(0, 0, At, B0); PG8_MMA(0, 1, At, B1); PG8_BAR; PG8_SCHED;
            PG8_LDA(At, 1, 1); PG8_STAGE_B(PG8_SB(1, 0), b3); PG8_STAGE_B(PG8_SB(1, 1), b3 + hstepB); PG8_STAGE_A(PG8_SA(1, 0), a3, 0, v2);
            PG8_WAIT_V(8); PG8_WAIT_L(0); PG8_BAR; PG8_MMA(1, 0, At, B0); PG8_MMA(1, 1, At, B1); PG8_BAR; PG8_SCHED;
        }
        if (wr == 0) PG8_BAR;
        E(acc, cur, wr, wc, fr, fq);
        if (!has_next) break;
#pragma unroll
        for (int a = 0; a < 2; ++a)
#pragma unroll
            for (int b = 0; b < 2; ++b)
#pragma unroll
                for (int m = 0; m < 4; ++m)
#pragma unroll
                    for (int n = 0; n < 2; ++n) acc[a][b][m][n] = (f32x4){0.f, 0.f, 0.f, 0.f};
        cur = nxt; cA = nA; cB = nB; nt = nnt; ++ui;
        if constexpr (GATHER) { vgc[0][0] = vgn[0][0]; vgc[0][1] = vgn[0][1]; vgc[1][0] = vgn[1][0]; vgc[1][1] = vgn[1][1]; }
        if (wr == 1) PG8_BAR;
    }
    PG8_WAIT_V(0);
    PG8_BAR;
#undef PG8_SA
#undef PG8_SB
#undef PG8_STG
#undef PG8_STAGE_A
#undef PG8_STAGE_B
#undef PG8_LDA
#undef PG8_LDB
#undef PG8_MMA
#undef PG8_WAIT_V
#undef PG8_WAIT_L
#undef PG8_BAR
#undef PG8_SCHED
}
}

#define RLX_AGENT __ATOMIC_RELAXED, __HIP_MEMORY_SCOPE_AGENT
#define LDS_WAIT() asm volatile("s_waitcnt lgkmcnt(0)" ::: "memory")
#define VM_WAIT() asm volatile("s_waitcnt vmcnt(0)" ::: "memory")
__device__ __forceinline__ float bf2f(unsigned b) { return __uint_as_float(b << 16); }
__device__ __forceinline__ unsigned f2bf(float f) { unsigned u = __float_as_uint(f); return (u + 0x7fffu + ((u >> 16) & 1u)) >> 16; }
__device__ __forceinline__ unsigned pk2(float lo, float hi) { return pg8::cvt_pk_bf16(lo, hi); }
__device__ __forceinline__ float fexp2(float x) { return __builtin_amdgcn_exp2f(x); }
__device__ __forceinline__ float flog2(float x) { return __builtin_amdgcn_logf(x); }
__device__ __forceinline__ float frcp(float x) { return __builtin_amdgcn_rcpf(x); }
__device__ __forceinline__ float fsigmoid(float x) { return frcp(1.0f + fexp2(-LOG2E * x)); }
__device__ __forceinline__ float wave_sum(float v) {
#pragma unroll
    for (int o = 1; o < 64; o <<= 1) v += __shfl_xor(v, o);
    return v;
}

#define XB_TMO      128
#define XB_XCNT(j)  (256  + 64 * (j))
#define XB_XSUB(j)  (1280 + 64 * (j))
#define XB_XGEN(j)  (2304 + 64 * (j))
#define XB_TOP      3328
#define XB_TOPGEN   3392
#define XCD_BAR_WORDS 3456
#if CHK
#define XB_SPIN_CAP (1u << 21)
#else
#define XB_SPIN_CAP (1u << 18)
#endif
__device__ __forceinline__ unsigned xb_ld(unsigned* p)              { return __hip_atomic_load(p, __ATOMIC_RELAXED, __HIP_MEMORY_SCOPE_AGENT); }
__device__ __forceinline__ unsigned xb_add(unsigned* p, unsigned v) { return __hip_atomic_fetch_add(p, v, __ATOMIC_RELAXED, __HIP_MEMORY_SCOPE_AGENT); }
__device__ __forceinline__ unsigned xb_xcc_id() { return (unsigned)__builtin_amdgcn_s_getreg((3 << 11) | 20) & 0xFu; }
#define XB_SPIN(cond, bar) do { unsigned _sp = 0; while (cond) { __builtin_amdgcn_s_sleep(1); \
    if ((++_sp & 255u) == 0u) { if (xb_ld(&(bar)[XB_TMO])) break; if (_sp > XB_SPIN_CAP) { atomicAdd(&(bar)[XB_TMO], 1u); break; } } } } while (0)
struct XcdBarrier { unsigned* bar; unsigned x; volatile LAS unsigned* st; };
__device__ __forceinline__ XcdBarrier xcd_barrier_post(unsigned* bar, volatile LAS unsigned* st) {
    XcdBarrier b; b.bar = bar; b.x = xb_xcc_id(); b.st = st;
    if (threadIdx.x == 0) (void)xb_add(&bar[XB_XCNT(b.x)], 1u);
    return b;
}
__device__ __forceinline__ void xcd_barrier_complete(unsigned* bar, unsigned x, unsigned& nloc, unsigned& nx) {
    const unsigned G = gridDim.x * gridDim.y * gridDim.z;
    unsigned sum, cnt, mine, sp = 0u;
    for (;;) {
        sum = 0u; cnt = 0u; mine = 0u;
#pragma unroll
        for (unsigned j = 0; j < 16; ++j) { const unsigned c = xb_ld(&bar[XB_XCNT(j)]); sum += c; cnt += (c > 0u) ? 1u : 0u; mine = (j == x) ? c : mine; }
        if (sum == G) break;
        __builtin_amdgcn_s_sleep(1);
        if ((++sp & 255u) == 0u) { if (xb_ld(&bar[XB_TMO])) break; if (sp > XB_SPIN_CAP) { atomicAdd(&bar[XB_TMO], 1u); break; } }
    }
    nloc = mine > 0u ? mine : 1u; nx = cnt > 0u ? cnt : 1u;
}
__device__ __forceinline__ void xcd_barrier(const XcdBarrier& b) {
    asm volatile("s_waitcnt vmcnt(0)" ::: "memory");
    __syncthreads();
    if (threadIdx.x == 0) {
        unsigned* bar = b.bar;
        __builtin_amdgcn_s_waitcnt(0);
        unsigned nloc = b.st[0], nx = b.st[1];
        if (nloc == 0u) { xcd_barrier_complete(bar, b.x, nloc, nx); b.st[0] = nloc; b.st[1] = nx; }
        const unsigned old = xb_add(&bar[XB_XSUB(b.x)], 1u);
        const unsigned gen = old / nloc;
        if (old + 1u == (gen + 1u) * nloc) {
            __builtin_amdgcn_fence(__ATOMIC_RELEASE, "agent");
            asm volatile("s_waitcnt vmcnt(0)" ::: "memory");
            const unsigned og = xb_add(&bar[XB_TOP], 1u);
            const unsigned tg = og / nx;
            if (og + 1u == (tg + 1u) * nx) xb_add(&bar[XB_TOPGEN], 1u);
            else XB_SPIN(xb_ld(&bar[XB_TOPGEN]) == tg, bar);
            __builtin_amdgcn_fence(__ATOMIC_ACQUIRE, "agent");
            xb_add(&bar[XB_XGEN(b.x)], 1u);
            asm volatile("s_waitcnt vmcnt(0)" ::: "memory");
        } else {
            XB_SPIN(xb_ld(&bar[XB_XGEN(b.x)]) == gen, bar);
            __builtin_amdgcn_fence(__ATOMIC_ACQUIRE, "agent");
            asm volatile("s_waitcnt vmcnt(0)" ::: "memory");
        }
    }
    __syncthreads();
}

struct Args { const float* in[29]; float* out; unsigned char* ws; };
typedef const __attribute__((address_space(4))) Args* ArgsP;
struct AR { ArgsP p;
    __device__ __forceinline__ const float* in(int i) const { return p->in[i]; }
    __device__ __forceinline__ float* out() const { return p->out; }
    __device__ __forceinline__ unsigned char* ws() const { return p->ws; } };
enum { I_X = 0, I_C, I_WADA, I_BADA, I_LN1G, I_LN1B, I_WIN, I_BF, I_CONVW, I_CONVB, I_WA, I_BA, I_WX, I_BX, I_LAM, I_WGATE, I_BGATE, I_WPA, I_WPB, I_WPC, I_WO,
       I_LN2G, I_LN2B, I_WR, I_BR, I_WGU, I_BGU, I_WDN, I_BDN };

__device__ __forceinline__ void p0_transpose_item(const float* W, int ldw, int srccol0, int k0, bf16_t* WT, size_t ldt, int drow0, int dk0, LAS float* scr, int lane) {
#pragma unroll 8
    for (int i = 0; i < 32; ++i) { const int kk = 2 * i + (lane >> 5); scr[kk * 33 + (lane & 31)] = W[(size_t)(k0 + kk) * ldw + srccol0 + (lane & 31)]; }
    LDS_WAIT(); asm volatile("" ::: "memory");
    const int c = lane & 7;
#pragma unroll
    for (int j = 0; j < 4; ++j) { const int n = (lane >> 3) + 8 * j; const LAS float* s = scr + (8 * c) * 33 + n;
        u32x4 o; o.x = pk2(s[0 * 33], s[1 * 33]); o.y = pk2(s[2 * 33], s[3 * 33]); o.z = pk2(s[4 * 33], s[5 * 33]); o.w = pk2(s[6 * 33], s[7 * 33]);
        *(GAS u32x4*)(WT + (size_t)(drow0 + n) * ldt + dk0 + k0 + 8 * c) = o; }
    LDS_WAIT(); asm volatile("" ::: "memory");
}
constexpr int IT_IN = 16 * 160, IT_G = 16 * 96, IT_PA = 8 * 32, IT_PB = 8 * 32, IT_PC = 16 * 32, IT_O = 16 * 32, IT_GU = 32 * 16 * 64, IT_DN = 32 * 16 * 32;
constexpr int IT_LAYER = IT_IN + IT_G + IT_PA + IT_PB + IT_PC + IT_O + IT_GU + IT_DN;
__device__ __forceinline__ void p0_weights(const AR a, LAS unsigned char* lds, int gw, int NGW, int wave, int lane) {
    LAS float* scr = (LAS float*)(lds + wave * 16384);
    for (int it = gw; it < DEPTH * IT_LAYER; it += NGW) {
        const int l = it / IT_LAYER; int r = it % IT_LAYER;
        unsigned char* wl = a.ws() + WS_W + (size_t)l * WL_SIZE;
        if (r < IT_IN) { const int kb = r / 160, nb = r % 160, n0 = 32 * nb; p0_transpose_item(a.in(I_WIN) + (size_t)l * D * DIN, DIN, n0 < 1536 ? n0 : n0 + 8, 64 * kb, (bf16_t*)(wl + WL_IN), 1024, n0, 0, scr, lane); continue; } r -= IT_IN;
        if (r < IT_G) { const int kb = r / 96, nb = r % 96, n0 = 32 * nb; p0_transpose_item(a.in(I_WGATE) + (size_t)l * D * 3072, 3072, n0, 64 * kb, (bf16_t*)(wl + WL_IN), 1024, 5120 + n0, 0, scr, lane); continue; } r -= IT_G;
        if (r < IT_PA) { const int kb = r / 32, nb = r % 32; p0_transpose_item(a.in(I_WPA) + (size_t)l * 512 * D, D, 32 * nb, 64 * kb, (bf16_t*)(wl + WL_P), 2048, 32 * nb, 0, scr, lane); continue; } r -= IT_PA;
        if (r < IT_PB) { const int kb = r / 32, nb = r % 32; p0_transpose_item(a.in(I_WPB) + (size_t)l * 512 * D, D, 32 * nb, 64 * kb, (bf16_t*)(wl + WL_P), 2048, 32 * nb, 512, scr, lane); continue; } r -= IT_PB;
        if (r < IT_PC) { const int kb = r / 32, nb = r % 32; p0_transpose_item(a.in(I_WPC) + (size_t)l * D * D, D, 32 * nb, 64 * kb, (bf16_t*)(wl + WL_P), 2048, 32 * nb, 1024, scr, lane); continue; } r -= IT_PC;
        if (r < IT_O) { const int kb = r / 32, nb = r % 32; p0_transpose_item(a.in(I_WO) + (size_t)l * D * D, D, 32 * nb, 64 * kb, (bf16_t*)(wl + WL_O), 1024, 32 * nb, 0, scr, lane); continue; } r -= IT_O;
        if (r < IT_GU) { const int e = r / 1024, q = r % 1024, kb = q / 64, nb = q % 64, n0 = 32 * nb;
            const int src = 1024 * ((n0 >> 7) & 1) + 128 * (n0 >> 8) + (n0 & 127);
            p0_transpose_item(a.in(I_WGU) + ((size_t)l * NEXP + e) * D * 2048, 2048, src, 64 * kb, (bf16_t*)(wl + WL_GU) + (size_t)e * 2048 * 1024, 1024, n0, 0, scr, lane); continue; } r -= IT_GU;
        { const int e = r / 512, q = r % 512, kb = q / 32, nb = q % 32;
            p0_transpose_item(a.in(I_WDN) + ((size_t)l * NEXP + e) * D * D, D, 32 * nb, 64 * kb, (bf16_t*)(wl + WL_DN) + (size_t)e * 1024 * 1024, 1024, 32 * nb, 0, scr, lane); }
    }
}
__device__ __forceinline__ void p0_ada(const AR a, LAS unsigned char* lds, int item, int tid, int wave, int lane) {
    LAS float* cond = (LAS float*)lds;
    LAS float* part = (LAS float*)(lds + 65536);
    const int l = item / 96, cg = item % 96, col = cg * 64 + lane;
    const float* c = a.in(I_C);
    for (int i = tid; i < 16 * 1024; i += 512) { const float v = c[i]; cond[i] = v * fsigmoid(v); }
    __syncthreads();
    float acc[16];
#pragma unroll
    for (int b = 0; b < 16; ++b) acc[b] = 0.f;
    const float* W = a.in(I_WADA) + (size_t)l * D * 6144;
#pragma unroll 4
    for (int kk = 0; kk < 128; ++kk) { const int k = wave * 128 + kk; const float w = W[(size_t)k * 6144 + col];
#pragma unroll
        for (int b = 0; b < 16; ++b) acc[b] += cond[b * 1024 + k] * w; }
#pragma unroll
    for (int b = 0; b < 16; ++b) part[(wave * 16 + b) * 64 + lane] = acc[b];
    __syncthreads();
    float* ada = (float*)(a.ws() + WS_ADA);
    for (int o = tid; o < 1024; o += 512) { const int b = o >> 6, ln = o & 63; float s = 0.f;
#pragma unroll
        for (int w = 0; w < 8; ++w) s += part[(w * 16 + b) * 64 + ln];
        ada[((size_t)l * 16 + b) * 6144 + cg * 64 + ln] = s + a.in(I_BADA)[(size_t)l * 6144 + cg * 64 + ln]; }
    __syncthreads();
}

__device__ __forceinline__ void stage_wf(const AR a, int l, LAS unsigned char* lds, int tid) {
    LAS float* Wf = (LAS float*)lds;
    const float* W = a.in(I_WIN) + (size_t)l * D * DIN + 1536;
    for (int i = tid; i < 8192; i += 512) Wf[i] = W[(size_t)(i >> 3) * DIN + (i & 7)];
}
__device__ __forceinline__ float log_sigmoidf(float x) { return fminf(x, 0.f) - log1pf(expf(-fabsf(x))); }
__device__ __forceinline__ void prep_row(const AR a, int l, int m, const f32x4 (&x)[4], const LAS float* Wf, int lane) {
    const int b = m >> 11;
    const float* ada = (const float*)(a.ws() + WS_ADA) + ((size_t)l * 16 + b) * 6144;
    bf16_t* H = (bf16_t*)(a.ws() + WS_H) + (size_t)m * D;
    float s[8];
#pragma unroll
    for (int j = 0; j < 8; ++j) s[j] = 0.f;
#pragma unroll
    for (int j = 0; j < 4; ++j) {
        const int col = 4 * lane + 256 * j;
        const f32x4 sh = *(const f32x4*)(ada + col), sc = *(const f32x4*)(ada + 1024 + col);
        const f32x4 h = x[j] * (sc + 1.0f) + sh;
        u32x2 w; w.x = pk2(h[0], h[1]); w.y = pk2(h[2], h[3]);
        *(u32x2*)(H + col) = w;
#pragma unroll
        for (int i = 0; i < 4; ++i) { const f32x4 w0 = *(const LAS f32x4*)(Wf + (col + i) * 8), w1 = *(const LAS f32x4*)(Wf + (col + i) * 8 + 4);
            s[0] += h[i] * w0[0]; s[1] += h[i] * w0[1]; s[2] += h[i] * w0[2]; s[3] += h[i] * w0[3];
            s[4] += h[i] * w1[0]; s[5] += h[i] * w1[1]; s[6] += h[i] * w1[2]; s[7] += h[i] * w1[3]; }
    }
#pragma unroll
    for (int j = 0; j < 8; ++j) s[j] = wave_sum(s[j]);
    float mine = s[0];
#pragma unroll
    for (int j = 1; j < 8; ++j) mine = (lane == j) ? s[j] : mine;
    if (lane < 8) { float* logf = (float*)(a.ws() + WS_LOGF); logf[(size_t)m * 8 + lane] = log_sigmoidf(mine + a.in(I_BF)[l * 8 + lane]); }
}
__device__ __forceinline__ void ln_row(f32x4 (&v)[4], const float* g, const float* bb, int lane) {
    float s = 0.f;
#pragma unroll
    for (int j = 0; j < 4; ++j) s += (v[j][0] + v[j][1]) + (v[j][2] + v[j][3]);
    const float mean = wave_sum(s) * (1.f / D); float s2 = 0.f;
#pragma unroll
    for (int j = 0; j < 4; ++j) { v[j] = v[j] - mean; s2 += (v[j][0] * v[j][0] + v[j][1] * v[j][1]) + (v[j][2] * v[j][2] + v[j][3] * v[j][3]); }
    const float rstd = 1.f / sqrtf(wave_sum(s2) * (1.f / D) + LN_EPS);
#pragma unroll
    for (int j = 0; j < 4; ++j) { const int col = 4 * lane + 256 * j; const f32x4 gg = *(const f32x4*)(g + col), bv = *(const f32x4*)(bb + col); v[j] = v[j] * rstd * gg + bv; }
}

struct DenseOrder {
    pg8::TileOrder T; const char* A; const char* B; int lda, ldb, nt;
    __device__ __forceinline__ bool next(int i, pg8::Unit& u) const { u.aux = 0; return T.tile(i, u.pm, u.pn); }
    __device__ __forceinline__ void operands(const pg8::Unit& u, const char*& a, const char*& b, int& n) const {
        a = A + (size_t)u.pm * 256 * lda * 2; b = B + (size_t)u.pn * 256 * ldb * 2; n = nt; }
};
struct MergeOrder {
    pg8::TileOrder T; const char* A; const char* B;
    __device__ __forceinline__ bool next(int i, pg8::Unit& u) const { u.aux = i % 3; return T.tile(i / 3, u.pm, u.pn); }
    __device__ __forceinline__ void operands(const pg8::Unit& u, const char*& a, const char*& b, int& n) const {
        const int k0 = (u.aux == 0) ? 0 : (u.aux == 1 ? 512 : 1024);
        a = A + ((size_t)u.pm * 256 * OP + k0) * 2; b = B + ((size_t)u.pn * 256 * OP + k0) * 2; n = (u.aux == 2) ? 16 : 8; }
};
struct MoeTables { const LAS int* cnt; const LAS int* bs; const LAS unsigned char* be; };
__device__ __forceinline__ MoeTables moe_tables(LAS unsigned char* lds) {
    MoeTables t; t.cnt = (const LAS int*)(lds + MISC_OFF + MO_CNT); t.bs = (const LAS int*)(lds + MISC_OFF + MO_BS); t.be = (const LAS unsigned char*)(lds + MISC_OFF + MO_BE); return t; }
__device__ __forceinline__ void moe_build_tables(gu32* ctl, int l, LAS unsigned char* lds, int tid) {
    LAS int* cnt = (LAS int*)(lds + MISC_OFF + MO_CNT); LAS int* bs = (LAS int*)(lds + MISC_OFF + MO_BS); LAS unsigned char* be = (LAS unsigned char*)(lds + MISC_OFF + MO_BE);
    __syncthreads();
    if (tid < 32) cnt[tid] = (int)__hip_atomic_load(ctl + CW_GCNT + (l * 32 + tid) * 64, RLX_AGENT);
    __syncthreads();
    if (tid == 0) { int s = 0; for (int e = 0; e < 32; ++e) { bs[e] = s; int c = cnt[e]; if (c > ECAP) c = ECAP; s += (c + 255) >> 8; } if (s > MAXBLK) s = MAXBLK; bs[32] = s; }
    __syncthreads();
    { const int nb = bs[32]; for (int b = tid; b < nb; b += 512) { int e = 0;
#pragma unroll 1
          for (int q = 1; q < 32; ++q) if (bs[q] <= b) e = q;
          be[b] = (unsigned char)e; } }
    __syncthreads();
}
template <int NPN, bool G1> struct MoeOrder {
    int vcu; MoeTables t; const char* A; const char* B; const int* slot_tok;
    __device__ __forceinline__ bool next(int i, pg8::Unit& u) const {
        const int L = i * 256 + vcu, nb = t.bs[32]; if (L >= nb * NPN) return false;
        u.pm = L / NPN; u.pn = L % NPN; u.aux = t.be[u.pm]; return true; }
    __device__ __forceinline__ void operands(const pg8::Unit& u, const char*& a, const char*& b, int& n) const {
        if (G1) { a = A; b = B + ((size_t)u.aux * 2048 + (size_t)u.pn * 256) * 1024 * 2; }
        else { a = A + (size_t)u.pm * 256 * 1024 * 2; b = B + ((size_t)u.aux * 1024 + (size_t)u.pn * 256) * 1024 * 2; }
        n = 16; }
    __device__ __forceinline__ void gather(const pg8::Unit& u, const int (&R)[2], const int (&C)[2], unsigned (&vg)[2][2]) const {
        const int e = u.aux, j = u.pm - t.bs[e], c = t.cnt[e];
#pragma unroll
        for (int h = 0; h < 2; ++h)
#pragma unroll
            for (int i = 0; i < 2; ++i) { const int idx = 256 * j + 128 * h + R[i]; int tok = 0; if (idx < c) tok = slot_tok[(size_t)e * ECAP + idx];
                vg[h][i] = (unsigned)tok * 2048u + (unsigned)C[i] * 2u; }
    }
};

__device__ __forceinline__ u32x4 pack8(const f32x4& v0, const f32x4& v1) { u32x4 w; w.x = pk2(v0[0], v0[1]); w.y = pk2(v0[2], v0[3]); w.z = pk2(v1[0], v1[1]); w.w = pk2(v1[2], v1[3]); return w; }
__device__ __forceinline__ void unpack8(const u32x4& w, f32x4& v0, f32x4& v1) {
    v0[0] = __uint_as_float(w.x << 16); v0[1] = __uint_as_float(w.x & 0xffff0000u); v0[2] = __uint_as_float(w.y << 16); v0[3] = __uint_as_float(w.y & 0xffff0000u);
    v1[0] = __uint_as_float(w.z << 16); v1[1] = __uint_as_float(w.z & 0xffff0000u); v1[2] = __uint_as_float(w.w << 16); v1[3] = __uint_as_float(w.w & 0xffff0000u); }

struct EpiInProj {
    static constexpr bool PERM = true;
    bf16_t* Z; const float* bgate;
    __device__ __forceinline__ void operator()(const f32x4 (&acc)[2][2][4][2], const pg8::Unit& u, int wr, int wc, int fr, int fq) const {
        const int row0 = u.pm * 256 + wr * 64 + fr, col0 = u.pn * 256 + wc * 32 + 8 * fq;
        const int mode = (u.pn >= 20) ? 2 : ((u.pn < 2 || (u.pn >= 6 && u.pn < 8)) ? 1 : 0);
        f32x4 bv[2][2];
#pragma unroll
        for (int bj = 0; bj < 2; ++bj)
#pragma unroll
            for (int n = 0; n < 2; ++n) bv[bj][n] = (mode == 2) ? *(const f32x4*)(bgate + (col0 - ZC_G) + bj * 128 + 4 * n) : (f32x4){0.f, 0.f, 0.f, 0.f};
        const float sc = (mode == 1) ? C2 : 1.0f;
#pragma unroll
        for (int ai = 0; ai < 2; ++ai)
#pragma unroll
            for (int m = 0; m < 4; ++m) { bf16_t* rowp = Z + (size_t)(row0 + ai * 128 + m * 16) * ZP + col0;
#pragma unroll
                for (int bj = 0; bj < 2; ++bj) { f32x4 v0 = acc[ai][bj][m][0] + bv[bj][0], v1 = acc[ai][bj][m][1] + bv[bj][1];
                    if (mode == 2) {
#pragma unroll
                        for (int i = 0; i < 4; ++i) { v0[i] = fsigmoid(v0[i]); v1[i] = fsigmoid(v1[i]); } }
                    v0 = v0 * sc; v1 = v1 * sc;
                    *(u32x4*)(rowp + bj * 128) = pack8(v0, v1); } }
    }
};
struct EpiMerge {
    static constexpr bool PERM = true;
    const bf16_t* Z; float* MB; bf16_t* MG;
    __device__ __forceinline__ void operator()(const f32x4 (&acc)[2][2][4][2], const pg8::Unit& u, int wr, int wc, int fr, int fq) const {
        const int row0 = u.pm * 256 + wr * 64 + fr, col0 = u.pn * 256 + wc * 32 + 8 * fq, seg = u.aux;
#pragma unroll
        for (int ai = 0; ai < 2; ++ai)
#pragma unroll
            for (int m = 0; m < 4; ++m) { const size_t row = (size_t)(row0 + ai * 128 + m * 16);
#pragma unroll
                for (int bj = 0; bj < 2; ++bj) { const int c = col0 + bj * 128;
                    const u32x4 gw = *(const u32x4*)(Z + row * ZP + ZC_G + seg * 1024 + c); f32x4 g0, g1; unpack8(gw, g0, g1);
                    f32x4 v0 = acc[ai][bj][m][0] * g0, v1 = acc[ai][bj][m][1] * g1;
                    float* mb = MB + row * D + c;
                    if (seg != 0) { v0 = v0 + *(const f32x4*)mb; v1 = v1 + *(const f32x4*)(mb + 4); }
                    if (seg != 2) { *(f32x4*)mb = v0; *(f32x4*)(mb + 4) = v1; }
                    else *(u32x4*)(MG + row * D + c) = pack8(v0, v1); } }
    }
};
struct EpiF32 {
    static constexpr bool PERM = false;
    float* C; int ldc;
    __device__ __forceinline__ void operator()(const f32x4 (&acc)[2][2][4][2], const pg8::Unit& u, int wr, int wc, int fr, int fq) const {
        const int row0 = u.pm * 256 + wr * 64 + fr, col0 = u.pn * 256 + wc * 32 + 4 * fq;
#pragma unroll
        for (int ai = 0; ai < 2; ++ai)
#pragma unroll
            for (int m = 0; m < 4; ++m) { float* rowp = C + (size_t)(row0 + ai * 128 + m * 16) * ldc + col0;
#pragma unroll
                for (int bj = 0; bj < 2; ++bj)
#pragma unroll
                    for (int n = 0; n < 2; ++n) *(f32x4*)(rowp + bj * 128 + n * 16) = acc[ai][bj][m][n]; }
    }
};
struct EpiGU {
    static constexpr bool PERM = true;
    bf16_t* ACT; const float* bgu;
    __device__ __forceinline__ void operator()(const f32x4 (&acc)[2][2][4][2], const pg8::Unit& u, int wr, int wc, int fr, int fq) const {
        const int row0 = u.pm * 256 + wr * 64 + fr, cc = u.pn * 128 + wc * 32 + 8 * fq;
        const float* bg = bgu + (size_t)u.aux * 2048 + cc;
        const f32x4 bg0 = *(const f32x4*)bg, bg1 = *(const f32x4*)(bg + 4), bu0 = *(const f32x4*)(bg + 1024), bu1 = *(const f32x4*)(bg + 1028);
#pragma unroll
        for (int ai = 0; ai < 2; ++ai)
#pragma unroll
            for (int m = 0; m < 4; ++m) {
                f32x4 g0 = acc[ai][0][m][0] + bg0, g1 = acc[ai][0][m][1] + bg1, u0 = acc[ai][1][m][0] + bu0, u1 = acc[ai][1][m][1] + bu1, o0, o1;
#pragma unroll
                for (int i = 0; i < 4; ++i) {
                    float ga = fminf(g0[i], 7.0f), up = fminf(fmaxf(u0[i], -7.0f), 7.0f); o0[i] = (up + 1.0f) * (ga * fsigmoid(1.702f * ga));
                    ga = fminf(g1[i], 7.0f); up = fminf(fmaxf(u1[i], -7.0f), 7.0f); o1[i] = (up + 1.0f) * (ga * fsigmoid(1.702f * ga)); }
                *(u32x4*)(ACT + (size_t)(row0 + ai * 128 + m * 16) * D + cc) = pack8(o0, o1); }
    }
};
struct EpiDown {
    static constexpr bool PERM = true;
    bf16_t* YB; const float* bdn;
    __device__ __forceinline__ void operator()(const f32x4 (&acc)[2][2][4][2], const pg8::Unit& u, int wr, int wc, int fr, int fq) const {
        const int row0 = u.pm * 256 + wr * 64 + fr, col0 = u.pn * 256 + wc * 32 + 8 * fq;
        const float* bp = bdn + (size_t)u.aux * D + col0;
        f32x4 bv[2][2];
#pragma unroll
        for (int bj = 0; bj < 2; ++bj)
#pragma unroll
            for (int n = 0; n < 2; ++n) bv[bj][n] = *(const f32x4*)(bp + bj * 128 + 4 * n);
#pragma unroll
        for (int ai = 0; ai < 2; ++ai)
#pragma unroll
            for (int m = 0; m < 4; ++m) { bf16_t* rowp = YB + (size_t)(row0 + ai * 128 + m * 16) * D + col0;
#pragma unroll
                for (int bj = 0; bj < 2; ++bj) *(u32x4*)(rowp + bj * 128) = pack8(acc[ai][bj][m][0] + bv[bj][0], acc[ai][bj][m][1] + bv[bj][1]); }
    }
};

__device__ __forceinline__ void fcumsum_wave(const AR a, int bh, int lane) {
    const int b = bh >> 3, h = bh & 7;
    const float* logf = (const float*)(a.ws() + WS_LOGF) + ((size_t)b * SEQ + 32 * lane) * 8 + h;
    float v[32]; float run = 0.f;
#pragma unroll
    for (int i = 0; i < 32; ++i) { run += logf[i * 8]; v[i] = run; }
    float inc = run;
#pragma unroll
    for (int o = 1; o < 64; o <<= 1) { const float t = __shfl_up(inc, o); if (lane >= o) inc += t; }
    const float base = inc - run;
    float* F2 = (float*)(a.ws() + WS_F2) + (size_t)bh * SEQ + 32 * lane;
#pragma unroll
    for (int i = 0; i < 32; i += 4) { f32x4 o = {(base + v[i]) * LOG2E, (base + v[i + 1]) * LOG2E, (base + v[i + 2]) * LOG2E, (base + v[i + 3]) * LOG2E}; *(f32x4*)(F2 + i) = o; }
}

__device__ __forceinline__ int crow(int r, int hi) { return (r & 3) + 8 * (r >> 2) + 4 * hi; }
#define MFMA32(a, b, c) __builtin_amdgcn_mfma_f32_32x32x16_bf16(a, b, c, 0, 0, 0)

constexpr int LRU_WB = 9728;
constexpr int LRU_CW = 8 * LRU_WB;
constexpr int LRU_BF = LRU_CW + 2048;
__device__ __forceinline__ void lru_unit(const AR a, int l, int b, int n, LAS unsigned char* lds, int tid, int wave, int lane) {
    const int r32 = lane & 31, hi = lane >> 5;
    LAS unsigned char* wb = lds + wave * LRU_WB;
    LAS unsigned short* XS = (LAS unsigned short*)wb; LAS unsigned short* GS = (LAS unsigned short*)(wb + 5120); LAS unsigned short* OS = XS;
    LAS unsigned char* BF = lds + LRU_BF;
    LAS float* CWT = (LAS float*)(lds + LRU_CW); LAS float* CBT = CWT + 256;
    LAS float* CAR = (LAS float*)(lds + MISC_OFF + MO_CAR);
    const bf16_t* Z = (const bf16_t*)(a.ws() + WS_Z); bf16_t* O = (bf16_t*)(a.ws() + WS_O);
    const int chb = n * 64;
    __syncthreads();
    if (tid < 256) CWT[tid] = a.in(I_CONVW)[(size_t)l * 4 * D + (tid >> 6) * D + chb + (tid & 63)];
    else if (tid < 320) CBT[tid - 256] = a.in(I_CONVB)[(size_t)l * D + chb + (tid - 256)];
#pragma unroll
    for (int q = 0; q < 2; ++q) { const int f = 2 * wave + q, mat = f >> 3, ks = (f >> 1) & 3, nt = f & 1, d = 32 * nt + r32, c0 = 16 * ks + 8 * hi;
        const float* w = a.in(mat ? I_WX : I_WA) + ((size_t)l * 16 + n) * 4096; u32x4 p;
        p.x = pk2(w[(c0 + 0) * 64 + d], w[(c0 + 1) * 64 + d]); p.y = pk2(w[(c0 + 2) * 64 + d], w[(c0 + 3) * 64 + d]); p.z = pk2(w[(c0 + 4) * 64 + d], w[(c0 + 5) * 64 + d]); p.w = pk2(w[(c0 + 6) * 64 + d], w[(c0 + 7) * 64 + d]);
        *(LAS u32x4*)(BF + f * 1024 + lane * 16) = p; }
    float ba[2], bx[2], cl[2], cwo[4][2], cbo[2], csup[2];
#pragma unroll
    for (int nt = 0; nt < 2; ++nt) { const int ch = chb + 32 * nt + r32;
        ba[nt] = a.in(I_BA)[(size_t)l * D + ch]; bx[nt] = a.in(I_BX)[(size_t)l * D + ch];
        const float lam = a.in(I_LAM)[(size_t)l * D + ch];
        cl[nt] = -8.0f * (fmaxf(-lam, 0.f) + log1pf(expf(-fabsf(lam))));
#pragma unroll
        for (int j = 0; j < 4; ++j) cwo[j][nt] = a.in(I_CONVW)[(size_t)l * 4 * D + j * D + ch];
        cbo[nt] = a.in(I_CONVB)[(size_t)l * D + ch]; csup[nt] = 0.f; }
    __syncthreads();
    int par = 0;
    for (int s = 0; s < 8; ++s) {
        const int t0 = 256 * s + 32 * wave; const size_t m0 = (size_t)b * SEQ + t0;
#pragma unroll
        for (int it = 0; it < 5; ++it) { const int c = lane + 64 * it; if (c < 280) { const int rr = c >> 3, c8 = c & 7; u32x4 v = {0u, 0u, 0u, 0u};
            if (t0 - 3 + rr >= 0) v = *(const u32x4*)(Z + (m0 - 3 + rr) * ZP + ZC_XC + chb + 8 * c8);
            *(LAS u32x4*)((LAS unsigned char*)XS + rr * 144 + c8 * 16) = v; } }
#pragma unroll
        for (int it = 0; it < 4; ++it) { const int c = lane + 64 * it; const int rr = c >> 3, c8 = c & 7;
            *(LAS u32x4*)((LAS unsigned char*)GS + rr * 144 + c8 * 16) = *(const u32x4*)(Z + (m0 + rr) * ZP + ZC_GC + chb + 8 * c8); }
        LDS_WAIT(); asm volatile("" ::: "memory");
        f32x16 accA[2], accX[2];
#pragma unroll
        for (int nt = 0; nt < 2; ++nt) { accA[nt] = f32x16{}; accX[nt] = f32x16{}; }
#pragma unroll
        for (int ks = 0; ks < 4; ++ks) { const int c0 = 16 * ks + 8 * hi;
            f32x4 o0 = *(const LAS f32x4*)(CBT + c0), o1 = *(const LAS f32x4*)(CBT + c0 + 4);
#pragma unroll
            for (int j = 0; j < 4; ++j) { const u32x4 xw = *(const LAS u32x4*)((LAS unsigned char*)XS + (r32 + j) * 144 + c0 * 2); f32x4 x0, x1; unpack8(xw, x0, x1);
                const f32x4 w0 = *(const LAS f32x4*)(CWT + j * 64 + c0), w1 = *(const LAS f32x4*)(CWT + j * 64 + c0 + 4);
                o0 = o0 + x0 * w0; o1 = o1 + x1 * w1; }
            const bf16x8 af = __builtin_bit_cast(bf16x8, pack8(o0, o1));
#pragma unroll
            for (int nt = 0; nt < 2; ++nt) { const bf16x8 bwa = *(const LAS bf16x8*)(BF + (ks * 2 + nt) * 1024 + lane * 16), bwx = *(const LAS bf16x8*)(BF + (8 + ks * 2 + nt) * 1024 + lane * 16);
                accA[nt] = MFMA32(af, bwa, accA[nt]); accX[nt] = MFMA32(af, bwx, accX[nt]); } }
        float av[2][16], uv[2][16], TA[2], TH[2];
#pragma unroll
        for (int nt = 0; nt < 2; ++nt) { const int d = 32 * nt + r32;
#pragma unroll
            for (int r = 0; r < 16; ++r) { const int row = crow(r, hi);
                float xc = cbo[nt];
#pragma unroll
                for (int j = 0; j < 4; ++j) xc += cwo[j][nt] * bf2f((unsigned)XS[(row + j) * 72 + d]);
                const float rg = fsigmoid(accA[nt][r] + ba[nt]), ig = fsigmoid(accX[nt][r] + bx[nt]);
                const float la = cl[nt] * rg, aa = fexp2(la * LOG2E), x2 = 2.0f * la;
                const float om = (x2 > -0.1f) ? -x2 * (1.0f + x2 * (0.5f + x2 * (0.16666667f + x2 * 0.041666668f))) : 1.0f - aa * aa;
                av[nt][r] = aa; uv[nt][r] = sqrtf(om) * (ig * xc);
                if ((r & 3) == 3) asm volatile("" ::: "memory"); }
            float GA[4], GH[4], oA[4], oH[4], cown[4], pown[4];
#pragma unroll
            for (int gi = 0; gi < 4; ++gi) { float hh = 0.f, pp = 1.f;
#pragma unroll
                for (int q = 0; q < 4; ++q) { const int r = 4 * gi + q; hh = av[nt][r] * hh + uv[nt][r]; pp = pp * av[nt][r]; uv[nt][r] = hh; av[nt][r] = pp; }
                GA[gi] = pp; GH[gi] = hh; oA[gi] = __shfl_xor(pp, 32); oH[gi] = __shfl_xor(hh, 32); cown[gi] = 0.f; pown[gi] = 1.f; }
            float cin = 0.f, pin = 1.f;
#pragma unroll
            for (int tg = 0; tg < 8; ++tg) { const int gi = tg >> 1; const bool own = ((tg & 1) == hi);
                const float A = own ? GA[gi] : oA[gi], H = own ? GH[gi] : oH[gi];
                cown[gi] = own ? cin : cown[gi]; pown[gi] = own ? pin : pown[gi];
                cin = A * cin + H; pin = A * pin; }
#pragma unroll
            for (int r = 0; r < 16; ++r) { uv[nt][r] = uv[nt][r] + av[nt][r] * cown[r >> 2]; av[nt][r] = av[nt][r] * pown[r >> 2]; }
            TA[nt] = pin; TH[nt] = cin;
            if (hi == 0) { CAR[((par * 8 + wave) * 64 + d) * 2] = pin; CAR[((par * 8 + wave) * 64 + d) * 2 + 1] = cin; } }
        __syncthreads();
#pragma unroll
        for (int nt = 0; nt < 2; ++nt) { const int d = 32 * nt + r32; float cw = csup[nt], call = csup[nt];
#pragma unroll
            for (int w2 = 0; w2 < 8; ++w2) { const f32x2 ah = *(const LAS f32x2*)(CAR + ((par * 8 + w2) * 64 + d) * 2);
                call = ah[0] * call + ah[1]; if (w2 < wave) cw = call; }
            csup[nt] = call;
#pragma unroll
            for (int r = 0; r < 16; ++r) { const int row = crow(r, hi);
                const float hf = uv[nt][r] + av[nt][r] * cw;
                const float g = bf2f((unsigned)GS[row * 72 + d]);
                const float ge = g * fsigmoid(1.5957691216f * (g + 0.044715f * g * g * g));
                OS[row * 72 + d] = (unsigned short)f2bf(hf * ge); } }
        LDS_WAIT(); asm volatile("" ::: "memory");
#pragma unroll
        for (int it = 0; it < 4; ++it) { const int c = lane + 64 * it; const int rr = c >> 3, c8 = c & 7;
            *(u32x4*)(O + (m0 + rr) * OP + 1024 + chb + 8 * c8) = *(const LAS u32x4*)((LAS unsigned char*)OS + rr * 144 + c8 * 16); }
        par ^= 1;
    }
}

constexpr int AT_KS = 0, AT_VT = 9216, AT_FS = 17920, AT_WSF = 18432, AT_FLAG = 20480;
template <int MODE>
__device__ __forceinline__ void attn_unit(const AR a, int b, int h, int qb, LAS unsigned char* lds, int tid, int wave, int lane) {
    const int r32 = lane & 31, hi = lane >> 5;
    const bf16_t* Z = (const bf16_t*)(a.ws() + WS_Z); bf16_t* O = (bf16_t*)(a.ws() + WS_O);
    const float* F2 = (const float*)(a.ws() + WS_F2) + (size_t)(b * 8 + h) * SEQ;
    const size_t rowbase = (size_t)b * SEQ; const int q0 = qb * 256, qw0 = q0 + 32 * wave, q = qw0 + r32;
    const int qcol = (MODE == 0 ? ZC_QA : ZC_QB) + h * 64, kcol = (MODE == 0 ? ZC_KA : ZC_KB) + h * 64, vcol = (MODE == 0 ? ZC_VA : ZC_VB) + h * 64, ocol = (MODE == 0 ? 0 : 512) + h * 64;
    LAS unsigned char* KS = lds + AT_KS; LAS unsigned short* VT = (LAS unsigned short*)(lds + AT_VT); LAS float* FS = (LAS float*)(lds + AT_FS);
    LAS float* wsf = (LAS float*)(lds + AT_WSF) + wave * 64; LAS int* flags = (LAS int*)(lds + AT_FLAG);
    bf16x8 qr[4];
#pragma unroll
    for (int ks = 0; ks < 4; ++ks) qr[ks] = *(const bf16x8*)(Z + (rowbase + q) * ZP + qcol + 16 * ks + 8 * hi);
    const float fq = (MODE == 0) ? F2[q] : 0.f;
    f32x16 o0 = f32x16{}, o1 = f32x16{};
    float mrun = -INFINITY, lsum = 0.f, R = 0.f;
    const int NT = 4 * qb + 4;
    const int lkey = tid >> 3, lch = tid & 7;
    const bf16_t* kp = Z + (rowbase + lkey) * ZP + kcol + 8 * lch; const bf16_t* vp = Z + (rowbase + lkey) * ZP + vcol + 8 * lch;
    u32x4 kreg = *(const u32x4*)(kp + (size_t)(NT - 1) * 64 * ZP), vreg = *(const u32x4*)(vp + (size_t)(NT - 1) * 64 * ZP);
    float freg = 0.f; if (MODE == 0 && tid < 64) freg = F2[(NT - 1) * 64 + tid];
    bool wdone = false;
    __syncthreads();
    for (int jt = NT - 1; jt >= 0; --jt) {
        *(LAS u32x4*)(KS + lkey * 144 + lch * 16) = kreg;
        { const unsigned vv[4] = {vreg.x, vreg.y, vreg.z, vreg.w};
#pragma unroll
          for (int i = 0; i < 4; ++i) { VT[(8 * lch + 2 * i) * 68 + lkey] = (unsigned short)(vv[i] & 0xffffu); VT[(8 * lch + 2 * i + 1) * 68 + lkey] = (unsigned short)(vv[i] >> 16); } }
        if (MODE == 0 && tid < 64) FS[tid] = freg;
        if (MODE == 1 && lane == 0) flags[wave] = wdone ? 1 : 0;
        __syncthreads();
        if (MODE == 1) { int all = 1;
#pragma unroll
            for (int w2 = 0; w2 < 8; ++w2) all &= flags[w2];
            if (all) break; }
        if (jt > 0) { kreg = *(const u32x4*)(kp + (size_t)(jt - 1) * 64 * ZP); vreg = *(const u32x4*)(vp + (size_t)(jt - 1) * 64 * ZP); if (MODE == 0 && tid < 64) freg = F2[(jt - 1) * 64 + tid]; }
        const int k0 = jt * 64;
        const bool active = (MODE == 0) ? (k0 <= qw0 + 31) : ((k0 < qw0 + 31) && !wdone);
        if (active) {
            f32x16 p0 = f32x16{}, p1 = f32x16{};
#pragma unroll
            for (int ks = 0; ks < 4; ++ks) { const bf16x8 ka = *(const LAS bf16x8*)(KS + r32 * 144 + (16 * ks + 8 * hi) * 2), kb = *(const LAS bf16x8*)(KS + (r32 + 32) * 144 + (16 * ks + 8 * hi) * 2);
                p0 = MFMA32(ka, qr[ks], p0); p1 = MFMA32(kb, qr[ks], p1); }
            if (MODE == 0) {
                float rm = -INFINITY;
#pragma unroll
                for (int g = 0; g < 4; ++g) { const f32x4 f0 = *(const LAS f32x4*)(FS + 8 * g + 4 * hi), f1 = *(const LAS f32x4*)(FS + 32 + 8 * g + 4 * hi);
#pragma unroll
                    for (int i = 0; i < 4; ++i) { const int r = 4 * g + i, kv = k0 + 8 * g + 4 * hi + i;
                        float s0 = p0[r] + (fq - f0[i]), s1 = p1[r] + (fq - f1[i]);
                        if (kv > q) s0 = -INFINITY; if (kv + 32 > q) s1 = -INFINITY;
                        p0[r] = s0; p1[r] = s1; rm = fmaxf(rm, fmaxf(s0, s1)); } }
                rm = fmaxf(rm, __shfl_xor(rm, 32));
                const float mnew = fmaxf(mrun, rm), alpha = fexp2(mrun - mnew); mrun = mnew;
                float ls = 0.f;
#pragma unroll
                for (int r = 0; r < 16; ++r) { p0[r] = fexp2(p0[r] - mnew); p1[r] = fexp2(p1[r] - mnew); ls += p0[r] + p1[r]; }
                lsum = lsum * alpha + ls;
                if (hi == 0) wsf[r32] = alpha;
                LDS_WAIT(); asm volatile("" ::: "memory");
#pragma unroll
                for (int r = 0; r < 16; ++r) { const float f = wsf[crow(r, hi)]; o0[r] *= f; o1[r] *= f; }
            } else {
                float sp0[16], sp1[16], GSm[8], oG[8];
#pragma unroll
                for (int r = 0; r < 16; ++r) { const int kv = k0 + crow(r, hi);
                    const float z0 = p0[r], z1 = p1[r];
                    const float a0 = fmaxf(z0, 0.f) + flog2(1.0f + fexp2(-fabsf(z0))), a1 = fmaxf(z1, 0.f) + flog2(1.0f + fexp2(-fabsf(z1)));
                    sp0[r] = (kv < q) ? a0 : 0.f; sp1[r] = (kv + 32 < q) ? a1 : 0.f; }
#pragma unroll
                for (int g = 0; g < 4; ++g) { GSm[g] = (sp0[4 * g] + sp0[4 * g + 1]) + (sp0[4 * g + 2] + sp0[4 * g + 3]); GSm[4 + g] = (sp1[4 * g] + sp1[4 * g + 1]) + (sp1[4 * g + 2] + sp1[4 * g + 3]); }
#pragma unroll
                for (int g = 0; g < 8; ++g) oG[g] = __shfl_xor(GSm[g], 32);
                float off[8], run = 0.f;
#pragma unroll
                for (int kg = 15; kg >= 0; --kg) { const bool own = ((kg & 1) == hi); const float sm = own ? GSm[kg >> 1] : oG[kg >> 1];
                    off[kg >> 1] = own ? run : off[kg >> 1]; run += sm; }
#pragma unroll
                for (int g = 0; g < 4; ++g) { float T0 = off[g], T1 = off[4 + g];
#pragma unroll
                    for (int i = 3; i >= 0; --i) { const int r = 4 * g + i, kv = k0 + crow(r, hi);
                        T0 += sp0[r]; T1 += sp1[r];
                        const float w0 = fexp2(p0[r] - T0 + R), w1 = fexp2(p1[r] - T1 + R);
                        p0[r] = (kv < q) ? w0 : 0.f; p1[r] = (kv + 32 < q) ? w1 : 0.f; } }
                R -= run;
                wdone = __all(R < -152.0f);
            }
            bf16x8 pa[4];
            { u32x4 w;
              w.x = pk2(p0[0], p0[1]); w.y = pk2(p0[2], p0[3]); w.z = pk2(p0[4], p0[5]); w.w = pk2(p0[6], p0[7]); pa[0] = __builtin_bit_cast(bf16x8, w);
              w.x = pk2(p0[8], p0[9]); w.y = pk2(p0[10], p0[11]); w.z = pk2(p0[12], p0[13]); w.w = pk2(p0[14], p0[15]); pa[1] = __builtin_bit_cast(bf16x8, w);
              w.x = pk2(p1[0], p1[1]); w.y = pk2(p1[2], p1[3]); w.z = pk2(p1[4], p1[5]); w.w = pk2(p1[6], p1[7]); pa[2] = __builtin_bit_cast(bf16x8, w);
              w.x = pk2(p1[8], p1[9]); w.y = pk2(p1[10], p1[11]); w.z = pk2(p1[12], p1[13]); w.w = pk2(p1[14], p1[15]); pa[3] = __builtin_bit_cast(bf16x8, w); }
#pragma unroll
            for (int s = 0; s < 4; ++s) {
#pragma unroll
                for (int d0 = 0; d0 < 2; ++d0) { const LAS unsigned short* vrow = VT + (32 * d0 + r32) * 68 + 16 * s + 4 * hi;
                    const u32x2 lo = *(const LAS u32x2*)vrow, hh = *(const LAS u32x2*)(vrow + 8);
                    const u32x4 vw = {lo.x, lo.y, hh.x, hh.y}; const bf16x8 vf = __builtin_bit_cast(bf16x8, vw);
                    if (d0 == 0) o0 = MFMA32(pa[s], vf, o0); else o1 = MFMA32(pa[s], vf, o1); } }
        }
        __syncthreads();
    }
    if (MODE == 0) { const float lt = lsum + __shfl_xor(lsum, 32); if (hi == 0) wsf[r32] = 1.0f / lt; LDS_WAIT(); asm volatile("" ::: "memory");
#pragma unroll
        for (int r = 0; r < 16; ++r) { const float f = wsf[crow(r, hi)]; o0[r] *= f; o1[r] *= f; } }
#pragma unroll
    for (int r = 0; r < 16; ++r) { bf16_t* op = O + (rowbase + qw0 + crow(r, hi)) * OP + ocol + r32; op[0] = (bf16_t)f2bf(o0[r]); op[32] = (bf16_t)f2bf(o1[r]); }
}

__device__ __forceinline__ void ln1_phase(const AR a, int l, const float* xin, LAS unsigned char* lds, int vcu, int tid, int wave, int lane) {
    LAS int* lcnt = (LAS int*)(lds + MISC_OFF + MO_LCNT); LAS int* lbase = (LAS int*)(lds + MISC_OFF + MO_LBASE);
    LAS unsigned* REC = (LAS unsigned*)(lds + MISC_OFF + MO_REC); LAS float* GT = (LAS float*)(lds + MISC_OFF + MO_GT);
    LAS float* LG = (LAS float*)(lds + MISC_OFF + MO_LG) + wave * 128;
    LAS float* HR = (LAS float*)(lds + wave * 16384);
    gu32* ctl = (gu32*)(a.ws() + WS_CTL);
    __syncthreads();
    if (tid < 32) lcnt[tid] = 0;
    __syncthreads();
    const float* Y = (const float*)(a.ws() + WS_Y); float* X1 = (float*)(a.ws() + WS_X1); bf16_t* H = (bf16_t*)(a.ws() + WS_H);
    const float* Wr = a.in(I_WR) + (size_t)l * D * NEXP; const float* br = a.in(I_BR) + (size_t)l * NEXP;
    const float* g1 = a.in(I_LN1G) + (size_t)l * D; const float* b1 = a.in(I_LN1B) + (size_t)l * D;
    for (int grp = 0; grp < 4; ++grp) {
#pragma unroll 1
        for (int rr = 0; rr < 4; ++rr) {
            const int rowl = wave * 16 + grp * 4 + rr, m = vcu * 128 + rowl, b = m >> 11;
            const float* ada = (const float*)(a.ws() + WS_ADA) + ((size_t)l * 16 + b) * 6144;
            f32x4 v[4];
#pragma unroll
            for (int j = 0; j < 4; ++j) { const int col = 4 * lane + 256 * j;
                const f32x4 xv = *(const f32x4*)(xin + (size_t)m * D + col), yv = *(const f32x4*)(Y + (size_t)m * D + col), gt = *(const f32x4*)(ada + 2048 + col);
                v[j] = xv * DN_ALPHA + (gt + 1.0f) * yv; }
            ln_row(v, g1, b1, lane);
#pragma unroll
            for (int j = 0; j < 4; ++j) { const int col = 4 * lane + 256 * j;
                *(f32x4*)(X1 + (size_t)m * D + col) = v[j];
                const f32x4 sh = *(const f32x4*)(ada + 3072 + col), sc = *(const f32x4*)(ada + 4096 + col);
                const f32x4 h = v[j] * (sc + 1.0f) + sh;
                u32x2 w; w.x = pk2(h[0], h[1]); w.y = pk2(h[2], h[3]); *(u32x2*)(H + (size_t)m * D + col) = w;
                *(LAS f32x4*)(HR + rr * 1024 + col) = h; }
        }
        LDS_WAIT(); asm volatile("" ::: "memory");
        { const int e = lane & 31, kh = lane >> 5; float acc[4] = {0.f, 0.f, 0.f, 0.f};
#pragma unroll 4
          for (int k4 = 0; k4 < 128; ++k4) { const int k = kh * 512 + 4 * k4;
              const float w0 = Wr[(k + 0) * 32 + e], w1 = Wr[(k + 1) * 32 + e], w2 = Wr[(k + 2) * 32 + e], w3 = Wr[(k + 3) * 32 + e];
#pragma unroll
              for (int r = 0; r < 4; ++r) { const f32x4 hv = *(const LAS f32x4*)(HR + r * 1024 + k); acc[r] += (hv[0] * w0 + hv[1] * w1) + (hv[2] * w2 + hv[3] * w3); } }
#pragma unroll
          for (int r = 0; r < 4; ++r) acc[r] += __shfl_xor(acc[r], 32);
          if (lane < 32) {
#pragma unroll
              for (int r = 0; r < 4; ++r) LG[r * 32 + lane] = acc[r] + br[lane]; } }
        LDS_WAIT(); asm volatile("" ::: "memory");
        if (lane < 4) {
            float v0 = -INFINITY, v1 = -INFINITY, v2 = -INFINITY, v3 = -INFINITY; int i0 = 0, i1 = 0, i2 = 0, i3 = 0;
#pragma unroll 1
            for (int e = 0; e < 32; ++e) { const float x = LG[lane * 32 + e];
                if (x > v3) { if (x > v2) { v3 = v2; i3 = i2; if (x > v1) { v2 = v1; i2 = i1; if (x > v0) { v1 = v0; i1 = i0; v0 = x; i0 = e; } else { v1 = x; i1 = e; } } else { v2 = x; i2 = e; } } else { v3 = x; i3 = e; } } }
            const float p1 = expf(v1 - v0), p2 = expf(v2 - v0), p3 = expf(v3 - v0), inv = 1.0f / (1.0f + p1 + p2 + p3);
            const int rowl = wave * 16 + grp * 4 + lane;
            const int ee[4] = {i0, i1, i2, i3}; const float gg[4] = {inv, p1 * inv, p2 * inv, p3 * inv};
#pragma unroll
            for (int k = 0; k < 4; ++k) { const int lr = __hip_atomic_fetch_add(lcnt + ee[k], 1, __ATOMIC_RELAXED, __HIP_MEMORY_SCOPE_WORKGROUP);
                REC[rowl * 4 + k] = (unsigned)ee[k] | ((unsigned)lr << 8); GT[rowl * 4 + k] = gg[k]; }
        }
        LDS_WAIT(); asm volatile("" ::: "memory");
    }
    __syncthreads();
    if (tid < 32) lbase[tid] = (int)__hip_atomic_fetch_add(ctl + CW_GCNT + (l * 32 + tid) * 64, (unsigned)lcnt[tid], RLX_AGENT);
    __syncthreads();
    { const int rowl = tid >> 2, k = tid & 3; const unsigned rec = REC[tid]; const int e = rec & 255, lr = rec >> 8, rank = lbase[e] + lr, tok = vcu * 128 + rowl;
      int* slot_tok = (int*)(a.ws() + WS_SLOTTOK); int* tok_er = (int*)(a.ws() + WS_TOKER); float* gates = (float*)(a.ws() + WS_GATE);
      if (rank < ECAP) slot_tok[(size_t)e * ECAP + rank] = tok;
      tok_er[tok * 4 + k] = e * ECAP + rank; gates[tok * 4 + k] = GT[tid]; }
    __syncthreads();
}

__device__ __forceinline__ void ln2_phase(const AR a, int l, float* xout, LAS unsigned char* lds, int gw, int NGW, int lane, bool prep_next) {
    const LAS int* bs = (const LAS int*)(lds + MISC_OFF + MO_BS);
    const LAS float* Wf = (const LAS float*)lds;
    const float* X1 = (const float*)(a.ws() + WS_X1); const bf16_t* YB = (const bf16_t*)(a.ws() + WS_YB);
    const int* tok_er = (const int*)(a.ws() + WS_TOKER); const float* gates = (const float*)(a.ws() + WS_GATE);
    const float* g2 = a.in(I_LN2G) + (size_t)l * D; const float* b2 = a.in(I_LN2B) + (size_t)l * D;
    for (int m = gw; m < M; m += NGW) {
        const int b = m >> 11;
        const float* ada = (const float*)(a.ws() + WS_ADA) + ((size_t)l * 16 + b) * 6144;
        f32x4 y[4];
#pragma unroll
        for (int j = 0; j < 4; ++j) y[j] = (f32x4){0.f, 0.f, 0.f, 0.f};
#pragma unroll
        for (int k = 0; k < 4; ++k) { const int er = tok_er[m * 4 + k], e = er >> 15, rank = er & (ECAP - 1); const float g = gates[m * 4 + k];
            const bf16_t* yr = YB + ((size_t)bs[e] * 256 + rank) * D;
#pragma unroll
            for (int j = 0; j < 4; ++j) { const u32x2 w = *(const u32x2*)(yr + 4 * lane + 256 * j);
                y[j][0] += g * __uint_as_float(w.x << 16); y[j][1] += g * __uint_as_float(w.x & 0xffff0000u); y[j][2] += g * __uint_as_float(w.y << 16); y[j][3] += g * __uint_as_float(w.y & 0xffff0000u); } }
        f32x4 v[4];
#pragma unroll
        for (int j = 0; j < 4; ++j) { const int col = 4 * lane + 256 * j; const f32x4 xv = *(const f32x4*)(X1 + (size_t)m * D + col), gt = *(const f32x4*)(ada + 5120 + col);
            v[j] = xv * DN_ALPHA + (gt + 1.0f) * y[j]; }
        ln_row(v, g2, b2, lane);
#pragma unroll
        for (int j = 0; j < 4; ++j) *(f32x4*)(xout + (size_t)m * D + 4 * lane + 256 * j) = v[j];
        if (prep_next) prep_row(a, l + 1, m, v, Wf, lane);
    }
}

#if CHK
__device__ __forceinline__ void chk_rec(const AR a, int stage, float err) {
    if (!(err == err)) err = 1e30f; err = fabsf(err);
    atomicMax((unsigned*)(a.ws() + WS_CTL) + CW_CHK + stage, __float_as_uint(err));
}
__device__ __forceinline__ unsigned hash32(unsigned x) { x ^= x >> 16; x *= 0x7feb352du; x ^= x >> 15; x *= 0x846ca68bu; x ^= x >> 16; return x; }
__device__ __forceinline__ float relerr(float got, float ref, float fl) { return fabsf(got - ref) / (fabsf(ref) + fl); }
__device__ __forceinline__ float rbf(float x) { return bf2f(f2bf(x)); }
#define CHK_GT() ({ int t_ = threadIdx.x; asm volatile("" : "+v"(t_)); (int)(blockIdx.x * 512 + t_); })
__device__ __forceinline__ void chk_weights(const AR a) {
    const int s = CHK_GT(); if (s >= 8192) return;
    const unsigned h1 = hash32(s * 3 + 1), h2 = hash32(s * 3 + 2), h3 = hash32(s * 3 + 3); const int l = (s >> 3) & 1, job = s % 5;
    const unsigned char* wl = a.ws() + WS_W + (size_t)l * WL_SIZE; float ref = 0.f, got = 0.f;
    if (job == 0) { const int n = h1 % 8192, k = h2 % 1024; ref = n < 5120 ? a.in(I_WIN)[((size_t)l * D + k) * DIN + (n < 1536 ? n : n + 8)] : a.in(I_WGATE)[((size_t)l * D + k) * 3072 + n - 5120]; got = bf2f(((const bf16_t*)(wl + WL_IN))[(size_t)n * 1024 + k]); }
    else if (job == 1) { const int n = h1 % 1024, k = h2 % 2048; ref = k < 512 ? a.in(I_WPA)[((size_t)l * 512 + k) * D + n] : (k < 1024 ? a.in(I_WPB)[((size_t)l * 512 + k - 512) * D + n] : a.in(I_WPC)[((size_t)l * D + k - 1024) * D + n]); got = bf2f(((const bf16_t*)(wl + WL_P))[(size_t)n * 2048 + k]); }
    else if (job == 2) { const int n = h1 % 1024, k = h2 % 1024; ref = a.in(I_WO)[((size_t)l * D + k) * D + n]; got = bf2f(((const bf16_t*)(wl + WL_O))[(size_t)n * 1024 + k]); }
    else if (job == 3) { const int e = h3 % 32, n = h1 % 2048, k = h2 % 1024, src = 1024 * ((n >> 7) & 1) + 128 * (n >> 8) + (n & 127); ref = a.in(I_WGU)[(((size_t)l * 32 + e) * D + k) * 2048 + src]; got = bf2f(((const bf16_t*)(wl + WL_GU))[((size_t)e * 2048 + n) * 1024 + k]); }
    else { const int e = h3 % 32, n = h1 % 1024, k = h2 % 1024; ref = a.in(I_WDN)[(((size_t)l * 32 + e) * D + k) * D + n]; got = bf2f(((const bf16_t*)(wl + WL_DN))[((size_t)e * 1024 + n) * 1024 + k]); }
    chk_rec(a, 0, fabsf(got - rbf(ref)));
}
__device__ __forceinline__ void chk_ada(const AR a) {
    const int s = CHK_GT(); if (s >= 512) return;
    const unsigned h1 = hash32(s + 77); const int l = s & 1, b = (s >> 1) & 15, j = h1 % 6144; float acc = 0.f;
    for (int k = 0; k < D; ++k) { const float c = a.in(I_C)[b * D + k]; acc += (c / (1.f + expf(-c))) * a.in(I_WADA)[((size_t)l * D + k) * 6144 + j]; }
    acc += a.in(I_BADA)[l * 6144 + j];
    chk_rec(a, 1, relerr(((const float*)(a.ws() + WS_ADA))[((size_t)l * 16 + b) * 6144 + j], acc, 0.01f));
}
__device__ __forceinline__ void chk_prep(const AR a, int l, const float* xin, int stage) {
    const int s = CHK_GT(); if (s >= 1024) return;
    const unsigned h1 = hash32(s + 1234 + l); const int m = h1 % M, b = m >> 11; const float* ada = (const float*)(a.ws() + WS_ADA) + ((size_t)l * 16 + b) * 6144;
    if (s < 768) { const int col = hash32(h1) % D; const float ref = xin[(size_t)m * D + col] * (1.f + ada[1024 + col]) + ada[col];
        chk_rec(a, stage, relerr(bf2f(((const bf16_t*)(a.ws() + WS_H))[(size_t)m * D + col]), ref, 0.05f)); }
    else { const int j = s & 7; float acc = 0.f;
        for (int k = 0; k < D; ++k) acc += (xin[(size_t)m * D + k] * (1.f + ada[1024 + k]) + ada[k]) * a.in(I_WIN)[((size_t)l * D + k) * DIN + 1536 + j];
        const float x = acc + a.in(I_BF)[l * 8 + j], ref = fminf(x, 0.f) - log1pf(expf(-fabsf(x)));
        chk_rec(a, stage, relerr(((const float*)(a.ws() + WS_LOGF))[(size_t)m * 8 + j], ref, 0.01f)); }
}
__device__ __forceinline__ void chk_inproj(const AR a, int l, int stage) {
    const int s = CHK_GT(); if (s >= 4096) return;
    const unsigned h1 = hash32(s + 999 + l), h2 = hash32(h1); const int m = h1 % M, n = h2 % 8192;
    const bf16_t* H = (const bf16_t*)(a.ws() + WS_H) + (size_t)m * D; const bf16_t* W = (const bf16_t*)(a.ws() + WS_W + (size_t)l * WL_SIZE + WL_IN) + (size_t)n * D;
    float acc = 0.f; for (int k = 0; k < D; ++k) acc += bf2f(H[k]) * bf2f(W[k]);
    if (n < 512 || (n >= 1536 && n < 2048)) acc *= C2;
    if (n >= 5120) { acc += a.in(I_BGATE)[l * 3072 + n - 5120]; acc = 1.f / (1.f + expf(-acc)); }
    chk_rec(a, stage, relerr(bf2f(((const bf16_t*)(a.ws() + WS_Z))[(size_t)m * ZP + n]), acc, 0.05f));
}
__device__ __forceinline__ void chk_f2(const AR a, int stage) {
    const int s = CHK_GT(); if (s >= 256) return;
    const unsigned h1 = hash32(s + 555); const int bh = s & 127, t = h1 % SEQ, b = bh >> 3, h = bh & 7; float acc = 0.f;
    for (int i = 0; i <= t; ++i) acc += ((const float*)(a.ws() + WS_LOGF))[((size_t)b * SEQ + i) * 8 + h];
    chk_rec(a, stage, relerr(((const float*)(a.ws() + WS_F2))[(size_t)bh * SEQ + t], acc * LOG2E, 0.05f));
}
__device__ __forceinline__ void chk_lru(const AR a, int l, int stage) {
    const int gt = CHK_GT(), s = gt >> 6, c = gt & 63; if (s >= 128) return;
    const unsigned h1 = hash32(s + 4242 + l), h2 = hash32(h1), h3 = hash32(h2);
    const int b = h1 % BATCH, ch = h2 % D, n = ch >> 6, d = ch & 63, tend = (s < 6) ? (s == 0 ? 2047 : h3 % SEQ) : (s < 40 ? h3 % 40 : h3 % 400);
    const bf16_t* Z = (const bf16_t*)(a.ws() + WS_Z);
    const float* cw = a.in(I_CONVW) + (size_t)l * 4 * D; const float* cb = a.in(I_CONVB) + (size_t)l * D;
    const float* wa = a.in(I_WA) + ((size_t)l * 16 + n) * 4096; const float* wx = a.in(I_WX) + ((size_t)l * 16 + n) * 4096;
    const float lam = a.in(I_LAM)[l * D + ch]; const float cl = -8.f * (fmaxf(-lam, 0.f) + log1pf(expf(-fabsf(lam))));
    const int cc = n * 64 + c; const float wac = rbf(wa[c * 64 + d]), wxc = rbf(wx[c * 64 + d]);
    const float cw0 = cw[cc], cw1 = cw[D + cc], cw2 = cw[2 * D + cc], cw3 = cw[3 * D + cc], cbc = cb[cc];
    const float bac = a.in(I_BA)[l * D + ch], bxc = a.in(I_BX)[l * D + ch];
    float hst = 0.f, x0 = 0.f, x1 = 0.f, x2 = 0.f;
    for (int t = 0; t <= tend; ++t) { const float x3 = bf2f(Z[((size_t)b * SEQ + t) * ZP + ZC_XC + cc]);
        const float xc = cbc + cw0 * x0 + cw1 * x1 + cw2 * x2 + cw3 * x3; x0 = x1; x1 = x2; x2 = x3;
        const float xb = rbf(xc); const float ra = wave_sum(xb * wac), rx = wave_sum(xb * wxc), xme = __shfl(xc, d);
        const float rg = 1.f / (1.f + expf(-(ra + bac))), ig = 1.f / (1.f + expf(-(rx + bxc)));
        const float la = cl * rg, aa = expf(la); hst = aa * hst + sqrtf(-expm1f(2.f * la)) * (ig * xme); }
    const float g = bf2f(Z[((size_t)b * SEQ + tend) * ZP + ZC_GC + ch]);
    const float ref = hst * (0.5f * g * (1.f + tanhf(0.7978845608f * (g + 0.044715f * g * g * g))));
    if (c == 0) chk_rec(a, stage, relerr(bf2f(((const bf16_t*)(a.ws() + WS_O))[((size_t)b * SEQ + tend) * OP + 1024 + ch]), ref, 0.02f));
}
template <int MODE> __device__ __forceinline__ void chk_attn(const AR a, int stage) {
    const int gt = CHK_GT(), s = gt >> 6, e = gt & 63; if (s >= 256) return;
    const unsigned h1 = hash32(s + 31337 + MODE), h2 = hash32(h1), h3 = hash32(h2);
    const int b = h1 % BATCH, h = h2 % 8, d = h3 % 64, t = (s < 8) ? ((s == 0) ? 0 : (s == 1 ? 1 : (s == 2 ? 2047 : hash32(h3) % SEQ))) : hash32(h3) % SEQ;
    const bf16_t* Z = (const bf16_t*)(a.ws() + WS_Z); const size_t rb = (size_t)b * SEQ;
    const int qc = (MODE == 0 ? ZC_QA : ZC_QB) + h * 64, kc = (MODE == 0 ? ZC_KA : ZC_KB) + h * 64, vc = (MODE == 0 ? ZC_VA : ZC_VB) + h * 64;
    const float* F2 = (const float*)(a.ws() + WS_F2) + (size_t)(b * 8 + h) * SEQ;
    const float qe = bf2f(Z[(rb + t) * ZP + qc + e]);
    float ref = 0.f;
    if (MODE == 0) { float mx = -INFINITY, sum = 0.f, o = 0.f;
        for (int k = 0; k <= t; ++k) { const float z = wave_sum(qe * bf2f(Z[(rb + k) * ZP + kc + e])) + (F2[t] - F2[k]);
            const float mn = fmaxf(mx, z), al = exp2f(mx - mn), p = exp2f(z - mn); sum = sum * al + p; o = o * al + p * bf2f(Z[(rb + k) * ZP + vc + d]); mx = mn; }
        ref = o / sum;
    } else { float R = 0.f, o = 0.f;
        for (int k = t - 1; k >= 0; --k) { const float z = wave_sum(qe * bf2f(Z[(rb + k) * ZP + kc + e]));
            const float sp = fmaxf(z, 0.f) + log2f(1.f + exp2f(-fabsf(z))); o += exp2f(z - sp + R) * bf2f(Z[(rb + k) * ZP + vc + d]); R -= sp; if (R < -200.f) break; }
        ref = o; }
    if (e == 0) chk_rec(a, stage, relerr(bf2f(((const bf16_t*)(a.ws() + WS_O))[(rb + t) * OP + (MODE == 0 ? 0 : 512) + h * 64 + d]), ref, 0.15f));
}
__device__ __forceinline__ void chk_merge(const AR a, int l, int stage) {
    const int s = CHK_GT(); if (s >= 2048) return;
    const unsigned h1 = hash32(s + 808 + l), h2 = hash32(h1); const int m = h1 % M, c = h2 % D;
    const bf16_t* O = (const bf16_t*)(a.ws() + WS_O) + (size_t)m * OP; const bf16_t* W = (const bf16_t*)(a.ws() + WS_W + (size_t)l * WL_SIZE + WL_P) + (size_t)c * OP; const bf16_t* Z = (const bf16_t*)(a.ws() + WS_Z) + (size_t)m * ZP;
    float tot = 0.f;
    for (int seg = 0; seg < 3; ++seg) { const int k0 = seg == 0 ? 0 : (seg == 1 ? 512 : 1024), k1 = seg == 0 ? 512 : (seg == 1 ? 1024 : 2048); float acc = 0.f;
        for (int k = k0; k < k1; ++k) acc += bf2f(O[k]) * bf2f(W[k]); tot += acc * bf2f(Z[ZC_G + seg * 1024 + c]); }
    chk_rec(a, stage, relerr(bf2f(((const bf16_t*)(a.ws() + WS_MG))[(size_t)m * D + c]), tot, 0.05f));
}
__device__ __forceinline__ void chk_wo(const AR a, int l, int stage) {
    const int s = CHK_GT(); if (s >= 2048) return;
    const unsigned h1 = hash32(s + 909 + l), h2 = hash32(h1); const int m = h1 % M, c = h2 % D;
    const bf16_t* A = (const bf16_t*)(a.ws() + WS_MG) + (size_t)m * D; const bf16_t* W = (const bf16_t*)(a.ws() + WS_W + (size_t)l * WL_SIZE + WL_O) + (size_t)c * D;
    float acc = 0.f; for (int k = 0; k < D; ++k) acc += bf2f(A[k]) * bf2f(W[k]);
    chk_rec(a, stage, relerr(((const float*)(a.ws() + WS_Y))[(size_t)m * D + c], acc, 0.02f));
}
__device__ __forceinline__ void chk_ln1(const AR a, int l, const float* xin, int stage) {
    const int s = CHK_GT(); if (s >= 256) return;
    const int m = hash32(s + 1717 + l) % M, b = m >> 11; const float* ada = (const float*)(a.ws() + WS_ADA) + ((size_t)l * 16 + b) * 6144;
    const float* Y = (const float*)(a.ws() + WS_Y) + (size_t)m * D; const float* X = xin + (size_t)m * D;
    float mean = 0.f; for (int k = 0; k < D; ++k) mean += DN_ALPHA * X[k] + (1.f + ada[2048 + k]) * Y[k]; mean /= D;
    float var = 0.f; for (int k = 0; k < D; ++k) { const float v = DN_ALPHA * X[k] + (1.f + ada[2048 + k]) * Y[k] - mean; var += v * v; } var /= D;
    const float rstd = 1.f / sqrtf(var + LN_EPS);
    float e1 = 0.f, e2 = 0.f;
    for (int k = (s & 63); k < D; k += 64) { const float x1 = (DN_ALPHA * X[k] + (1.f + ada[2048 + k]) * Y[k] - mean) * rstd * a.in(I_LN1G)[l * D + k] + a.in(I_LN1B)[l * D + k];
        const float h2 = x1 * (1.f + ada[4096 + k]) + ada[3072 + k];
        e1 = fmaxf(e1, relerr(((const float*)(a.ws() + WS_X1))[(size_t)m * D + k], x1, 0.02f)); e2 = fmaxf(e2, relerr(bf2f(((const bf16_t*)(a.ws() + WS_H))[(size_t)m * D + k]), h2, 0.05f)); }
    chk_rec(a, stage, e1); chk_rec(a, stage, e2);
    const int* tok_er = (const int*)(a.ws() + WS_TOKER); const float* gates = (const float*)(a.ws() + WS_GATE);
    const int r0 = tok_er[m * 4 + 0] >> 15, r1 = tok_er[m * 4 + 1] >> 15, r2 = tok_er[m * 4 + 2] >> 15, r3 = tok_er[m * 4 + 3] >> 15;
    float v0 = -INFINITY, v1 = -INFINITY, v2 = -INFINITY, v3 = -INFINITY; int i0 = 0, i1 = 0, i2 = 0, i3 = 0; float lr0 = 0.f, lr1 = 0.f, lr2 = 0.f, lr3 = 0.f;
    for (int e = 0; e < 32; ++e) { float x = a.in(I_BR)[l * 32 + e];
        for (int k = 0; k < D; ++k) { const float x1 = (DN_ALPHA * X[k] + (1.f + ada[2048 + k]) * Y[k] - mean) * rstd * a.in(I_LN1G)[l * D + k] + a.in(I_LN1B)[l * D + k];
            x += (x1 * (1.f + ada[4096 + k]) + ada[3072 + k]) * a.in(I_WR)[((size_t)l * D + k) * 32 + e]; }
        if (e == r0) lr0 = x; if (e == r1) lr1 = x; if (e == r2) lr2 = x; if (e == r3) lr3 = x;
        if (x > v3) { if (x > v2) { v3 = v2; i3 = i2; if (x > v1) { v2 = v1; i2 = i1; if (x > v0) { v1 = v0; i1 = i0; v0 = x; i0 = e; } else { v1 = x; i1 = e; } } else { v2 = x; i2 = e; } } else { v3 = x; i3 = e; } } }
    float worst = 0.f;
    { const float den = 1.f + expf(v1 - v0) + expf(v2 - v0) + expf(v3 - v0);
      const float lrs[4] = {lr0, lr1, lr2, lr3}; const int rs[4] = {r0, r1, r2, r3};
#pragma unroll
      for (int k = 0; k < 4; ++k) { const bool found = (rs[k] == i0) || (rs[k] == i1) || (rs[k] == i2) || (rs[k] == i3);
          if (found) worst = fmaxf(worst, fabsf(gates[m * 4 + k] - expf(lrs[k] - v0) / den)); else worst = fmaxf(worst, (fabsf(lrs[k] - v3) > 1e-3f) ? 10.f : 0.f); }
      if (r0 == r1 || r0 == r2 || r0 == r3 || r1 == r2 || r1 == r3 || r2 == r3) worst = 15.f; }
    chk_rec(a, stage + 1, worst);
    for (int k = 0; k < 4; ++k) { const int er = tok_er[m * 4 + k], e = er >> 15, rank = er & (ECAP - 1);
        const int cnt = (int)__hip_atomic_load((gu32*)(a.ws() + WS_CTL) + CW_GCNT + (l * 32 + e) * 64, RLX_AGENT);
        if (rank >= cnt || ((const int*)(a.ws() + WS_SLOTTOK))[(size_t)e * ECAP + rank] != m) chk_rec(a, stage + 1, 20.f); }
    if (s == 0) { int tot = 0; for (int e = 0; e < 32; ++e) tot += (int)__hip_atomic_load((gu32*)(a.ws() + WS_CTL) + CW_GCNT + (l * 32 + e) * 64, RLX_AGENT); if (tot != M * 4) chk_rec(a, stage + 1, 30.f); }
}
__device__ __forceinline__ void chk_gemm1(const AR a, int l, const LAS int* bs, int stage) {
    const int s = CHK_GT(); if (s >= 2048) return;
    const unsigned h1 = hash32(s + 2121 + l), h2 = hash32(h1); const int tok = h1 % M, k = h2 & 3, j = (h2 >> 2) % D;
    const int er = ((const int*)(a.ws() + WS_TOKER))[tok * 4 + k], e = er >> 15, rank = er & (ECAP - 1); const size_t cs = (size_t)bs[e] * 256 + rank;
    const bf16_t* H = (const bf16_t*)(a.ws() + WS_H) + (size_t)tok * D; const bf16_t* Wg = (const bf16_t*)(a.ws() + WS_W + (size_t)l * WL_SIZE + WL_GU) + ((size_t)e * 2048 + 256 * (j >> 7) + (j & 127)) * D; const bf16_t* Wu = Wg + 128 * D;
    float ga = 0.f, up = 0.f; for (int q = 0; q < D; ++q) { const float hv = bf2f(H[q]); ga += hv * bf2f(Wg[q]); up += hv * bf2f(Wu[q]); }
    ga += a.in(I_BGU)[((size_t)l * 32 + e) * 2048 + j]; up += a.in(I_BGU)[((size_t)l * 32 + e) * 2048 + 1024 + j];
    ga = fminf(ga, 7.f); up = fminf(fmaxf(up, -7.f), 7.f); const float ref = (up + 1.f) * (ga / (1.f + expf(-1.702f * ga)));
    chk_rec(a, stage, relerr(bf2f(((const bf16_t*)(a.ws() + WS_ACT))[cs * D + j]), ref, 0.05f));
}
__device__ __forceinline__ void chk_gemm2(const AR a, int l, const LAS int* bs, int stage) {
    const int s = CHK_GT(); if (s >= 2048) return;
    const unsigned h1 = hash32(s + 2323 + l), h2 = hash32(h1); const int tok = h1 % M, k = h2 & 3, c = (h2 >> 2) % D;
    const int er = ((const int*)(a.ws() + WS_TOKER))[tok * 4 + k], e = er >> 15, rank = er & (ECAP - 1); const size_t cs = (size_t)bs[e] * 256 + rank;
    const bf16_t* A = (const bf16_t*)(a.ws() + WS_ACT) + cs * D; const bf16_t* W = (const bf16_t*)(a.ws() + WS_W + (size_t)l * WL_SIZE + WL_DN) + ((size_t)e * 1024 + c) * D;
    float acc = 0.f; for (int q = 0; q < D; ++q) acc += bf2f(A[q]) * bf2f(W[q]); acc += a.in(I_BDN)[((size_t)l * 32 + e) * D + c];
    chk_rec(a, stage, relerr(bf2f(((const bf16_t*)(a.ws() + WS_YB))[cs * D + c]), acc, 0.05f));
}
__device__ __forceinline__ void chk_ln2(const AR a, int l, const float* xout, const LAS int* bs, int stage) {
    const int s = CHK_GT(); if (s >= 256) return;
    const int m = hash32(s + 2525 + l) % M, b = m >> 11; const float* ada = (const float*)(a.ws() + WS_ADA) + ((size_t)l * 16 + b) * 6144;
    const float* X1 = (const float*)(a.ws() + WS_X1) + (size_t)m * D; const bf16_t* YB = (const bf16_t*)(a.ws() + WS_YB);
    const bf16_t* yr[4]; float g[4];
#pragma unroll
    for (int k = 0; k < 4; ++k) { const int er = ((const int*)(a.ws() + WS_TOKER))[m * 4 + k], e = er >> 15, rank = er & (ECAP - 1); yr[k] = YB + ((size_t)bs[e] * 256 + rank) * D; g[k] = ((const float*)(a.ws() + WS_GATE))[m * 4 + k]; }
    float mean = 0.f, var = 0.f;
    for (int q = 0; q < D; ++q) { float y = g[0] * bf2f(yr[0][q]) + g[1] * bf2f(yr[1][q]) + g[2] * bf2f(yr[2][q]) + g[3] * bf2f(yr[3][q]); mean += DN_ALPHA * X1[q] + (1.f + ada[5120 + q]) * y; } mean /= D;
    for (int q = 0; q < D; ++q) { float y = g[0] * bf2f(yr[0][q]) + g[1] * bf2f(yr[1][q]) + g[2] * bf2f(yr[2][q]) + g[3] * bf2f(yr[3][q]); const float v = DN_ALPHA * X1[q] + (1.f + ada[5120 + q]) * y - mean; var += v * v; } var /= D;
    const float rstd = 1.f / sqrtf(var + LN_EPS); float worst = 0.f;
    for (int q = (s & 31); q < D; q += 32) { float y = g[0] * bf2f(yr[0][q]) + g[1] * bf2f(yr[1][q]) + g[2] * bf2f(yr[2][q]) + g[3] * bf2f(yr[3][q]);
        const float ref = (DN_ALPHA * X1[q] + (1.f + ada[5120 + q]) * y - mean) * rstd * a.in(I_LN2G)[l * D + q] + a.in(I_LN2B)[l * D + q];
        worst = fmaxf(worst, relerr(xout[(size_t)m * D + q], ref, 0.02f)); }
    chk_rec(a, stage, worst);
}
__device__ __forceinline__ void chk_report(const AR a) {
    if (blockIdx.x != 0 || threadIdx.x != 0) return;
    const unsigned* w = (const unsigned*)(a.ws() + WS_CTL) + CW_CHK;
    const unsigned tmo = __hip_atomic_load((gu32*)(a.ws() + WS_CTL) + CW_BAR + XB_TMO, RLX_AGENT);
    if (tmo) { a.out()[0] = 9.9e7f; return; }
#ifdef CHK_REPORT_STAGE
    { const float e = __uint_as_float(__hip_atomic_load((gu32*)w + CHK_REPORT_STAGE, RLX_AGENT)); a.out()[0] = 1e5f * e + 100.f; return; }
#endif
    for (int st = 0; st < 32; ++st) { const float e = __uint_as_float(__hip_atomic_load((gu32*)w + st, RLX_AGENT));
        if (e > 0.02f) { const float sc = e < 0.1f ? 1e3f : (e < 1.f ? 1e4f : (e < 100.f ? 1e5f : 1e6f)); a.out()[0] = (10.f + st) * sc; return; } }
}
#endif

#if CHK
#define CHECK(stmt) do { PHASE_IDS(); stmt; } while (0)
#else
#define CHECK(stmt) do { } while (0)
#endif
#define PHASE_IDS() int tid_o = threadIdx.x; asm volatile("" : "+v"(tid_o)); const int tid = tid_o, lane = tid & 63, wave = __builtin_amdgcn_readfirstlane(tid >> 6); const int gw = vcu * 8 + wave; \
    AR a; { ArgsP q_ = a0.p; asm volatile("" : "+s"(q_)); a.p = q_; } int l_o = ll; asm volatile("" : "+s"(l_o)); const int l = l_o; (void)gw; (void)lane; (void)tid; (void)l
__global__ void __launch_bounds__(512, 2) fwd_kernel(Args args_unused) {
    extern __shared__ __attribute__((aligned(16))) unsigned char lds_raw[];
    LAS unsigned char* lds = (LAS unsigned char*)lds_raw;
    AR a0; a0.p = (ArgsP)__builtin_amdgcn_kernarg_segment_ptr();
    const int G = gridDim.x, bx = blockIdx.x, vcu = (G % 8 == 0) ? (bx % 8) * (G / 8) + bx / 8 : bx;
    const int NGW = G * 8;
    const int ll = 0;
    { const int tid = threadIdx.x;
      for (int u = tid; u < (LDS_BYTES - MISC_OFF) / 4; u += 512) ((LAS unsigned*)(lds + MISC_OFF))[u] = 0u; }
    __syncthreads();
    (void)xcd_barrier_post((unsigned*)(a0.ws() + WS_CTL) + CW_BAR, (volatile LAS unsigned*)(lds + MISC_OFF + MO_BAR));
#define GRID_BAR() do { ArgsP q_ = a0.p; asm volatile("" : "+s"(q_)); XcdBarrier b_; b_.bar = (unsigned*)(q_->ws + WS_CTL) + CW_BAR; b_.x = xb_xcc_id(); b_.st = (volatile LAS unsigned*)(lds + MISC_OFF + MO_BAR); xcd_barrier(b_); } while (0)

    { PHASE_IDS();
      p0_weights(a, lds, gw, NGW, wave, lane);
      __syncthreads();
      if (bx < 192) p0_ada(a, lds, bx, tid, wave, lane); }
    GRID_BAR();
    CHECK(chk_weights(a); chk_ada(a));
    { PHASE_IDS();
      stage_wf(a, 0, lds, tid); __syncthreads();
      const float* X = a.in(I_X);
      for (int m = gw; m < M; m += NGW) { f32x4 x[4];
#pragma unroll
          for (int j = 0; j < 4; ++j) x[j] = *(const f32x4*)(X + (size_t)m * D + 4 * lane + 256 * j);
          prep_row(a, 0, m, x, (const LAS float*)lds, lane); } }
    GRID_BAR();
#pragma unroll 1
    for (int ll = 0; ll < DEPTH; ++ll) {
        const int cs = 16 * ll;
        CHECK(chk_prep(a, l, (l == 0) ? a.in(I_X) : (const float*)(a.ws() + WS_XL), cs + 2));
        if (CHK_STOP <= 2) break;
        { PHASE_IDS(); const unsigned char* wl = a.ws() + WS_W + (size_t)l * WL_SIZE;
          DenseOrder S; S.T.init(M / 256, 32, G, bx); S.A = (const char*)(a.ws() + WS_H); S.B = (const char*)(wl + WL_IN); S.lda = 1024; S.ldb = 1024; S.nt = 16;
          EpiInProj E{(bf16_t*)(a.ws() + WS_Z), a.in(I_BGATE) + (size_t)l * 3072};
          pg8::gemm_phase<EpiInProj, DenseOrder, false>(lds, 1024, 1024, S, E); }
        GRID_BAR();
        CHECK(chk_inproj(a, l, cs + 3));
        if (CHK_STOP <= 3) break;
        { PHASE_IDS();
          if (gw < 128) fcumsum_wave(a, gw, lane);
          for (int u = vcu; u < 256; u += G) lru_unit(a, l, u >> 4, u & 15, lds, tid, wave, lane); }
        GRID_BAR();
        CHECK(chk_f2(a, cs + 4); chk_lru(a, l, cs + 5));
        if (CHK_STOP <= 5) break;
        { PHASE_IDS();
          for (int u = vcu; u < 256; u += G) { const int bh = u >> 1, s = u & 1;
#pragma unroll 1
            for (int i = 0; i < 4; ++i) { const int qb = (i == 0) ? s : (i == 1 ? 7 - s : (i == 2 ? 2 + s : 5 - s)); attn_unit<0>(a, bh >> 3, bh & 7, qb, lds, tid, wave, lane); } } }
        { PHASE_IDS();
          for (int u = vcu; u < 256; u += G) { const int bh = u >> 1, s = u & 1;
#pragma unroll 1
            for (int i = 0; i < 4; ++i) { const int qb = (i == 0) ? s : (i == 1 ? 7 - s : (i == 2 ? 2 + s : 5 - s)); attn_unit<1>(a, bh >> 3, bh & 7, qb, lds, tid, wave, lane); } } }
        GRID_BAR();
        CHECK(chk_attn<0>(a, cs + 6); chk_attn<1>(a, cs + 7));
        if (CHK_STOP <= 7) break;
        { PHASE_IDS(); const unsigned char* wl = a.ws() + WS_W + (size_t)l * WL_SIZE;
          MergeOrder S; S.T.init(M / 256, 4, G, bx); S.A = (const char*)(a.ws() + WS_O); S.B = (const char*)(wl + WL_P);
          EpiMerge E{(const bf16_t*)(a.ws() + WS_Z), (float*)(a.ws() + WS_MB), (bf16_t*)(a.ws() + WS_MG)};
          pg8::gemm_phase<EpiMerge, MergeOrder, false>(lds, OP, OP, S, E); }
        GRID_BAR();
        CHECK(chk_merge(a, l, cs + 8));
        { PHASE_IDS(); const unsigned char* wl = a.ws() + WS_W + (size_t)l * WL_SIZE;
          DenseOrder S; S.T.init(M / 256, 4, G, bx); S.A = (const char*)(a.ws() + WS_MG); S.B = (const char*)(wl + WL_O); S.lda = 1024; S.ldb = 1024; S.nt = 16;
          EpiF32 E{(float*)(a.ws() + WS_Y), D};
          pg8::gemm_phase<EpiF32, DenseOrder, false>(lds, 1024, 1024, S, E); }
        GRID_BAR();
        CHECK(chk_wo(a, l, cs + 9));
        if (CHK_STOP <= 9) break;
        { PHASE_IDS(); const float* xin = (l == 0) ? a.in(I_X) : (const float*)(a.ws() + WS_XL);
          for (int u = vcu; u < 256; u += G) ln1_phase(a, l, xin, lds, u, tid, wave, lane); }
        GRID_BAR();
        CHECK(chk_ln1(a, l, (l == 0) ? a.in(I_X) : (const float*)(a.ws() + WS_XL), cs + 10));
        if (CHK_STOP <= 11) break;
        { PHASE_IDS(); const unsigned char* wl = a.ws() + WS_W + (size_t)l * WL_SIZE;
          moe_build_tables((gu32*)(a.ws() + WS_CTL), l, lds, tid);
          MoeOrder<8, true> S{vcu, moe_tables(lds), (const char*)(a.ws() + WS_H), (const char*)(wl + WL_GU), (const int*)(a.ws() + WS_SLOTTOK)};
          EpiGU E{(bf16_t*)(a.ws() + WS_ACT), a.in(I_BGU) + (size_t)l * NEXP * 2048};
          pg8::gemm_phase<EpiGU, MoeOrder<8, true>, true>(lds, 1024, 1024, S, E); }
        GRID_BAR();
        CHECK(chk_gemm1(a, l, (const LAS int*)(lds + MISC_OFF + MO_BS), cs + 12));
        { PHASE_IDS(); const unsigned char* wl = a.ws() + WS_W + (size_t)l * WL_SIZE;
          MoeOrder<4, false> S{vcu, moe_tables(lds), (const char*)(a.ws() + WS_ACT), (const char*)(wl + WL_DN), nullptr};
          EpiDown E{(bf16_t*)(a.ws() + WS_YB), a.in(I_BDN) + (size_t)l * NEXP * D};
          pg8::gemm_phase<EpiDown, MoeOrder<4, false>, false>(lds, 1024, 1024, S, E); }
        GRID_BAR();
        CHECK(chk_gemm2(a, l, (const LAS int*)(lds + MISC_OFF + MO_BS), cs + 13));
        if (CHK_STOP <= 13) break;
        { PHASE_IDS(); float* xout = (l == DEPTH - 1) ? a.out() : (float*)(a.ws() + WS_XL);
          if (l + 1 < DEPTH) stage_wf(a, l + 1, lds, tid);
          __syncthreads();
          ln2_phase(a, l, xout, lds, gw, NGW, lane, l + 1 < DEPTH); }
        if (ll + 1 < DEPTH || CHK) GRID_BAR();
        CHECK(chk_ln2(a, l, (l == DEPTH - 1) ? a.out() : (float*)(a.ws() + WS_XL), (const LAS int*)(lds + MISC_OFF + MO_BS), cs + 14));
    }
#if CHK
    GRID_BAR();
    chk_report(a0);
#endif
}

extern "C" void kernel_launch(void* const* d_in, const int* in_sizes, int n_in, void* d_out, int out_size, void* d_ws, size_t ws_size, hipStream_t stream) {
    static int grid = 0;
    if (grid == 0) {
        if (n_in != 29 || out_size != M * D || ws_size < WS_END) { fprintf(stderr, "kernel_launch: unexpected sizes n_in %d out %d ws %zu\n", n_in, out_size, ws_size); grid = -1; return; }
        if (hipFuncSetAttribute((const void*)fwd_kernel, hipFuncAttributeMaxDynamicSharedMemorySize, LDS_BYTES) != hipSuccess) { fprintf(stderr, "kernel_launch: hipFuncSetAttribute failed\n"); grid = -1; return; }
        int dev = 0, cus = 0, per_cu = 0;
        (void)hipGetDevice(&dev); (void)hipDeviceGetAttribute(&cus, hipDeviceAttributeMultiprocessorCount, dev);
        if (hipOccupancyMaxActiveBlocksPerMultiprocessor(&per_cu, (const void*)fwd_kernel, 512, LDS_BYTES) != hipSuccess || per_cu < 1) fprintf(stderr, "kernel_launch: occupancy query says %d\n", per_cu);
        (void)hipGetLastError();
        grid = cus < 256 ? cus : 256;
    }
    if (grid < 0) return;
    (void)hipMemsetAsync((char*)d_ws + WS_CTL, 0, CTL_ZERO_BYTES, stream);
    Args a{};
    for (int i = 0; i < 29; ++i) a.in[i] = (const float*)d_in[i];
    a.out = (float*)d_out; a.ws = (unsigned char*)d_ws;
    hipLaunchKernelGGL(fwd_kernel, dim3(grid), dim3(512), LDS_BYTES, stream, a);
}
```

```cpp
#define CHK 0
#define CHK_STOP 99
#include <hip/hip_runtime.h>
#include <cstdio>
#include <cstdint>

#ifndef CHK
#define CHK 0
#endif
#ifndef STAMP
#define STAMP 0
#endif
#ifndef CHK_STOP
#define CHK_STOP 99
#endif

#ifndef FP8_MOE
#define FP8_MOE 1
#endif
#ifndef COL_AUX
#define COL_AUX 1
#endif
#ifndef WIDE_ST
#define WIDE_ST 1
#endif
#ifndef FP8_MRG
#define FP8_MRG 1
#endif
#ifndef FP8_G
#define FP8_G 1
#endif
#ifndef FP8_YB
#define FP8_YB 1
#endif
#ifndef FP8_IN
#define FP8_IN 2
#endif
#define LAS __attribute__((address_space(3)))
#define GAS __attribute__((address_space(1)))
typedef unsigned short bf16_t;
typedef short bf16x8 __attribute__((ext_vector_type(8)));
typedef int i32x8 __attribute__((ext_vector_type(8)));
typedef int i32x4v __attribute__((ext_vector_type(4)));
typedef short s16x4 __attribute__((ext_vector_type(4)));
typedef float f32x4 __attribute__((ext_vector_type(4)));
typedef float f32x2 __attribute__((ext_vector_type(2)));
typedef float f32x16 __attribute__((ext_vector_type(16)));
typedef unsigned u32x4 __attribute__((ext_vector_type(4)));
typedef unsigned u32x2 __attribute__((ext_vector_type(2)));
typedef GAS unsigned gu32;

constexpr int D = 1024, BATCH = 16, SEQ = 2048, M = BATCH * SEQ, DEPTH = 2;
constexpr int NEXP = 32, TOPK = 4, DIN = 5128;
constexpr int ZP = 8192;
constexpr int ZC_QA = 0, ZC_KA = 512, ZC_VA = 1024, ZC_QB = 1536, ZC_KB = 2048, ZC_VB = 2560, ZC_XC = 3072, ZC_GC = 4096, ZC_G = 5120;
constexpr int OP = 2048;
constexpr float LN_EPS = 1e-5f;
constexpr float DN_ALPHA = 1.41421356237f;
constexpr float LOG2E = 1.4426950408889634f;
constexpr float C2 = 0.125f * 1.4426950408889634f;
constexpr int MAXBLK = M * TOPK / 256 + NEXP;
constexpr int ECAP = 32768;

constexpr size_t MiB = 1u << 20;
constexpr size_t WS_CTL = 0, CTL_ZERO_BYTES = 1 * MiB;
constexpr size_t WS_ADA = 1 * MiB;
constexpr size_t WS_ONES = 1 * MiB + 800 * 1024;
constexpr size_t WS_LOGF = 2 * MiB;
constexpr size_t WS_F2 = 3 * MiB;
constexpr size_t WS_TOKER = 4 * MiB;
constexpr size_t WS_GATE = 4 * MiB + 512 * 1024;
constexpr size_t WS_SLOTTOK = 5 * MiB;
constexpr size_t WS_W = 16 * MiB;
constexpr size_t WL_IN = 0, WL_P = 16 * MiB, WL_O = 20 * MiB, WL_GU = 22 * MiB, WL_DN = 150 * MiB, WL_SIZE = 214 * MiB;
constexpr float Q_H1 = 8.0f, Q_WIN = 256.0f;
constexpr float Q_YB = 16.0f;
constexpr float Q_O = 8.0f, Q_WP = 256.0f;
constexpr float Q_H2 = 8.0f, Q_WGU = 256.0f, Q_ACT = 8.0f, Q_WDN = 512.0f;
constexpr size_t WS_G8 = 1153 * MiB;
constexpr float Q_G = 255.0f;
constexpr size_t WS_ROWS = 1152 * MiB;
constexpr size_t WS_H = 448 * MiB;
constexpr size_t WS_Z = 512 * MiB;
constexpr size_t WS_ACT = 512 * MiB;
constexpr size_t WS_O = 1024 * MiB;
constexpr size_t WS_MB = 1152 * MiB;
constexpr size_t WS_MG = 1280 * MiB;
constexpr size_t WS_Y = 1344 * MiB;
constexpr size_t WS_X1 = 1472 * MiB;
constexpr size_t WS_XL = 1600 * MiB;
constexpr size_t WS_YB = 1728 * MiB;
constexpr size_t WS_END = 2000 * MiB;
static_assert((size_t)MAXBLK * 256 * 1024 * 2 <= 272 * MiB, "act / y_buf size");

constexpr int CW_TMO = 0, CW_CODE = 1;
constexpr int CW_BAR = 4096;
constexpr int CW_GCNT = 8192;
constexpr int CW_WMAX = 32768;
constexpr int CW_CHK = 16384;

constexpr int RING_BYTES = 131072;
constexpr int MISC_OFF = RING_BYTES;
constexpr int LDS_BYTES = 147456;
constexpr int MO_BAR = 14336;
constexpr int MO_CNT = 64;
constexpr int MO_BS = 64 + 128;
constexpr int MO_BE = 64 + 128 + 136;
constexpr int MO_LCNT = 1024;
constexpr int MO_LBASE = 1024 + 128;
constexpr int MO_REC = 2048;
constexpr int MO_GT = 4096;
constexpr int MO_LG = 6144;
constexpr int MO_CAR = 2048;

namespace pg8 {
constexpr int BM = 256, BK = 64, HALF = 128, HTB = HALF * BK * 2, STAGE_BYTES = 8 * HTB, NXCD = 8, WGM = 8;
__host__ __device__ __forceinline__ int lds_byte(int r, int c) { const int st = (r >> 4) * 2 + (c >> 5), rr = r & 15, cc = c & 31, ob = rr * 64 + cc * 2; return st * 1024 + (ob ^ (((ob >> 9) & 1) << 5)); }
__host__ __device__ __forceinline__ void stage_rc(int b, int& R, int& C) { const int st = b / 1024, sb = b % 1024, swz = sb ^ (((sb >> 9) & 1) << 5); R = (st >> 1) * 16 + swz / 64; C = (st & 1) * 32 + (swz % 64) / 2; }
__host__ __device__ __forceinline__ int perm32(int rho) { const int n = rho >> 4, i = rho & 15; return 8 * (i >> 2) + 4 * n + (i & 3); }

struct Unit { int pm, pn, aux; };

struct TileOrder {
    int nM, nN, nwg, G, c;
    __device__ __forceinline__ void init(int nM_, int nN_, int G_, int c_) { nM = nM_; nN = nN_; nwg = nM * nN; G = G_; c = c_; }
    __device__ __forceinline__ bool tile(int i, int& pm, int& pn) const {
        const long L = (long)i * G + c; if (L >= nwg) return false;
        int wgid = (int)L; { const int q = nwg / NXCD, r = nwg % NXCD, xcd = wgid % NXCD, off = wgid / NXCD; wgid = (xcd < r ? xcd * (q + 1) : r * (q + 1) + (xcd - r) * q) + off; }
        const int nig = WGM * nN, gid = wgid / nig, fm = gid * WGM, gsz = (nM - fm) < WGM ? (nM - fm) : WGM;
        pm = fm + ((wgid % nig) % gsz); pn = (wgid % nig) / gsz; return true;
    }
};

__device__ __forceinline__ unsigned cvt_pk_bf16(float lo, float hi) { unsigned r; asm volatile("v_cvt_pk_bf16_f32 %0, %1, %2" : "=v"(r) : "v"(lo), "v"(hi)); return r; }

template <class Epi, class Sched, bool GATHER>
__device__ __forceinline__ void gemm_phase(LAS unsigned char* lds, const int lda, const int ldb, const Sched& S, Epi& E, const int tid_in) {
    int tid_ = tid_in; asm volatile("" : "+v"(tid_));
    const int tid = tid_, wid = __builtin_amdgcn_readfirstlane(tid >> 6), lane = tid & 63, wr = wid >> 2, wc = wid & 3, fr = lane & 15, fq = lane >> 4;
    unsigned voffA[2], voffB[2]; int RR[2], CC[2];
#pragma unroll
    for (int i = 0; i < 2; ++i) { int R, C; stage_rc(tid * 16 + i * 8192, R, C); const int Rb = Epi::WIDE ? (64 * (R >> 5) + perm32(R & 31)) : (Epi::PERM ? ((R & ~31) + perm32(R & 31)) : R);
        RR[i] = R; CC[i] = C; voffA[i] = (unsigned)(R * lda + C) * 2u; voffB[i] = (unsigned)(Rb * ldb + C) * 2u; }
    const size_t kstep = (size_t)(BK * 2);
    const size_t hstepA = (size_t)HALF * lda * 2, hstepB = (size_t)(Epi::WIDE ? 32 : HALF) * ldb * 2;
    const unsigned ldsw = (unsigned)wid * 1024u;
    const int aoff = lds_byte(wr * 64 + fr, fq * 8), boff = lds_byte(wc * 32 + fr, fq * 8);
#define PG8_SA(b, h) (((b) * 2 + (h)) * HTB)
#define PG8_SB(b, h) ((4 + (b) * 2 + (h)) * HTB)
#define PG8_STG(bufoff, ptr, vo, _i) __builtin_amdgcn_global_load_lds((const unsigned*)((const char*)(ptr) + (vo)), (LAS unsigned*)(lds + (bufoff) + ldsw + (_i) * 8192), 16, 0, 0)
#define PG8_STAGE_B(bufoff, gbase) do { PG8_STG(bufoff, gbase, voffB[0], 0); PG8_STG(bufoff, gbase, voffB[1], 1); } while (0)
#define PG8_STAGE_A(bufoff, gbase, h, VG) do { if constexpr (GATHER) { PG8_STG(bufoff, gbase, VG[h][0], 0); PG8_STG(bufoff, gbase, VG[h][1], 1); } \
        else { PG8_STG(bufoff, (gbase) + (h) * hstepA, voffA[0], 0); PG8_STG(bufoff, (gbase) + (h) * hstepA, voffA[1], 1); } } while (0)
#define PG8_LDA(dst, b, h) do { _Pragma("unroll") for (int m = 0; m < 4; ++m) _Pragma("unroll") for (int k = 0; k < 2; ++k) dst[m][k] = *(const LAS bf16x8*)(lds + PG8_SA(b, h) + aoff + m * 2048 + k * 1024); } while (0)
#define PG8_LDB(dst, b, h) do { _Pragma("unroll") for (int n = 0; n < 2; ++n) _Pragma("unroll") for (int k = 0; k < 2; ++k) dst[n][k] = *(const LAS bf16x8*)(lds + PG8_SB(b, h) + boff + n * 2048 + k * 1024); } while (0)
#define PG8_F8CAT(x) __builtin_shufflevector(__builtin_bit_cast(i32x4v, x[0]), __builtin_bit_cast(i32x4v, x[1]), 0, 1, 2, 3, 4, 5, 6, 7)
#define PG8_MMA(ai, bj, At, Bt) do { __builtin_amdgcn_s_setprio(1); _Pragma("unroll") for (int m = 0; m < 4; ++m) _Pragma("unroll") for (int n = 0; n < 2; ++n) { \
        if constexpr (Epi::F8) asm volatile("v_mfma_f32_16x16x128_f8f6f4 %0, %1, %2, %0" : "+v"(acc[ai][bj][m][n]) : "v"(PG8_F8CAT(Bt[n])), "v"(PG8_F8CAT(At[m])));   \
        else if constexpr (Epi::I8) { _Pragma("unroll") for (int k = 0; k < 2; ++k) acc[ai][bj][m][n] = __builtin_bit_cast(f32x4, __builtin_amdgcn_mfma_i32_16x16x64_i8(__builtin_bit_cast(i32x4v, Bt[n][k]), __builtin_bit_cast(i32x4v, At[m][k]), __builtin_bit_cast(i32x4v, acc[ai][bj][m][n]), 0, 0, 0)); }   \
        else { _Pragma("unroll") for (int k = 0; k < 2; ++k) acc[ai][bj][m][n] = __builtin_amdgcn_mfma_f32_16x16x32_bf16(Bt[n][k], At[m][k], acc[ai][bj][m][n], 0, 0, 0); } } __builtin_amdgcn_s_setprio(0); } while (0)
#define PG8_WAIT_V(n) asm volatile("s_waitcnt vmcnt(" #n ")" ::: "memory")
#define PG8_WAIT_L(n) asm volatile("s_waitcnt lgkmcnt(" #n ")" ::: "memory")
#define PG8_BAR __builtin_amdgcn_s_barrier()
#define PG8_SCHED __builtin_amdgcn_sched_barrier(0)
    Unit cur, nxt; int ui = 0;
    if (!S.next(0, cur)) return;
    f32x4 acc[2][2][4][2];
#pragma unroll
    for (int a = 0; a < 2; ++a)
#pragma unroll
        for (int b = 0; b < 2; ++b)
#pragma unroll
            for (int m = 0; m < 4; ++m)
#pragma unroll
                for (int n = 0; n < 2; ++n) acc[a][b][m][n] = (f32x4){0.f, 0.f, 0.f, 0.f};
    bf16x8 At[4][2], B0[2][2], B1[2][2];
    const char* cA; const char* cB; int nt;
    S.operands(cur, cA, cB, nt);
    unsigned vgc[2][2] = {{0u, 0u}, {0u, 0u}}, vgn[2][2] = {{0u, 0u}, {0u, 0u}};
    LAS unsigned* gbuf = (LAS unsigned*)(lds + 131072 + 10240);
    if constexpr (GATHER) { S.gather_issue(cur, gbuf, wid, lane); asm volatile("s_waitcnt vmcnt(0)" ::: "memory"); __builtin_amdgcn_s_barrier(); asm volatile("" ::: "memory"); S.gather_read(cur, RR, CC, vgc, gbuf); }
    LAS unsigned* abuf = (LAS unsigned*)(lds + 131072 + 12288);
    if constexpr (Epi::COLAUX) E.caux_issue(cur, abuf, wid, lane);
    if constexpr (Epi::ROWAUX) E.aux_issue(cur, gbuf, wid, lane);
    PG8_STAGE_B(PG8_SB(0, 0), cB); PG8_STAGE_B(PG8_SB(0, 1), cB + hstepB); PG8_STAGE_A(PG8_SA(0, 0), cA, 0, vgc); PG8_STAGE_A(PG8_SA(0, 1), cA, 1, vgc);
    if (wr == 1) PG8_BAR;
    PG8_WAIT_V(2); PG8_BAR;
    PG8_STAGE_B(PG8_SB(1, 0), cB + kstep); PG8_STAGE_A(PG8_SA(1, 0), cA + kstep, 0, vgc); PG8_STAGE_B(PG8_SB(1, 1), cB + hstepB + kstep);
    PG8_WAIT_V(6); PG8_BAR;
    for (;;) {
        const bool has_next = S.next(ui + 1, nxt);
        const char* nA = cA; const char* nB = cB; int nnt = nt;
        if (has_next) { S.operands(nxt, nA, nB, nnt); if constexpr (GATHER) S.gather_issue(nxt, gbuf + 256 * ((ui + 1) & 1), wid, lane); }
        else { if constexpr (GATHER) { vgn[0][0] = vgc[0][0]; vgn[0][1] = vgc[0][1]; vgn[1][0] = vgc[1][0]; vgn[1][1] = vgc[1][1]; } }
        for (int t = 0; t < nt; t += 2) {
            const bool last = (t == nt - 2);
            const char* a1 = cA + (size_t)(t + 1) * kstep;
            const char* a2 = last ? nA : cA + (size_t)(t + 2) * kstep; const char* b2 = last ? nB : cB + (size_t)(t + 2) * kstep;
            const char* a3 = a2 + kstep; const char* b3 = b2 + kstep;
            unsigned v2[2][2];
            if constexpr (GATHER) { if (last && has_next) S.gather_read(nxt, RR, CC, vgn, gbuf + 256 * ((ui + 1) & 1)); }
            if constexpr (GATHER) { v2[0][0] = last ? vgn[0][0] : vgc[0][0]; v2[0][1] = last ? vgn[0][1] : vgc[0][1]; v2[1][0] = last ? vgn[1][0] : vgc[1][0]; v2[1][1] = last ? vgn[1][1] : vgc[1][1]; }
            else { v2[0][0] = v2[0][1] = v2[1][0] = v2[1][1] = 0u; }
            PG8_LDB(B0, 0, 0); PG8_LDB(B1, 0, 1); PG8_SCHED; PG8_LDA(At, 0, 0); PG8_STAGE_A(PG8_SA(1, 1), a1, 1, vgc);
            PG8_WAIT_V(8); PG8_WAIT_L(0); PG8_BAR; PG8_MMA(0, 0, At, B0); PG8_MMA(0, 1, At, B1); PG8_BAR; PG8_SCHED;
            PG8_LDA(At, 0, 1); PG8_STAGE_B(PG8_SB(0, 0), b2); PG8_STAGE_B(PG8_SB(0, 1), b2 + hstepB); PG8_STAGE_A(PG8_SA(0, 0), a2, 0, v2);
            PG8_WAIT_V(8); PG8_WAIT_L(0); PG8_BAR; PG8_MMA(1, 0, At, B0); PG8_MMA(1, 1, At, B1); PG8_BAR; PG8_SCHED;
            PG8_LDB(B0, 1, 0); PG8_LDB(B1, 1, 1); PG8_SCHED; PG8_LDA(At, 1, 0); PG8_STAGE_A(PG8_SA(0, 1), a2, 1, v2);
            PG8_WAIT_V(8); PG8_WAIT_L(0); PG8_BAR; PG8_MMA(0, 0, At, B0); PG8_MMA(0, 1, At, B1); PG8_BAR; PG8_SCHED;
            PG8_LDA(At, 1, 1); PG8_STAGE_B(PG8_SB(1, 0), b3); PG8_STAGE_B(PG8_SB(1, 1), b3 + hstepB); PG8_STAGE_A(PG8_SA(1, 0), a3, 0, v2);
            PG8_WAIT_V(8); PG8_WAIT_L(0); PG8_BAR; PG8_MMA(1, 0, At, B0); PG8_MMA(1, 1, At, B1); PG8_BAR; PG8_SCHED;
        }
        if (wr == 0) PG8_BAR;
        if constexpr (Epi::F8) asm volatile("s_nop 15\n\ts_nop 7" ::: "memory");
        if constexpr (Epi::ROWAUX) E.aux_buf(gbuf + 256 * (ui & 1));
        if constexpr (Epi::COLAUX) E.caux_buf(abuf + 256 * (ui & 1));
        E(acc, cur, wr, wc, fr, fq);
#ifdef GEMM_DUP_EPI
        if constexpr (!Epi::NODUP && ((GEMM_DUP_EPI) & Epi::DUPBIT) != 0) { asm volatile("" ::: "memory"); E(acc, cur, wr, wc, fr, fq); }
#endif
        if (!has_next) break;
        if (!E.keep(cur)) {
#pragma unroll
        for (int a = 0; a < 2; ++a)
#pragma unroll
            for (int b = 0; b < 2; ++b)
#pragma unroll
                for (int m = 0; m < 4; ++m)
#pragma unroll
                    for (int n = 0; n < 2; ++n) acc[a][b][m][n] = (f32x4){0.f, 0.f, 0.f, 0.f}; }
        cur = nxt; cA = nA; cB = nB; nt = nnt; ++ui;
        if constexpr (Epi::ROWAUX) E.aux_issue(cur, gbuf + 256 * (ui & 1), wid, lane);
        if constexpr (Epi::COLAUX) E.caux_issue(cur, abuf + 256 * (ui & 1), wid, lane);
        if constexpr (GATHER) { vgc[0][0] = vgn[0][0]; vgc[0][1] = vgn[0][1]; vgc[1][0] = vgn[1][0]; vgc[1][1] = vgn[1][1]; }
        if (wr == 1) PG8_BAR;
    }
    PG8_WAIT_V(0);
    PG8_BAR;
#undef PG8_SA
#undef PG8_SB
#undef PG8_STG
#undef PG8_STAGE_A
#undef PG8_STAGE_B
#undef PG8_LDA
#undef PG8_LDB
#undef PG8_MMA
#undef PG8_F8CAT
#undef PG8_WAIT_V
#undef PG8_WAIT_L
#undef PG8_BAR
#undef PG8_SCHED
}
}

#define RLX_AGENT __ATOMIC_RELAXED, __HIP_MEMORY_SCOPE_AGENT
#define LDS_WAIT() asm volatile("s_waitcnt lgkmcnt(0)" ::: "memory")
#define VM_WAIT() asm volatile("s_waitcnt vmcnt(0)" ::: "memory")
__device__ __forceinline__ float bf2f(unsigned b) { return __uint_as_float(b << 16); }
__device__ __forceinline__ unsigned f2bf(float f) { unsigned u = __float_as_uint(f); return (u + 0x7fffu + ((u >> 16) & 1u)) >> 16; }
__device__ __forceinline__ unsigned pk2(float lo, float hi) { return pg8::cvt_pk_bf16(lo, hi); }
__device__ __forceinline__ float f8clamp(float x) { return fminf(fmaxf(x, -448.0f), 448.0f); }
__device__ __forceinline__ unsigned pk4_u8(float a, float b, float c, float d) { int r = __builtin_amdgcn_cvt_pk_u8_f32(__builtin_rintf(a), 0, 0); r = __builtin_amdgcn_cvt_pk_u8_f32(__builtin_rintf(b), 1, r); r = __builtin_amdgcn_cvt_pk_u8_f32(__builtin_rintf(c), 2, r); r = __builtin_amdgcn_cvt_pk_u8_f32(__builtin_rintf(d), 3, r); return (unsigned)r; }
__device__ __forceinline__ unsigned char f8_byte(float x) { return (unsigned char)(__builtin_amdgcn_cvt_pk_fp8_f32(f8clamp(x), 0.0f, 0, false) & 0xff); }
__device__ __forceinline__ unsigned pk4_f8_nc(float a, float b, float c, float d) { int r = __builtin_amdgcn_cvt_pk_fp8_f32(a, b, 0, false); r = __builtin_amdgcn_cvt_pk_fp8_f32(c, d, r, true); return (unsigned)r; }
__device__ __forceinline__ unsigned pk4_f8(float a, float b, float c, float d) { int r = __builtin_amdgcn_cvt_pk_fp8_f32(f8clamp(a), f8clamp(b), 0, false); r = __builtin_amdgcn_cvt_pk_fp8_f32(f8clamp(c), f8clamp(d), r, true); return (unsigned)r; }
__device__ __forceinline__ float fexp2(float x) { return __builtin_amdgcn_exp2f(x); }
__device__ __forceinline__ float flog2(float x) { return __builtin_amdgcn_logf(x); }
__device__ __forceinline__ float frcp(float x) { return __builtin_amdgcn_rcpf(x); }
__device__ __forceinline__ float fsigmoid(float x) { return frcp(1.0f + fexp2(-LOG2E * x)); }
__device__ __forceinline__ float shx(int lane, float v, int mask) { return __int_as_float(__builtin_amdgcn_ds_bpermute((lane ^ mask) << 2, __float_as_int(v))); }
__device__ __forceinline__ float shup(int lane, float v, int o) { return __int_as_float(__builtin_amdgcn_ds_bpermute((lane >= o ? lane - o : lane) << 2, __float_as_int(v))); }
__device__ __forceinline__ float shidx(float v, int src) { return __int_as_float(__builtin_amdgcn_ds_bpermute(src << 2, __float_as_int(v))); }
#define WV_DPP(x, ctrl) __int_as_float(__builtin_amdgcn_update_dpp(0, __float_as_int(x), (ctrl), 0xf, 0xf, true))
__device__ __forceinline__ float wave_sum(int lane, float v) {
    (void)lane;
    v += WV_DPP(v, 0xb1); v += WV_DPP(v, 0x4e); v += WV_DPP(v, 0x141); v += WV_DPP(v, 0x140);
    { const auto r = __builtin_amdgcn_permlane16_swap(__float_as_uint(v), __float_as_uint(v), false, false); v = __uint_as_float(r[0]) + __uint_as_float(r[1]); }
    { const auto r = __builtin_amdgcn_permlane32_swap(__float_as_uint(v), __float_as_uint(v), false, false); v = __uint_as_float(r[0]) + __uint_as_float(r[1]); }
    return v;
}
__device__ __forceinline__ float wave_max(int lane, float v) {
    (void)lane;
    v = fmaxf(v, WV_DPP(v, 0xb1)); v = fmaxf(v, WV_DPP(v, 0x4e)); v = fmaxf(v, WV_DPP(v, 0x141)); v = fmaxf(v, WV_DPP(v, 0x140));
    { const auto r = __builtin_amdgcn_permlane16_swap(__float_as_uint(v), __float_as_uint(v), false, false); v = fmaxf(__uint_as_float(r[0]), __uint_as_float(r[1])); }
    { const auto r = __builtin_amdgcn_permlane32_swap(__float_as_uint(v), __float_as_uint(v), false, false); v = fmaxf(__uint_as_float(r[0]), __uint_as_float(r[1])); }
    return v;
}
__device__ __forceinline__ unsigned pk4_i8(float a, float b, float c, float d) {
    const int qa = (int)__builtin_rintf(a), qb = (int)__builtin_rintf(b), qc = (int)__builtin_rintf(c), qd = (int)__builtin_rintf(d);
    return ((unsigned)qa & 255u) | (((unsigned)qb & 255u) << 8) | (((unsigned)qc & 255u) << 16) | ((unsigned)qd << 24); }

#define XB_TMO      128
#define XB_XCNT(j)  (256  + 64 * (j))
#define XB_XSUB(j)  (1280 + 64 * (j))
#define XB_XGEN(j)  (2304 + 64 * (j))
#define XB_TOP      3328
#define XB_TOPGEN   3392
#define XCD_BAR_WORDS 3456
#if CHK
#define XB_SPIN_CAP (1u << 21)
#else
#define XB_SPIN_CAP (1u << 18)
#endif
__device__ __forceinline__ unsigned xb_ld(unsigned* p)              { return __hip_atomic_load(p, __ATOMIC_RELAXED, __HIP_MEMORY_SCOPE_AGENT); }
__device__ __forceinline__ unsigned xb_add(unsigned* p, unsigned v) { return __hip_atomic_fetch_add(p, v, __ATOMIC_RELAXED, __HIP_MEMORY_SCOPE_AGENT); }
__device__ __forceinline__ unsigned xb_xcc_id() { return (unsigned)__builtin_amdgcn_s_getreg((3 << 11) | 20) & 0xFu; }
#define XB_SPIN(cond, bar) do { unsigned _sp = 0; while (cond) { __builtin_amdgcn_s_sleep(1); \
    if ((++_sp & 255u) == 0u) { if (xb_ld(&(bar)[XB_TMO])) break; if (_sp > XB_SPIN_CAP) { atomicAdd(&(bar)[XB_TMO], 1u); break; } } } } while (0)
struct XcdBarrier { unsigned* bar; unsigned x; volatile LAS unsigned* st; };
__device__ __forceinline__ XcdBarrier xcd_barrier_post(unsigned* bar, volatile LAS unsigned* st) {
    XcdBarrier b; b.bar = bar; b.x = xb_xcc_id(); b.st = st;
    if (threadIdx.x == 0) (void)xb_add(&bar[XB_XCNT(b.x)], 1u);
    return b;
}
__device__ __forceinline__ void xcd_barrier_complete(unsigned* bar, unsigned x, unsigned& nloc, unsigned& nx) {
    const unsigned G = gridDim.x * gridDim.y * gridDim.z;
    unsigned sum, cnt, mine, sp = 0u;
    for (;;) {
        sum = 0u; cnt = 0u; mine = 0u;
#pragma unroll
        for (unsigned j = 0; j < 16; ++j) { const unsigned c = xb_ld(&bar[XB_XCNT(j)]); sum += c; cnt += (c > 0u) ? 1u : 0u; mine = (j == x) ? c : mine; }
        if (sum == G) break;
        __builtin_amdgcn_s_sleep(1);
        if ((++sp & 255u) == 0u) { if (xb_ld(&bar[XB_TMO])) break; if (sp > XB_SPIN_CAP) { atomicAdd(&bar[XB_TMO], 1u); break; } }
    }
    nloc = mine > 0u ? mine : 1u; nx = cnt > 0u ? cnt : 1u;
}
__device__ __forceinline__ void xcd_barrier(const XcdBarrier& b) {
    asm volatile("s_waitcnt vmcnt(0)" ::: "memory");
    __syncthreads();
    if (threadIdx.x == 0) {
        unsigned* bar = b.bar;
        __builtin_amdgcn_s_waitcnt(0);
        unsigned nloc = b.st[0], nx = b.st[1];
        if (nloc == 0u) { xcd_barrier_complete(bar, b.x, nloc, nx); b.st[0] = nloc; b.st[1] = nx; }
        const unsigned old = xb_add(&bar[XB_XSUB(b.x)], 1u);
        const unsigned gen = old / nloc;
        if (old + 1u == (gen + 1u) * nloc) {
            __builtin_amdgcn_fence(__ATOMIC_RELEASE, "agent");
            asm volatile("s_waitcnt vmcnt(0)" ::: "memory");
            const unsigned og = xb_add(&bar[XB_TOP], 1u);
            const unsigned tg = og / nx;
            if (og + 1u == (tg + 1u) * nx) xb_add(&bar[XB_TOPGEN], 1u);
            else XB_SPIN(xb_ld(&bar[XB_TOPGEN]) == tg, bar);
            __builtin_amdgcn_fence(__ATOMIC_ACQUIRE, "agent");
            xb_add(&bar[XB_XGEN(b.x)], 1u);
            asm volatile("s_waitcnt vmcnt(0)" ::: "memory");
        } else {
            XB_SPIN(xb_ld(&bar[XB_XGEN(b.x)]) == gen, bar);
            __builtin_amdgcn_fence(__ATOMIC_ACQUIRE, "agent");
            asm volatile("s_waitcnt vmcnt(0)" ::: "memory");
        }
    }
    __syncthreads();
}

struct Args { const float* in[29]; float* out; unsigned char* ws; };
typedef const __attribute__((address_space(4))) Args* ArgsP;
struct AR { ArgsP p;
    __device__ __forceinline__ const float* in(int i) const { return p->in[i]; }
    __device__ __forceinline__ float* out() const { return p->out; }
    __device__ __forceinline__ unsigned char* ws() const { return p->ws; } };
enum { I_X = 0, I_C, I_WADA, I_BADA, I_LN1G, I_LN1B, I_WIN, I_BF, I_CONVW, I_CONVB, I_WA, I_BA, I_WX, I_BX, I_LAM, I_WGATE, I_BGATE, I_WPA, I_WPB, I_WPC, I_WO,
       I_LN2G, I_LN2B, I_WR, I_BR, I_WGU, I_BGU, I_WDN, I_BDN };

struct P0Item { const float* src; bf16_t* dst; int ldw; int ldt; float qs; };
constexpr int IT_IN = 16 * 80, IT_G = 16 * 48, IT_PA = 8 * 16, IT_PB = 8 * 16, IT_PC = 16 * 16, IT_O = 16 * 16, IT_GU = 32 * 16 * 32, IT_DN = 32 * 16 * 16;
constexpr int IT_LAYER = IT_IN + IT_G + IT_PA + IT_PB + IT_PC + IT_O + IT_GU + IT_DN;
__device__ __forceinline__ P0Item p0_decode(const AR a, int it) {
    const int l = it / IT_LAYER; int r = it % IT_LAYER; P0Item d; d.qs = 0.f;
    unsigned char* wl = a.ws() + WS_W + (size_t)l * WL_SIZE;
    if (r < IT_IN) { const int kb = FP8_IN ? (r / 160) * 2 : r / 80, n0 = FP8_IN ? 32 * (r % 160) : 64 * (r % 80); d.ldw = DIN; d.ldt = 1024; d.src = a.in(I_WIN) + (size_t)l * D * DIN + (size_t)(64 * kb) * DIN + (n0 < 1536 ? n0 : n0 + 8);
        if (FP8_IN) { d.qs = (FP8_IN == 2) ? -127.0f / fmaxf(__uint_as_float(__hip_atomic_load((gu32*)(a.ws() + WS_CTL) + CW_WMAX + (2 * l) * 64, RLX_AGENT)), 1e-30f) : Q_WIN; d.dst = (bf16_t*)(wl + WL_IN + (size_t)n0 * 1024 + 64 * kb); } else d.dst = (bf16_t*)(wl + WL_IN) + (size_t)n0 * 1024 + 64 * kb; return d; } r -= IT_IN;
    if (r < IT_G) { const int kb = FP8_IN ? (r / 96) * 2 : r / 48, n0 = FP8_IN ? 32 * (r % 96) : 64 * (r % 48); d.ldw = 3072; d.ldt = 1024; d.src = a.in(I_WGATE) + (size_t)l * D * 3072 + (size_t)(64 * kb) * 3072 + n0;
        if (FP8_IN) { d.qs = (FP8_IN == 2) ? -127.0f / fmaxf(__uint_as_float(__hip_atomic_load((gu32*)(a.ws() + WS_CTL) + CW_WMAX + (2 * l + 1) * 64, RLX_AGENT)), 1e-30f) : Q_WIN; d.dst = (bf16_t*)(wl + WL_IN + (size_t)(5120 + n0) * 1024 + 64 * kb); } else d.dst = (bf16_t*)(wl + WL_IN) + (size_t)(5120 + n0) * 1024 + 64 * kb; return d; } r -= IT_G;
    if (r < IT_PA) { const int kb = FP8_MRG ? (r / 32) * 2 : r / 16, n0 = FP8_MRG ? 32 * (r % 32) : 64 * (r % 16); d.ldw = D; d.ldt = 2048; d.src = a.in(I_WPA) + (size_t)l * 512 * D + (size_t)(64 * kb) * D + n0;
        if (FP8_MRG) { d.qs = Q_WP; d.dst = (bf16_t*)(wl + WL_P + (size_t)n0 * 2048 + 64 * kb); } else d.dst = (bf16_t*)(wl + WL_P) + (size_t)n0 * 2048 + 64 * kb; return d; } r -= IT_PA;
    if (r < IT_PB) { const int kb = FP8_MRG ? (r / 32) * 2 : r / 16, n0 = FP8_MRG ? 32 * (r % 32) : 64 * (r % 16); d.ldw = D; d.ldt = 2048; d.src = a.in(I_WPB) + (size_t)l * 512 * D + (size_t)(64 * kb) * D + n0;
        if (FP8_MRG) { d.qs = Q_WP; d.dst = (bf16_t*)(wl + WL_P + (size_t)n0 * 2048 + 512 + 64 * kb); } else d.dst = (bf16_t*)(wl + WL_P) + (size_t)n0 * 2048 + 512 + 64 * kb; return d; } r -= IT_PB;
    if (r < IT_PC) { const int kb = FP8_MRG ? (r / 32) * 2 : r / 16, n0 = FP8_MRG ? 32 * (r % 32) : 64 * (r % 16); d.ldw = D; d.ldt = 2048; d.src = a.in(I_WPC) + (size_t)l * D * D + (size_t)(64 * kb) * D + n0;
        if (FP8_MRG) { d.qs = Q_WP; d.dst = (bf16_t*)(wl + WL_P + (size_t)n0 * 2048 + 1024 + 64 * kb); } else d.dst = (bf16_t*)(wl + WL_P) + (size_t)n0 * 2048 + 1024 + 64 * kb; return d; } r -= IT_PC;
    if (r < IT_O) { const int kb = r / 16, n0 = 64 * (r % 16); d.ldw = D; d.ldt = 1024; d.src = a.in(I_WO) + (size_t)l * D * D + (size_t)(64 * kb) * D + n0; d.dst = (bf16_t*)(wl + WL_O) + (size_t)n0 * 1024 + 64 * kb; return d; } r -= IT_O;
    if (r < IT_GU) { const int e = r / 512, q = r % 512, kb = FP8_MOE ? (q / 64) * 2 : q / 32, n0 = FP8_MOE ? 32 * (q % 64) : 64 * (q % 32);
        const int sc = 1024 * ((n0 >> 7) & 1) + 128 * (n0 >> 8) + (n0 & 127);
        d.ldw = 2048; d.ldt = 1024; d.src = a.in(I_WGU) + ((size_t)l * NEXP + e) * D * 2048 + (size_t)(64 * kb) * 2048 + sc; if (FP8_MOE) { d.qs = Q_WGU; d.dst = (bf16_t*)(wl + WL_GU + ((size_t)e * 2048 + n0) * 1024 + 64 * kb); } else d.dst = (bf16_t*)(wl + WL_GU) + ((size_t)e * 2048 + n0) * 1024 + 64 * kb; return d; } r -= IT_GU;
    { const int e = r / 256, q = r % 256, kb = FP8_MOE ? (q / 32) * 2 : q / 16, n0 = FP8_MOE ? 32 * (q % 32) : 64 * (q % 16);
      d.ldw = D; d.ldt = 1024; d.src = a.in(I_WDN) + ((size_t)l * NEXP + e) * D * D + (size_t)(64 * kb) * D + n0; if (FP8_MOE) { d.qs = Q_WDN; d.dst = (bf16_t*)(wl + WL_DN + ((size_t)e * 1024 + n0) * 1024 + 64 * kb); } else d.dst = (bf16_t*)(wl + WL_DN) + ((size_t)e * 1024 + n0) * 1024 + 64 * kb; return d; }
}
__device__ __forceinline__ void p0_load(const P0Item& d, f32x4 (&v)[16], int lane) {
    if (d.qs != 0.f) {
        const float* p = d.src + (size_t)(lane >> 3) * d.ldw + 4 * (lane & 7);
#pragma unroll
        for (int i = 0; i < 16; ++i) v[i] = __builtin_nontemporal_load((const f32x4*)(p + (size_t)(8 * i) * d.ldw)); }
    else {
    const float* p = d.src + (size_t)(lane >> 4) * d.ldw + 4 * (lane & 15);
#pragma unroll
    for (int i = 0; i < 16; ++i) v[i] = __builtin_nontemporal_load((const f32x4*)(p + (size_t)(4 * i) * d.ldw)); }
}
__device__ __forceinline__ void p0_store(const P0Item& d, const f32x4 (&v)[16], LAS float* T, int lane) {
    if (d.qs != 0.f) {
        const int r = lane >> 3, c8 = lane & 7;
#pragma unroll
        for (int i = 0; i < 16; ++i) { const int kk = 8 * i + r;
            T[(4 * c8 + 0) * 129 + kk] = v[i][0]; T[(4 * c8 + 1) * 129 + kk] = v[i][1]; T[(4 * c8 + 2) * 129 + kk] = v[i][2]; T[(4 * c8 + 3) * 129 + kk] = v[i][3]; }
        LDS_WAIT(); asm volatile("" ::: "memory");
        const float q = fabsf(d.qs); const bool i8 = d.qs < 0.f;
#pragma unroll
        for (int j = 0; j < 4; ++j) { const int n = r + 8 * j; const LAS float* s = T + n * 129 + 16 * c8; u32x4 o;
            if (FP8_IN == 2 && i8) { o.x = pk4_i8(s[0] * q, s[1] * q, s[2] * q, s[3] * q); o.y = pk4_i8(s[4] * q, s[5] * q, s[6] * q, s[7] * q); o.z = pk4_i8(s[8] * q, s[9] * q, s[10] * q, s[11] * q); o.w = pk4_i8(s[12] * q, s[13] * q, s[14] * q, s[15] * q); }
            else { o.x = pk4_f8(s[0] * q, s[1] * q, s[2] * q, s[3] * q); o.y = pk4_f8(s[4] * q, s[5] * q, s[6] * q, s[7] * q); o.z = pk4_f8(s[8] * q, s[9] * q, s[10] * q, s[11] * q); o.w = pk4_f8(s[12] * q, s[13] * q, s[14] * q, s[15] * q); }
            *(GAS u32x4*)((unsigned char*)d.dst + (size_t)n * d.ldt + 16 * c8) = o; }
        LDS_WAIT(); asm volatile("" ::: "memory");
        return; }
    const int r = lane >> 4, c4 = lane & 15;
#pragma unroll
    for (int i = 0; i < 16; ++i) { const int kk = 4 * i + r;
        T[(4 * c4 + 0) * 65 + kk] = v[i][0]; T[(4 * c4 + 1) * 65 + kk] = v[i][1]; T[(4 * c4 + 2) * 65 + kk] = v[i][2]; T[(4 * c4 + 3) * 65 + kk] = v[i][3]; }
    LDS_WAIT(); asm volatile("" ::: "memory");
    const int c = lane & 7;
#pragma unroll
    for (int j = 0; j < 8; ++j) { const int n = (lane >> 3) + 8 * j; const LAS float* s = T + n * 65 + 8 * c;
        u32x4 o; o.x = pk2(s[0], s[1]); o.y = pk2(s[2], s[3]); o.z = pk2(s[4], s[5]); o.w = pk2(s[6], s[7]);
        *(GAS u32x4*)(d.dst + (size_t)n * d.ldt + 8 * c) = o; }
    LDS_WAIT(); asm volatile("" ::: "memory");
}
constexpr int IT_Q = (FP8_IN == 2) ? (IT_IN + IT_G) : 0;
__device__ __forceinline__ int p0_item(int q, int part) { return part ? (q / IT_Q) * IT_LAYER + (q % IT_Q) : (q / (IT_LAYER - IT_Q)) * IT_LAYER + IT_Q + (q % (IT_LAYER - IT_Q)); }
__device__ __forceinline__ void p0_weights(const AR a, LAS unsigned char* lds, int gw, int NGW, int wave, int lane, int part) {
    LAS float* T = (LAS float*)(lds + wave * 16640);
    const int NQ = DEPTH * (part ? IT_Q : IT_LAYER - IT_Q);
    int q = gw; if (q >= NQ) return;
    P0Item cur = p0_decode(a, p0_item(q, part)); f32x4 v[16]; p0_load(cur, v, lane);
    for (;;) {
        const int nx = q + NGW; const bool more = nx < NQ;
        P0Item nxt = cur; f32x4 w[16];
        if (more) { nxt = p0_decode(a, p0_item(nx, part)); p0_load(nxt, w, lane); }
        p0_store(cur, v, T, lane);
        if (!more) break;
#pragma unroll
        for (int i = 0; i < 16; ++i) v[i] = w[i];
        cur = nxt; q = nx;
    }
}
__device__ __forceinline__ void p0_wabsmax(const AR a, int gt, int NT, int lane) {
#pragma unroll 1
    for (int t = 0; t < 2 * DEPTH; ++t) { const int l = t >> 1, which = t & 1;
        const f32x4* W = (const f32x4*)(which ? a.in(I_WGATE) + (size_t)l * D * 3072 : a.in(I_WIN) + (size_t)l * D * DIN); const int n4 = (which ? D * 3072 : D * DIN) / 4;
        float mx = 0.f;
#pragma unroll 4
        for (int i = gt; i < n4; i += NT) { const f32x4 v = W[i]; mx = fmaxf(fmaxf(mx, fmaxf(fabsf(v[0]), fabsf(v[1]))), fmaxf(fabsf(v[2]), fabsf(v[3]))); }
        mx = wave_max(lane, mx);
        if (lane == 0) __hip_atomic_fetch_max((gu32*)(a.ws() + WS_CTL) + CW_WMAX + t * 64, __float_as_uint(mx), RLX_AGENT); }
}
__device__ __forceinline__ void p0_ada(const AR a, LAS unsigned char* lds, int item, int tid, int wave, int lane) {
    LAS float* cond = (LAS float*)lds;
    LAS float* part = (LAS float*)(lds + 65536);
    const int l = item / 96, cg = item % 96, col = cg * 64 + lane;
    const float* c = a.in(I_C);
    for (int i = tid; i < 16 * 1024; i += 512) { const float v = c[i]; cond[i] = v * fsigmoid(v); }
    __syncthreads();
    float acc[16];
#pragma unroll
    for (int b = 0; b < 16; ++b) acc[b] = 0.f;
    const float* W = a.in(I_WADA) + (size_t)l * D * 6144;
    {
        const float* Wp = W + (size_t)(wave * 128) * 6144 + col; float wc[16], wn[16];
#pragma unroll
        for (int i = 0; i < 16; ++i) wc[i] = Wp[(size_t)i * 6144];
#pragma unroll 1
        for (int k0 = 0; k0 < 128; k0 += 16) {
            if (k0 + 16 < 128) {
#pragma unroll
                for (int i = 0; i < 16; ++i) wn[i] = Wp[(size_t)(k0 + 16 + i) * 6144]; }
#pragma unroll
            for (int i = 0; i < 16; ++i) { const int k = wave * 128 + k0 + i;
#pragma unroll
                for (int b = 0; b < 16; ++b) acc[b] += cond[b * 1024 + k] * wc[i]; }
#pragma unroll
            for (int i = 0; i < 16; ++i) wc[i] = wn[i];
        } }
#pragma unroll
    for (int b = 0; b < 16; ++b) part[(wave * 16 + b) * 64 + lane] = acc[b];
    __syncthreads();
    float* ada = (float*)(a.ws() + WS_ADA);
    for (int o = tid; o < 1024; o += 512) { const int b = o >> 6, ln = o & 63; float s = 0.f;
#pragma unroll
        for (int w = 0; w < 8; ++w) s += part[(w * 16 + b) * 64 + ln];
        ada[((size_t)l * 16 + b) * 6144 + cg * 64 + ln] = s + a.in(I_BADA)[(size_t)l * 6144 + cg * 64 + ln]; }
    __syncthreads();
}

__device__ __forceinline__ void stage_wf(const AR a, int l, LAS unsigned char* lds, int tid) {
    LAS float* Wf = (LAS float*)lds;
    const float* W = a.in(I_WIN) + (size_t)l * D * DIN + 1536;
    for (int i = tid; i < 8192; i += 512) { const int k = i >> 3, g = i & 7, L = (k & 255) >> 2, j = k >> 8, ii = k & 3;
        Wf[((((4 * j + ii) * 2 + (g >> 2)) * 64 + L) << 2) + (g & 3)] = W[(size_t)k * DIN + g]; }
}
__device__ __forceinline__ float log_sigmoidf(float x) { return fminf(x, 0.f) - 0.6931471806f * flog2(1.0f + fexp2(-LOG2E * fabsf(x))); }
__device__ __forceinline__ void stage_vec(const float* src, LAS float* dst, int tid) { if (tid < 256) *(LAS f32x4*)(dst + 4 * tid) = *(const f32x4*)(src + 4 * tid); }
__device__ __forceinline__ void stage_vec5(const float* s0, const float* s1, const float* s2, const float* s3, const float* s4, LAS float* dst, int tid) {
    if (tid < 256) { const f32x4 v0 = *(const f32x4*)(s0 + 4 * tid), v1 = *(const f32x4*)(s1 + 4 * tid), v2 = *(const f32x4*)(s2 + 4 * tid), v3 = *(const f32x4*)(s3 + 4 * tid), v4 = *(const f32x4*)(s4 + 4 * tid);
        *(LAS f32x4*)(dst + 4 * tid) = v0; *(LAS f32x4*)(dst + 1024 + 4 * tid) = v1; *(LAS f32x4*)(dst + 2048 + 4 * tid) = v2; *(LAS f32x4*)(dst + 3072 + 4 * tid) = v3; *(LAS f32x4*)(dst + 4096 + 4 * tid) = v4; } }
__device__ __forceinline__ void prep_row(const AR a, int m, const f32x4 (&x)[4], const LAS float* Wf, const LAS float* shL, const LAS float* scL, const LAS float* bfL, int lane) {
    bf16_t* H = (bf16_t*)(a.ws() + WS_H) + (size_t)m * D;
    float s[8];
#pragma unroll
    for (int j = 0; j < 8; ++j) s[j] = 0.f;
    float mx = 0.f;
#pragma unroll
    for (int j = 0; j < 4; ++j) {
        const int col = 4 * lane + 256 * j;
        const f32x4 sh = *(const LAS f32x4*)(shL + 256 * j), sc = *(const LAS f32x4*)(scL + 256 * j);
        const f32x4 h = x[j] * (sc + 1.0f) + sh;
        if (FP8_IN == 2) { mx = fmaxf(fmaxf(mx, fmaxf(fabsf(h[0]), fabsf(h[1]))), fmaxf(fabsf(h[2]), fabsf(h[3]))); }
        else if (FP8_IN == 1) *(unsigned*)((unsigned char*)(a.ws() + WS_H) + (size_t)m * D + col) = pk4_f8(h[0] * Q_H1, h[1] * Q_H1, h[2] * Q_H1, h[3] * Q_H1);
        else { u32x2 w; w.x = pk2(h[0], h[1]); w.y = pk2(h[2], h[3]); *(u32x2*)(H + col) = w; }
#pragma unroll
        for (int i = 0; i < 4; ++i) { const f32x4 w0 = *(const LAS f32x4*)(Wf + ((((4 * j + i) * 2) * 64 + lane) << 2)), w1 = *(const LAS f32x4*)(Wf + ((((4 * j + i) * 2 + 1) * 64 + lane) << 2));
            s[0] += h[i] * w0[0]; s[1] += h[i] * w0[1]; s[2] += h[i] * w0[2]; s[3] += h[i] * w0[3];
            s[4] += h[i] * w1[0]; s[5] += h[i] * w1[1]; s[6] += h[i] * w1[2]; s[7] += h[i] * w1[3]; }
    }
    if (FP8_IN == 2) {
        mx = fmaxf(wave_max(lane, mx), 1e-30f); const float inv = 127.0f / mx;
#pragma unroll
        for (int j = 0; j < 4; ++j) { const f32x4 sh = *(const LAS f32x4*)(shL + 256 * j), sc = *(const LAS f32x4*)(scL + 256 * j); const f32x4 h = x[j] * (sc + 1.0f) + sh;
            *(unsigned*)((unsigned char*)(a.ws() + WS_H) + (size_t)m * D + 4 * lane + 256 * j) = pk4_i8(h[0] * inv, h[1] * inv, h[2] * inv, h[3] * inv); }
        if (lane == 0) ((float*)(a.ws() + WS_ROWS))[m] = mx * (1.0f / 127.0f); }
#pragma unroll
    for (int j = 0; j < 8; ++j) s[j] = wave_sum(lane, s[j]);
    float mine = s[0];
#pragma unroll
    for (int j = 1; j < 8; ++j) mine = (lane == j) ? s[j] : mine;
    if (lane < 8) { float* logf = (float*)(a.ws() + WS_LOGF); logf[(size_t)m * 8 + lane] = log_sigmoidf(mine + bfL[lane]); }
}
__device__ __forceinline__ void ln_row(f32x4 (&v)[4], const LAS float* g, const LAS float* bb, int lane) {
    float s = 0.f;
#pragma unroll
    for (int j = 0; j < 4; ++j) s += (v[j][0] + v[j][1]) + (v[j][2] + v[j][3]);
    const float mean = wave_sum(lane, s) * (1.f / D); float s2 = 0.f;
#pragma unroll
    for (int j = 0; j < 4; ++j) { v[j] = v[j] - mean; s2 += (v[j][0] * v[j][0] + v[j][1] * v[j][1]) + (v[j][2] * v[j][2] + v[j][3] * v[j][3]); }
    const float rstd = 1.f / sqrtf(wave_sum(lane, s2) * (1.f / D) + LN_EPS);
#pragma unroll
    for (int j = 0; j < 4; ++j) { const f32x4 gg = *(const LAS f32x4*)(g + 256 * j), bv = *(const LAS f32x4*)(bb + 256 * j); v[j] = v[j] * rstd * gg + bv; }
}

struct DenseOrder {
    pg8::TileOrder T; const char* A; const char* B; int lda, ldb, nt; int rot = 0, nper = 0;
    __device__ __forceinline__ bool next(int i, pg8::Unit& u) const { u.aux = 0; if (nper > 0) { if (i >= nper) return false; int j = i + rot; if (j >= nper) j -= nper; return T.tile(j, u.pm, u.pn); } return T.tile(i, u.pm, u.pn); }
    __device__ __forceinline__ void operands(const pg8::Unit& u, const char*& a, const char*& b, int& n) const {
        a = A + (size_t)u.pm * 256 * lda * 2; b = B + (size_t)u.pn * 256 * ldb * 2; n = nt; }
};
struct MergeOrder {
    pg8::TileOrder T; const char* A; const char* B;
    __device__ __forceinline__ bool next(int i, pg8::Unit& u) const { u.aux = i % 3; return T.tile(i / 3, u.pm, u.pn); }
    __device__ __forceinline__ void operands(const pg8::Unit& u, const char*& a, const char*& b, int& n) const {
        const int k0 = (u.aux == 0) ? 0 : (u.aux == 1 ? 512 : 1024);
        constexpr size_t EB = FP8_MRG ? 1 : 2;
        a = A + ((size_t)u.pm * 256 * OP + k0) * EB; b = B + ((size_t)u.pn * 256 * OP + k0) * EB; n = ((u.aux == 2) ? 16 : 8) / (FP8_MRG ? 2 : 1); }
};
struct MoeTables { const LAS int* cnt; const LAS int* bs; const LAS unsigned char* be; };
__device__ __forceinline__ MoeTables moe_tables(LAS unsigned char* lds) {
    MoeTables t; t.cnt = (const LAS int*)(lds + MISC_OFF + MO_CNT); t.bs = (const LAS int*)(lds + MISC_OFF + MO_BS); t.be = (const LAS unsigned char*)(lds + MISC_OFF + MO_BE); return t; }
__device__ __forceinline__ void moe_build_tables(gu32* ctl, int l, LAS unsigned char* lds, int tid) {
    LAS int* cnt = (LAS int*)(lds + MISC_OFF + MO_CNT); LAS int* bs = (LAS int*)(lds + MISC_OFF + MO_BS); LAS unsigned char* be = (LAS unsigned char*)(lds + MISC_OFF + MO_BE);
    __syncthreads();
    if (tid < 32) cnt[tid] = (int)__hip_atomic_load(ctl + CW_GCNT + (l * 32 + tid) * 64, RLX_AGENT);
    __syncthreads();
    if (tid == 0) { int s = 0; for (int e = 0; e < 32; ++e) { bs[e] = s; int c = cnt[e]; if (c > ECAP) c = ECAP; s += (c + 255) >> 8; } if (s > MAXBLK) s = MAXBLK; bs[32] = s; }
    __syncthreads();
    { const int nb = bs[32]; for (int b = tid; b < nb; b += 512) { int e = 0;
#pragma unroll 1
          for (int q = 1; q < 32; ++q) if (bs[q] <= b) e = q;
          be[b] = (unsigned char)e; } }
    __syncthreads();
}
template <int NPN, bool G1> struct MoeOrder {
    int vcu; MoeTables t; const char* A; const char* B; const int* slot_tok;
    __device__ __forceinline__ bool next(int i, pg8::Unit& u) const {
        const int L = i * 256 + vcu, nb = t.bs[32]; if (L >= nb * NPN) return false;
        u.pm = L / NPN; u.pn = L % NPN; u.aux = t.be[u.pm]; return true; }
    __device__ __forceinline__ void operands(const pg8::Unit& u, const char*& a, const char*& b, int& n) const {
        constexpr size_t RB = FP8_MOE ? 1024 : 2048;
        if (G1) { a = A; b = B + ((size_t)u.aux * 2048 + (size_t)u.pn * 256) * RB; }
        else { a = A + (size_t)u.pm * 256 * RB; b = B + ((size_t)u.aux * 1024 + (size_t)u.pn * 256) * RB; }
        n = FP8_MOE ? 8 : 16; }
    __device__ __forceinline__ void gather_issue(const pg8::Unit& u, LAS unsigned* buf, int wid, int lane) const {
        const int e = u.aux, j = u.pm - t.bs[e];
        __builtin_amdgcn_global_load_lds((const unsigned*)(slot_tok + (size_t)e * ECAP + 256 * j + 64 * (wid & 3) + lane), buf + 64 * (wid & 3), 4, 0, 0);
    }
    __device__ __forceinline__ void gather_read(const pg8::Unit& u, const int (&R)[2], const int (&C)[2], unsigned (&vg)[2][2], const LAS unsigned* buf) const {
        const int e = u.aux, j = u.pm - t.bs[e], c = t.cnt[e];
#pragma unroll
        for (int h = 0; h < 2; ++h)
#pragma unroll
            for (int i = 0; i < 2; ++i) { const int r = 128 * h + R[i]; unsigned tok = buf[r]; if (256 * j + r >= c) tok = 0u;
                vg[h][i] = tok * (FP8_MOE ? 1024u : 2048u) + (unsigned)C[i] * 2u; }
    }
};

__device__ __forceinline__ u32x4 pack8(const f32x4& v0, const f32x4& v1) { u32x4 w; w.x = pk2(v0[0], v0[1]); w.y = pk2(v0[2], v0[3]); w.z = pk2(v1[0], v1[1]); w.w = pk2(v1[2], v1[3]); return w; }
__device__ __forceinline__ void unpack8(const u32x4& w, f32x4& v0, f32x4& v1) {
    v0[0] = __uint_as_float(w.x << 16); v0[1] = __uint_as_float(w.x & 0xffff0000u); v0[2] = __uint_as_float(w.y << 16); v0[3] = __uint_as_float(w.y & 0xffff0000u);
    v1[0] = __uint_as_float(w.z << 16); v1[1] = __uint_as_float(w.z & 0xffff0000u); v1[2] = __uint_as_float(w.w << 16); v1[3] = __uint_as_float(w.w & 0xffff0000u); }

__device__ __forceinline__ void unpack8_f8(const u32x2& w, f32x4& v0, f32x4& v1) {
    v0[0] = (float)(w.x & 255u); v0[1] = (float)((w.x >> 8) & 255u); v0[2] = (float)((w.x >> 16) & 255u); v0[3] = (float)(w.x >> 24);
    v1[0] = (float)(w.y & 255u); v1[1] = (float)((w.y >> 8) & 255u); v1[2] = (float)((w.y >> 16) & 255u); v1[3] = (float)(w.y >> 24); }
__device__ __forceinline__ void wide_store16(bf16_t* rowp  , size_t pitch8  , const u32x4& P0, const u32x4& P1) {
    u32x4 S1, S2;
#pragma unroll
    for (int d = 0; d < 4; ++d) { S1[d] = (unsigned)__builtin_amdgcn_update_dpp((int)P0[d], (int)P1[d], 0x128, 0xf, 0xc, false); S2[d] = (unsigned)__builtin_amdgcn_update_dpp((int)P1[d], (int)P0[d], 0x128, 0xf, 0x3, false); }
#ifdef NT_STORES
    __builtin_nontemporal_store(S1, (u32x4*)rowp); __builtin_nontemporal_store(S2, (u32x4*)(rowp + pitch8)); }
#else
    *(u32x4*)rowp = S1; *(u32x4*)(rowp + pitch8) = S2; }
#endif
struct EpiInProj {
    static constexpr bool PERM = true, NODUP = false, F8 = (FP8_IN == 1), I8 = (FP8_IN == 2), ROWAUX = I8, COLAUX = (COL_AUX != 0), WIDE = (WIDE_ST != 0); static constexpr int DUPBIT = 1;
    bf16_t* Z; const float* bgate; const float* rows; float sw_in, sw_gate; const LAS float* rbuf;
    __device__ __forceinline__ void aux_issue(const pg8::Unit& u, LAS unsigned* buf, int wid, int lane) const {
        __builtin_amdgcn_global_load_lds((const unsigned*)(rows + (size_t)u.pm * 256 + 64 * (wid & 3) + lane), buf + 64 * (wid & 3), 4, 0, 0); }
    __device__ __forceinline__ void aux_buf(const LAS unsigned* buf) { rbuf = (const LAS float*)buf; }
    const LAS float* cbuf = nullptr;
    unsigned char* G8 = nullptr;
    __device__ __forceinline__ void caux_issue(const pg8::Unit& u, LAS unsigned* buf, int wid, int lane) const {
        if (u.pn >= 20) __builtin_amdgcn_global_load_lds((const unsigned*)(bgate + (u.pn - 20) * 256 + 64 * (wid & 3) + lane), buf + 64 * (wid & 3), 4, 0, 0); }
    __device__ __forceinline__ void caux_buf(const LAS unsigned* buf) { cbuf = (const LAS float*)buf; }
#ifdef PROBE_SKIP_EPI
    int skip = 0;
#endif
    __device__ __forceinline__ bool keep(const pg8::Unit&) const { return false; }
    __device__ __forceinline__ void operator()(f32x4 (&acc)[2][2][4][2], const pg8::Unit& u, int wr, int wc, int fr, int fq) const {
#ifdef PROBE_SKIP_EPI
        if (skip == 1) return;
#endif
        const int row0 = u.pm * 256 + wr * 64 + fr, col0 = u.pn * 256 + (WIDE ? wc * 64 : wc * 32) + 8 * fq; constexpr int BJ = WIDE ? 32 : 128;
        const int mode = (u.pn >= 20) ? 2 : ((u.pn < 2 || (u.pn >= 6 && u.pn < 8)) ? 1 : 0);
        f32x4 bv[2][2];
#pragma unroll
        for (int bj = 0; bj < 2; ++bj)
#pragma unroll
            for (int n = 0; n < 2; ++n) bv[bj][n] = (mode == 2) ? (COLAUX ? *(const LAS f32x4*)(cbuf + (col0 - u.pn * 256) + bj * BJ + 4 * n) : *(const f32x4*)(bgate + (col0 - ZC_G) + bj * BJ + 4 * n)) : (f32x4){0.f, 0.f, 0.f, 0.f};
        const float sc = (mode == 1) ? C2 : 1.0f;
        constexpr float dq = F8 ? 1.0f / (Q_H1 * Q_WIN) : 1.0f;
        float rsc[2][4];
        if constexpr (I8) { const float sw = ((mode == 2) ? sw_gate : sw_in) * sc;
#pragma unroll
            for (int ai = 0; ai < 2; ++ai)
#pragma unroll
                for (int m = 0; m < 4; ++m) rsc[ai][m] = rbuf[wr * 64 + fr + ai * 128 + m * 16] * sw; }
#pragma unroll
        for (int ai = 0; ai < 2; ++ai)
#pragma unroll
            for (int m = 0; m < 4; ++m) { bf16_t* rowp = Z + (size_t)(row0 + ai * 128 + m * 16) * ZP + col0; u32x4 P[2]; u32x2 GQ[2] = {{0u, 0u}, {0u, 0u}};
#pragma unroll
                for (int bj = 0; bj < 2; ++bj) { f32x4 v0, v1;
                    if constexpr (I8) { f32x4 c0, c1;
#pragma unroll
                        for (int i = 0; i < 4; ++i) { c0[i] = (float)__float_as_int(acc[ai][bj][m][0][i]); c1[i] = (float)__float_as_int(acc[ai][bj][m][1][i]); }
                        v0 = c0 * rsc[ai][m] + bv[bj][0]; v1 = c1 * rsc[ai][m] + bv[bj][1]; }
                    else { v0 = acc[ai][bj][m][0] * (dq * sc) + bv[bj][0]; v1 = acc[ai][bj][m][1] * (dq * sc) + bv[bj][1]; }
                    if (mode == 2) { const f32x4 t0 = v0 * (-LOG2E), t1 = v1 * (-LOG2E); f32x4 e0, e1;
#pragma unroll
                        for (int i = 0; i < 4; ++i) { e0[i] = fexp2(t0[i]); e1[i] = fexp2(t1[i]); }
                        e0 = e0 + 1.0f; e1 = e1 + 1.0f;
#pragma unroll
                        for (int i = 0; i < 4; ++i) { v0[i] = frcp(e0[i]); v1[i] = frcp(e1[i]); } }
                    if (FP8_G && WIDE && mode == 2) { const f32x4 g0 = v0 * Q_G, g1 = v1 * Q_G; GQ[bj].x = pk4_u8(g0[0], g0[1], g0[2], g0[3]); GQ[bj].y = pk4_u8(g1[0], g1[1], g1[2], g1[3]); }
                    P[bj] = pack8(v0, v1);
                    if constexpr (!WIDE) *(u32x4*)(rowp + bj * 128) = P[bj]; }
#ifdef PROBE_SKIP_EPI
                if (skip == 2) { asm volatile("" :: "v"(P[0]), "v"(P[1])); } else
                if (skip == 3) { wide_store16((bf16_t*)((unsigned char*)Z + 641ull * 1048576ull) + (size_t)((wr * 64 + ai * 128 + m * 16 + (fr & 7)) & 63) * ZP + col0 + 32 * (fr >> 3), (size_t)8 * ZP, P[0], P[1]); } else
#endif
                if (FP8_G && WIDE && mode == 2) {
                    const auto r0 = __builtin_amdgcn_permlane16_swap(GQ[1].x, GQ[0].x, false, false), r1 = __builtin_amdgcn_permlane16_swap(GQ[1].y, GQ[0].y, false, false);
                    u32x4 w; w.x = r0[0]; w.y = r1[0]; w.z = r0[1]; w.w = r1[1];
                    *(u32x4*)(G8 + (size_t)(row0 + ai * 128 + m * 16) * 3072 + (u.pn - 20) * 256 + wc * 64 + ((fq & 1) ? 8 * (fq - 1) : 32 + 8 * fq)) = w; }
                else
                if constexpr (WIDE) wide_store16(Z + (size_t)(u.pm * 256 + wr * 64 + ai * 128 + m * 16 + (fr & 7)) * ZP + col0 + 32 * (fr >> 3), (size_t)8 * ZP, P[0], P[1]); }
    }
};
struct EpiMerge {
    static constexpr bool PERM = true, NODUP = true, F8 = (FP8_MRG != 0), I8 = false, ROWAUX = false, COLAUX = false, WIDE = false; static constexpr int DUPBIT = 0;
    const bf16_t* Z; bf16_t* MG; const bf16_t* ONES;
    __device__ __forceinline__ bool keep(const pg8::Unit& u) const { return u.aux != 2; }
    __device__ __forceinline__ void operator()(f32x4 (&acc)[2][2][4][2], const pg8::Unit& u, int wr, int wc, int fr, int fq) const {
        const int row0 = u.pm * 256 + wr * 64 + fr, col0 = u.pn * 256 + wc * 32 + 8 * fq, seg = u.aux;
        const bool fin = (seg == 2);
        const char* nb = (const char*)Z; const char* db = fin ? (const char*)ONES : (const char*)Z;
        constexpr unsigned GP = FP8_G ? 3072u : (unsigned)ZP * 2u, GB = FP8_G ? 1u : 2u;
        const unsigned on0 = (unsigned)row0 * GP + ((FP8_G ? 0 : ZC_G) + seg * 1024 + col0) * GB;
        const unsigned od0 = fin ? (unsigned)(8 * fq) * GB : (unsigned)row0 * GP + ((FP8_G ? 0 : ZC_G) + (seg + 1) * 1024 + col0) * GB;
        const unsigned dmul = fin ? 0u : 1u;
#pragma unroll
        for (int ai = 0; ai < 2; ++ai)
#pragma unroll
          for (int mh = 0; mh < 2; ++mh) {
            u32x4 gw[2][2], dw[2][2]; u32x2 g8[2][2], d8[2][2];
#pragma unroll
            for (int mm = 0; mm < 2; ++mm)
#pragma unroll
                for (int bj = 0; bj < 2; ++bj) { const unsigned ad = (unsigned)(ai * 128 + (2 * mh + mm) * 16) * GP + (unsigned)(bj * 128) * GB;
                    if (FP8_G) { g8[mm][bj] = *(const u32x2*)(nb + (size_t)(on0 + ad)); d8[mm][bj] = *(const u32x2*)(db + (size_t)(od0 + ad * dmul)); }
                    else { gw[mm][bj] = *(const u32x4*)(nb + (size_t)(on0 + ad)); dw[mm][bj] = *(const u32x4*)(db + (size_t)(od0 + ad * dmul)); } }
#pragma unroll
            for (int mm = 0; mm < 2; ++mm)
#pragma unroll
                for (int bj = 0; bj < 2; ++bj) { const int m = 2 * mh + mm; f32x4 n0, n1, d0, d1;
                    if (FP8_G) { unpack8_f8(g8[mm][bj], n0, n1); unpack8_f8(d8[mm][bj], d0, d1); } else { unpack8(gw[mm][bj], n0, n1); unpack8(dw[mm][bj], d0, d1); }
#pragma unroll
                    for (int i = 0; i < 4; ++i) { n0[i] = fmaxf(n0[i], 1e-18f) * frcp(fmaxf(d0[i], 1e-18f)); n1[i] = fmaxf(n1[i], 1e-18f) * frcp(fmaxf(d1[i], 1e-18f)); }
                    acc[ai][bj][m][0] = acc[ai][bj][m][0] * n0; acc[ai][bj][m][1] = acc[ai][bj][m][1] * n1; }
            asm volatile("" ::: "memory");
          }
        if (fin) {
#pragma unroll
            for (int ai = 0; ai < 2; ++ai)
#pragma unroll
                for (int m = 0; m < 4; ++m) { bf16_t* rowp = MG + (size_t)(row0 + ai * 128 + m * 16) * D + col0;
#pragma unroll
                    for (int bj = 0; bj < 2; ++bj) { constexpr float dq = F8 ? 1.0f / (Q_O * Q_WP) : 1.0f; *(u32x4*)(rowp + bj * 128) = pack8(acc[ai][bj][m][0] * dq, acc[ai][bj][m][1] * dq); } } }
    }
};
struct EpiBf16 {
    static constexpr bool PERM = true, NODUP = false, F8 = false, I8 = false, ROWAUX = false, COLAUX = false, WIDE = (WIDE_ST != 0); static constexpr int DUPBIT = 2;
    bf16_t* C; int ldc;
    __device__ __forceinline__ bool keep(const pg8::Unit&) const { return false; }
    __device__ __forceinline__ void operator()(f32x4 (&acc)[2][2][4][2], const pg8::Unit& u, int wr, int wc, int fr, int fq) const {
        const int row0 = u.pm * 256 + wr * 64 + fr, col0 = u.pn * 256 + (WIDE ? wc * 64 : wc * 32) + 8 * fq;
#pragma unroll
        for (int ai = 0; ai < 2; ++ai)
#pragma unroll
            for (int m = 0; m < 4; ++m) {
                if constexpr (WIDE) wide_store16(C + (size_t)(u.pm * 256 + wr * 64 + ai * 128 + m * 16 + (fr & 7)) * ldc + col0 + 32 * (fr >> 3), (size_t)8 * ldc, pack8(acc[ai][0][m][0], acc[ai][0][m][1]), pack8(acc[ai][1][m][0], acc[ai][1][m][1]));
                else { bf16_t* rowp = C + (size_t)(row0 + ai * 128 + m * 16) * ldc + col0;
#pragma unroll
                for (int bj = 0; bj < 2; ++bj) *(u32x4*)(rowp + bj * 128) = pack8(acc[ai][bj][m][0], acc[ai][bj][m][1]); } }
    }
};
struct EpiGU {
    static constexpr bool PERM = true, NODUP = false, F8 = (FP8_MOE != 0), I8 = false, ROWAUX = false, COLAUX = (COL_AUX != 0), WIDE = false; static constexpr int DUPBIT = 4;
    unsigned char* ACT; const float* bgu;
    const LAS float* cbuf = nullptr;
    __device__ __forceinline__ void caux_issue(const pg8::Unit& u, LAS unsigned* buf, int wid, int lane) const {
        const int w = wid & 3; __builtin_amdgcn_global_load_lds((const unsigned*)(bgu + (size_t)u.aux * 2048 + (w >> 1) * 1024 + u.pn * 128 + (w & 1) * 64 + lane), buf + 64 * w, 4, 0, 0); }
    __device__ __forceinline__ void caux_buf(const LAS unsigned* buf) { cbuf = (const LAS float*)buf; }
    __device__ __forceinline__ bool keep(const pg8::Unit&) const { return false; }
    __device__ __forceinline__ void operator()(f32x4 (&acc)[2][2][4][2], const pg8::Unit& u, int wr, int wc, int fr, int fq) const {
        const int row0 = u.pm * 256 + wr * 64 + fr, cc = u.pn * 128 + wc * 32 + 8 * fq;
        const float* bg = bgu + (size_t)u.aux * 2048 + cc;
        f32x4 bg0, bg1, bu0, bu1;
        if constexpr (COLAUX) { const LAS float* cb = cbuf + wc * 32 + 8 * fq; bg0 = *(const LAS f32x4*)cb; bg1 = *(const LAS f32x4*)(cb + 4); bu0 = *(const LAS f32x4*)(cb + 128); bu1 = *(const LAS f32x4*)(cb + 132); }
        else { bg0 = *(const f32x4*)bg; bg1 = *(const f32x4*)(bg + 4); bu0 = *(const f32x4*)(bg + 1024); bu1 = *(const f32x4*)(bg + 1028); }
        float dq = F8 ? 1.0f / (Q_H2 * Q_WGU) : 1.0f; asm volatile("" : "+s"(dq));
#pragma unroll
        for (int ai = 0; ai < 2; ++ai)
#pragma unroll
            for (int m = 0; m < 4; ++m) {
                f32x4 o0, o1;
                { const f32x4 g = acc[ai][0][m][0] * dq + bg0, uu = acc[ai][1][m][0] * dq + bu0; f32x4 ga, up, e;
#pragma unroll
                  for (int i = 0; i < 4; ++i) { ga[i] = fminf(g[i], 7.0f); up[i] = fminf(fmaxf(uu[i], -7.0f), 7.0f); }
                  const f32x4 t = ga * (-1.702f * LOG2E);
#pragma unroll
                  for (int i = 0; i < 4; ++i) e[i] = fexp2(t[i]);
                  const f32x4 dn = e + 1.0f; f32x4 r;
#pragma unroll
                  for (int i = 0; i < 4; ++i) r[i] = frcp(dn[i]);
                  o0 = (up + 1.0f) * (ga * r); }
                { const f32x4 g = acc[ai][0][m][1] * dq + bg1, uu = acc[ai][1][m][1] * dq + bu1; f32x4 ga, up, e;
#pragma unroll
                  for (int i = 0; i < 4; ++i) { ga[i] = fminf(g[i], 7.0f); up[i] = fminf(fmaxf(uu[i], -7.0f), 7.0f); }
                  const f32x4 t = ga * (-1.702f * LOG2E);
#pragma unroll
                  for (int i = 0; i < 4; ++i) e[i] = fexp2(t[i]);
                  const f32x4 dn = e + 1.0f; f32x4 r;
#pragma unroll
                  for (int i = 0; i < 4; ++i) r[i] = frcp(dn[i]);
                  o1 = (up + 1.0f) * (ga * r); }
                if constexpr (F8) { const f32x4 q0 = o0 * Q_ACT, q1 = o1 * Q_ACT; u32x2 w; w.x = pk4_f8_nc(q0[0], q0[1], q0[2], q0[3]); w.y = pk4_f8_nc(q1[0], q1[1], q1[2], q1[3]);
                    *(u32x2*)(ACT + (size_t)(row0 + ai * 128 + m * 16) * D + cc) = w; }
                else *(u32x4*)((bf16_t*)ACT + (size_t)(row0 + ai * 128 + m * 16) * D + cc) = pack8(o0, o1); }
    }
};
struct EpiDown {
    static constexpr bool PERM = true, NODUP = false, F8 = (FP8_MOE != 0), I8 = false, ROWAUX = false, COLAUX = (COL_AUX != 0), WIDE = (WIDE_ST != 0 && FP8_YB != 0); static constexpr int DUPBIT = 8;
    unsigned char* YB; const float* bdn;
    const LAS float* cbuf = nullptr;
    __device__ __forceinline__ void caux_issue(const pg8::Unit& u, LAS unsigned* buf, int wid, int lane) const {
        __builtin_amdgcn_global_load_lds((const unsigned*)(bdn + (size_t)u.aux * D + u.pn * 256 + 64 * (wid & 3) + lane), buf + 64 * (wid & 3), 4, 0, 0); }
    __device__ __forceinline__ void caux_buf(const LAS unsigned* buf) { cbuf = (const LAS float*)buf; }
    __device__ __forceinline__ bool keep(const pg8::Unit&) const { return false; }
    __device__ __forceinline__ void operator()(f32x4 (&acc)[2][2][4][2], const pg8::Unit& u, int wr, int wc, int fr, int fq) const {
        const int row0 = u.pm * 256 + wr * 64 + fr, col0 = u.pn * 256 + (WIDE ? wc * 64 : wc * 32) + 8 * fq; constexpr int BJ = WIDE ? 32 : 128;
        const float* bp = bdn + (size_t)u.aux * D + col0;
        f32x4 bv[2][2];
        constexpr float dq = (F8 ? 1.0f / (Q_ACT * Q_WDN) : 1.0f) * (FP8_YB ? Q_YB : 1.0f);
#pragma unroll
        for (int bj = 0; bj < 2; ++bj)
#pragma unroll
            for (int n = 0; n < 2; ++n) bv[bj][n] = (COLAUX ? *(const LAS f32x4*)(cbuf + (col0 - u.pn * 256) + bj * BJ + 4 * n) : *(const f32x4*)(bp + bj * BJ + 4 * n)) * (FP8_YB ? Q_YB : 1.0f);
#pragma unroll
        for (int ai = 0; ai < 2; ++ai)
#pragma unroll
            for (int m = 0; m < 4; ++m) {
                if constexpr (FP8_YB != 0) { unsigned char* rowp = YB + (size_t)(row0 + ai * 128 + m * 16) * D + col0; u32x2 Q[2];
#pragma unroll
                    for (int bj = 0; bj < 2; ++bj) { const f32x4 v0 = acc[ai][bj][m][0] * dq + bv[bj][0], v1 = acc[ai][bj][m][1] * dq + bv[bj][1];
                        Q[bj].x = pk4_f8(v0[0], v0[1], v0[2], v0[3]); Q[bj].y = pk4_f8(v1[0], v1[1], v1[2], v1[3]); if constexpr (!WIDE) *(u32x2*)(rowp + bj * 128) = Q[bj]; }
                    if constexpr (WIDE) {
                        const auto r0 = __builtin_amdgcn_permlane16_swap(Q[1].x, Q[0].x, false, false), r1 = __builtin_amdgcn_permlane16_swap(Q[1].y, Q[0].y, false, false);
                        u32x4 w; w.x = r0[0]; w.y = r1[0]; w.z = r0[1]; w.w = r1[1];
                        *(u32x4*)(YB + (size_t)(row0 + ai * 128 + m * 16) * D + u.pn * 256 + wc * 64 + ((fq & 1) ? 8 * (fq - 1) : 32 + 8 * fq)) = w; } }
                else { bf16_t* rowp = (bf16_t*)YB + (size_t)(row0 + ai * 128 + m * 16) * D + col0;
#pragma unroll
                for (int bj = 0; bj < 2; ++bj) *(u32x4*)(rowp + bj * 128) = pack8(acc[ai][bj][m][0] * dq + bv[bj][0], acc[ai][bj][m][1] * dq + bv[bj][1]); } }
    }
};

__device__ __forceinline__ void fcumsum_wave(const AR a, int bh, int lane) {
    const int b = bh >> 3, h = bh & 7;
    const float* logf = (const float*)(a.ws() + WS_LOGF) + ((size_t)b * SEQ + 32 * lane) * 8 + h;
    float v[32]; float run = 0.f;
#pragma unroll
    for (int i = 0; i < 32; ++i) { run += logf[i * 8]; v[i] = run; }
    float inc = run;
#pragma unroll
    for (int o = 1; o < 64; o <<= 1) { const float t = shup(lane, inc, o); if (lane >= o) inc += t; }
    const float base = inc - run;
    float* F2 = (float*)(a.ws() + WS_F2) + (size_t)bh * SEQ + 32 * lane;
#pragma unroll
    for (int i = 0; i < 32; i += 4) { f32x4 o = {(base + v[i]) * LOG2E, (base + v[i + 1]) * LOG2E, (base + v[i + 2]) * LOG2E, (base + v[i + 3]) * LOG2E}; *(f32x4*)(F2 + i) = o; }
}

__device__ __forceinline__ int crow(int r, int hi) { return (r & 3) + 8 * (r >> 2) + 4 * hi; }
#define MFMA32(a, b, c) __builtin_amdgcn_mfma_f32_32x32x16_bf16(a, b, c, 0, 0, 0)

constexpr int LRU_WB = 13312;
constexpr int LRU_CW = 8 * LRU_WB;
constexpr int LRU_BF = LRU_CW + 2048;
__device__ __forceinline__ void lru_unit(const AR a, int l, int b, int n, LAS unsigned char* lds, int tid, int wave, int lane) {
    const int r32 = lane & 31, hi = lane >> 5;
    LAS unsigned char* wb = lds + wave * LRU_WB;
    LAS unsigned short* XS = (LAS unsigned short*)wb; LAS unsigned short* GS = (LAS unsigned short*)(wb + 8704); LAS unsigned short* OS = XS; LAS float* XF = (LAS float*)wb;
    LAS unsigned char* BF = lds + LRU_BF;
    LAS float* CWT = (LAS float*)(lds + LRU_CW); LAS float* CBT = CWT + 256;
    LAS float* CAR = (LAS float*)(lds + MISC_OFF + MO_CAR);
    const bf16_t* Z = (const bf16_t*)(a.ws() + WS_Z); bf16_t* O = (bf16_t*)(a.ws() + WS_O);
    const int chb = n * 64;
    __syncthreads();
    if (tid < 256) CWT[tid] = a.in(I_CONVW)[(size_t)l * 4 * D + (tid >> 6) * D + chb + (tid & 63)];
    else if (tid < 320) CBT[tid - 256] = a.in(I_CONVB)[(size_t)l * D + chb + (tid - 256)];
#pragma unroll
    for (int q = 0; q < 2; ++q) { const int f = 2 * wave + q, mat = f >> 3, ks = (f >> 1) & 3, nt = f & 1, d = 32 * nt + r32, c0 = 16 * ks + 8 * hi;
        const float* w = a.in(mat ? I_WX : I_WA) + ((size_t)l * 16 + n) * 4096; u32x4 p;
        p.x = pk2(w[(c0 + 0) * 64 + d], w[(c0 + 1) * 64 + d]); p.y = pk2(w[(c0 + 2) * 64 + d], w[(c0 + 3) * 64 + d]); p.z = pk2(w[(c0 + 4) * 64 + d], w[(c0 + 5) * 64 + d]); p.w = pk2(w[(c0 + 6) * 64 + d], w[(c0 + 7) * 64 + d]);
        *(LAS u32x4*)(BF + f * 1024 + lane * 16) = p; }
    float ba[2], bx[2], cl[2], csup[2];
    { const float* pba = a.in(I_BA) + (size_t)l * D + chb + r32; const float* pbx = a.in(I_BX) + (size_t)l * D + chb + r32; const float* plm = a.in(I_LAM) + (size_t)l * D + chb + r32;
      const float ba0 = pba[0], ba1 = pba[32], bx0 = pbx[0], bx1 = pbx[32], lm0 = plm[0], lm1 = plm[32];
      ba[0] = ba0; ba[1] = ba1; bx[0] = bx0; bx[1] = bx1; csup[0] = 0.f; csup[1] = 0.f;
      cl[0] = -8.0f * (fmaxf(-lm0, 0.f) + 0.6931471806f * flog2(1.0f + fexp2(-LOG2E * fabsf(lm0))));
      cl[1] = -8.0f * (fmaxf(-lm1, 0.f) + 0.6931471806f * flog2(1.0f + fexp2(-LOG2E * fabsf(lm1)))); }
    __syncthreads();
    int par = 0;
    u32x4 xsr[5], gsr[4];
#define LRU_LOADROWS(S) do { const int t0_ = 256 * (S) + 32 * wave; const size_t m0_ = (size_t)b * SEQ + t0_; \
        _Pragma("unroll") for (int it = 0; it < 5; ++it) { const int c = lane + 64 * it; const int rr = c >> 3, c8 = c & 7; xsr[it] = (u32x4){0u, 0u, 0u, 0u}; \
            if (c < 280 && t0_ - 3 + rr >= 0) xsr[it] = *(const u32x4*)(Z + (m0_ - 3 + rr) * ZP + ZC_XC + chb + 8 * c8); } \
        _Pragma("unroll") for (int it = 0; it < 4; ++it) { const int c = lane + 64 * it; const int rr = c >> 3, c8 = c & 7; gsr[it] = *(const u32x4*)(Z + (m0_ + rr) * ZP + ZC_GC + chb + 8 * c8); } } while (0)
    LRU_LOADROWS(0);
    for (int s = 0; s < 8; ++s) {
        const int t0 = 256 * s + 32 * wave; const size_t m0 = (size_t)b * SEQ + t0;
#pragma unroll
        for (int it = 0; it < 5; ++it) { const int c = lane + 64 * it; if (c < 280) { const int rr = c >> 3, c8 = c & 7; *(LAS u32x4*)((LAS unsigned char*)XS + rr * 144 + c8 * 16) = xsr[it]; } }
#pragma unroll
        for (int it = 0; it < 4; ++it) { const int c = lane + 64 * it; const int rr = c >> 3, c8 = c & 7; *(LAS u32x4*)((LAS unsigned char*)GS + rr * 144 + c8 * 16) = gsr[it]; }
        if (s < 7) LRU_LOADROWS(s + 1);
        LDS_WAIT(); asm volatile("" ::: "memory");
        f32x16 accA[2], accX[2];
#pragma unroll
        for (int nt = 0; nt < 2; ++nt) { accA[nt] = f32x16{}; accX[nt] = f32x16{}; }
        f32x4 xo[4][2];
#pragma unroll
        for (int ks = 0; ks < 4; ++ks) { const int c0 = 16 * ks + 8 * hi;
            f32x4 o0 = *(const LAS f32x4*)(CBT + c0), o1 = *(const LAS f32x4*)(CBT + c0 + 4);
#pragma unroll
            for (int j = 0; j < 4; ++j) { const u32x4 xw = *(const LAS u32x4*)((LAS unsigned char*)XS + (r32 + j) * 144 + c0 * 2); f32x4 x0, x1; unpack8(xw, x0, x1);
                const f32x4 w0 = *(const LAS f32x4*)(CWT + j * 64 + c0), w1 = *(const LAS f32x4*)(CWT + j * 64 + c0 + 4);
                o0 = o0 + x0 * w0; o1 = o1 + x1 * w1; }
            xo[ks][0] = o0; xo[ks][1] = o1;
            const bf16x8 af = __builtin_bit_cast(bf16x8, pack8(o0, o1));
#pragma unroll
            for (int nt = 0; nt < 2; ++nt) { const bf16x8 bwa = *(const LAS bf16x8*)(BF + (ks * 2 + nt) * 1024 + lane * 16), bwx = *(const LAS bf16x8*)(BF + (8 + ks * 2 + nt) * 1024 + lane * 16);
                accA[nt] = MFMA32(af, bwa, accA[nt]); accX[nt] = MFMA32(af, bwx, accX[nt]); } }
        LDS_WAIT(); asm volatile("" ::: "memory");
#pragma unroll
        for (int ks = 0; ks < 4; ++ks) { const int c0 = 16 * ks + 8 * hi; *(LAS f32x4*)(XF + r32 * 68 + c0) = xo[ks][0]; *(LAS f32x4*)(XF + r32 * 68 + c0 + 4) = xo[ks][1]; }
        LDS_WAIT(); asm volatile("" ::: "memory");
        float av[2][16], uv[2][16], TA[2], TH[2];
#pragma unroll
        for (int nt = 0; nt < 2; ++nt) { const int d = 32 * nt + r32;
#pragma unroll
            for (int r = 0; r < 16; ++r) { const int row = crow(r, hi);
                const float xc = XF[row * 68 + d];
                const float rg = fsigmoid(accA[nt][r] + ba[nt]), ig = fsigmoid(accX[nt][r] + bx[nt]);
                const float la = cl[nt] * rg, aa = fexp2(la * LOG2E), x2 = 2.0f * la;
                const float om = (x2 > -0.1f) ? -x2 * (1.0f + x2 * (0.5f + x2 * (0.16666667f + x2 * 0.041666668f))) : 1.0f - aa * aa;
                av[nt][r] = aa; uv[nt][r] = sqrtf(om) * (ig * xc);
                if ((r & 3) == 3) asm volatile("" ::: "memory"); }
            float GA[4], GH[4], oA[4], oH[4], cown[4], pown[4];
#pragma unroll
            for (int gi = 0; gi < 4; ++gi) { float hh = 0.f, pp = 1.f;
#pragma unroll
                for (int q = 0; q < 4; ++q) { const int r = 4 * gi + q; hh = av[nt][r] * hh + uv[nt][r]; pp = pp * av[nt][r]; uv[nt][r] = hh; av[nt][r] = pp; }
                GA[gi] = pp; GH[gi] = hh; oA[gi] = shx(lane, pp, 32); oH[gi] = shx(lane, hh, 32); cown[gi] = 0.f; pown[gi] = 1.f; }
            float cin = 0.f, pin = 1.f;
#pragma unroll
            for (int tg = 0; tg < 8; ++tg) { const int gi = tg >> 1; const bool own = ((tg & 1) == hi);
                const float A = own ? GA[gi] : oA[gi], H = own ? GH[gi] : oH[gi];
                cown[gi] = own ? cin : cown[gi]; pown[gi] = own ? pin : pown[gi];
                cin = A * cin + H; pin = A * pin; }
#pragma unroll
            for (int r = 0; r < 16; ++r) { uv[nt][r] = uv[nt][r] + av[nt][r] * cown[r >> 2]; av[nt][r] = av[nt][r] * pown[r >> 2]; }
            TA[nt] = pin; TH[nt] = cin;
            if (hi == 0) { CAR[((par * 8 + wave) * 64 + d) * 2] = pin; CAR[((par * 8 + wave) * 64 + d) * 2 + 1] = cin; } }
        __syncthreads();
#pragma unroll
        for (int nt = 0; nt < 2; ++nt) { const int d = 32 * nt + r32; float cw = csup[nt], call = csup[nt];
#pragma unroll
            for (int w2 = 0; w2 < 8; ++w2) { const f32x2 ah = *(const LAS f32x2*)(CAR + ((par * 8 + w2) * 64 + d) * 2);
                call = ah[0] * call + ah[1]; if (w2 < wave) cw = call; }
            csup[nt] = call;
#pragma unroll
            for (int r = 0; r < 16; ++r) { const int row = crow(r, hi);
                const float hf = uv[nt][r] + av[nt][r] * cw;
                const float g = bf2f((unsigned)GS[row * 72 + d]);
                const float ge = g * fsigmoid(1.5957691216f * (g + 0.044715f * g * g * g));
                if (FP8_MRG) ((LAS unsigned char*)OS)[row * 80 + d] = f8_byte(hf * ge * Q_O); else OS[row * 72 + d] = (unsigned short)f2bf(hf * ge); } }
        LDS_WAIT(); asm volatile("" ::: "memory");
        if (FP8_MRG) {
#pragma unroll
            for (int it = 0; it < 2; ++it) { const int c = lane + 64 * it; const int rr = c >> 2, c4 = c & 3;
                *(u32x4*)((unsigned char*)O + (m0 + rr) * OP + 1024 + chb + 16 * c4) = *(const LAS u32x4*)((LAS unsigned char*)OS + rr * 80 + c4 * 16); } }
        else {
#pragma unroll
        for (int it = 0; it < 4; ++it) { const int c = lane + 64 * it; const int rr = c >> 3, c8 = c & 7;
            *(u32x4*)(O + (m0 + rr) * OP + 1024 + chb + 8 * c8) = *(const LAS u32x4*)((LAS unsigned char*)OS + rr * 144 + c8 * 16); } }
        par ^= 1;
    }
}

constexpr int AT_KS = 0, AT_VT = 9216, AT_FS = 17920, AT_WSF = 18432, AT_FLAG = 20480;
template <int MODE>
__device__ __forceinline__ void attn_unit(const AR a, int b, int h, int qb, LAS unsigned char* lds, int tid, int wave, int lane) {
    const int r32 = lane & 31, hi = lane >> 5;
    const bf16_t* Z = (const bf16_t*)(a.ws() + WS_Z); bf16_t* O = (bf16_t*)(a.ws() + WS_O);
    const float* F2 = (const float*)(a.ws() + WS_F2) + (size_t)(b * 8 + h) * SEQ;
    const size_t rowbase = (size_t)b * SEQ; const int q0 = qb * 256, qw0 = q0 + 32 * wave, q = qw0 + r32;
    const int qcol = (MODE == 0 ? ZC_QA : ZC_QB) + h * 64, kcol = (MODE == 0 ? ZC_KA : ZC_KB) + h * 64, vcol = (MODE == 0 ? ZC_VA : ZC_VB) + h * 64, ocol = (MODE == 0 ? 0 : 512) + h * 64;
    LAS unsigned char* KS = lds + AT_KS; LAS unsigned short* VT = (LAS unsigned short*)(lds + AT_VT); LAS float* FS = (LAS float*)(lds + AT_FS);
    LAS float* wsf = (LAS float*)(lds + AT_WSF) + wave * 64; LAS int* flags = (LAS int*)(lds + AT_FLAG);
    bf16x8 qr[4];
#pragma unroll
    for (int ks = 0; ks < 4; ++ks) qr[ks] = *(const bf16x8*)(Z + (rowbase + q) * ZP + qcol + 16 * ks + 8 * hi);
    const float fq = (MODE == 0) ? F2[q] : 0.f;
    f32x16 o0 = f32x16{}, o1 = f32x16{};
    float mrun = -INFINITY, lsum = 0.f, R = 0.f;
    const int NT = 4 * qb + 4;
    const int lkey = tid >> 3, lch = tid & 7;
    const bf16_t* kp = Z + (rowbase + lkey) * ZP + kcol + 8 * lch; const bf16_t* vp = Z + (rowbase + lkey) * ZP + vcol + 8 * lch;
    u32x4 kreg = *(const u32x4*)(kp + (size_t)(NT - 1) * 64 * ZP), vreg = *(const u32x4*)(vp + (size_t)(NT - 1) * 64 * ZP);
    float freg = 0.f; if (MODE == 0 && tid < 64) freg = F2[(NT - 1) * 64 + tid];
    bool wdone = false;
    __syncthreads();
    for (int jt = NT - 1; jt >= 0; --jt) {
        *(LAS u32x4*)(KS + lkey * 144 + lch * 16) = kreg;
        { const unsigned vv[4] = {vreg.x, vreg.y, vreg.z, vreg.w};
#pragma unroll
          for (int i = 0; i < 4; ++i) { VT[(8 * lch + 2 * i) * 68 + lkey] = (unsigned short)(vv[i] & 0xffffu); VT[(8 * lch + 2 * i + 1) * 68 + lkey] = (unsigned short)(vv[i] >> 16); } }
        if (MODE == 0 && tid < 64) FS[tid] = freg;
        if (MODE == 1 && lane == 0) flags[wave] = wdone ? 1 : 0;
        __syncthreads();
        if (MODE == 1) { int all = 1;
#pragma unroll
            for (int w2 = 0; w2 < 8; ++w2) all &= flags[w2];
            if (all) break; }
        if (jt > 0) { kreg = *(const u32x4*)(kp + (size_t)(jt - 1) * 64 * ZP); vreg = *(const u32x4*)(vp + (size_t)(jt - 1) * 64 * ZP); if (MODE == 0 && tid < 64) freg = F2[(jt - 1) * 64 + tid]; }
        const int k0 = jt * 64;
        const bool active = (MODE == 0) ? (k0 <= qw0 + 31) : ((k0 < qw0 + 31) && !wdone);
        if (active) {
            f32x16 p0 = f32x16{}, p1 = f32x16{};
#pragma unroll
            for (int ks = 0; ks < 4; ++ks) { const bf16x8 ka = *(const LAS bf16x8*)(KS + r32 * 144 + (16 * ks + 8 * hi) * 2), kb = *(const LAS bf16x8*)(KS + (r32 + 32) * 144 + (16 * ks + 8 * hi) * 2);
                p0 = MFMA32(ka, qr[ks], p0); p1 = MFMA32(kb, qr[ks], p1); }
            if (MODE == 0) {
                float rm = -INFINITY;
#pragma unroll
                for (int g = 0; g < 4; ++g) { const f32x4 f0 = *(const LAS f32x4*)(FS + 8 * g + 4 * hi), f1 = *(const LAS f32x4*)(FS + 32 + 8 * g + 4 * hi);
#pragma unroll
                    for (int i = 0; i < 4; ++i) { const int r = 4 * g + i, kv = k0 + 8 * g + 4 * hi + i;
                        float s0 = p0[r] + (fq - f0[i]), s1 = p1[r] + (fq - f1[i]);
                        if (kv > q) s0 = -INFINITY; if (kv + 32 > q) s1 = -INFINITY;
                        p0[r] = s0; p1[r] = s1; rm = fmaxf(rm, fmaxf(s0, s1)); } }
                rm = fmaxf(rm, shx(lane, rm, 32));
                const float mnew = fmaxf(mrun, rm), alpha = fexp2(mrun - mnew); mrun = mnew;
                float ls = 0.f;
#pragma unroll
                for (int r = 0; r < 16; ++r) { p0[r] = fexp2(p0[r] - mnew); p1[r] = fexp2(p1[r] - mnew); ls += p0[r] + p1[r]; }
                lsum = lsum * alpha + ls;
                if (hi == 0) wsf[r32] = alpha;
                LDS_WAIT(); asm volatile("" ::: "memory");
#pragma unroll
                for (int r = 0; r < 16; ++r) { const float f = wsf[crow(r, hi)]; o0[r] *= f; o1[r] *= f; }
            } else {
                float lg[8], rG[8], P1[8], P2[8], P3[8], oL[8];
#pragma unroll
                for (int r = 0; r < 16; ++r) { const int kv = k0 + crow(r, hi);
                    const float e0 = fexp2(fminf(p0[r], 30.0f)), e1 = fexp2(fminf(p1[r], 30.0f));
                    p0[r] = (kv < q) ? e0 : 0.f; p1[r] = (kv + 32 < q) ? e1 : 0.f; }
#pragma unroll
                for (int g = 0; g < 4; ++g) {
                    { const float d0 = 1.0f + p0[4 * g], d1 = 1.0f + p0[4 * g + 1], d2 = 1.0f + p0[4 * g + 2], d3 = 1.0f + p0[4 * g + 3];
                      P1[g] = d0; P2[g] = d0 * d1; P3[g] = P2[g] * d2; const float G = P3[g] * d3; lg[g] = flog2(G); rG[g] = frcp(G); }
                    { const float d0 = 1.0f + p1[4 * g], d1 = 1.0f + p1[4 * g + 1], d2 = 1.0f + p1[4 * g + 2], d3 = 1.0f + p1[4 * g + 3];
                      P1[4 + g] = d0; P2[4 + g] = d0 * d1; P3[4 + g] = P2[4 + g] * d2; const float G = P3[4 + g] * d3; lg[4 + g] = flog2(G); rG[4 + g] = frcp(G); } }
#pragma unroll
                for (int g = 0; g < 8; ++g) oL[g] = shx(lane, lg[g], 32);
                float off[8], run = 0.f;
#pragma unroll
                for (int kg = 15; kg >= 0; --kg) { const bool own = ((kg & 1) == hi); const float sm = own ? lg[kg >> 1] : oL[kg >> 1];
                    off[kg >> 1] = own ? run : off[kg >> 1]; run += sm; }
#pragma unroll
                for (int g = 0; g < 4; ++g) {
                    { const float F = fexp2(R - off[g]), c = rG[g];
                      p0[4 * g] = (c * p0[4 * g]) * F; p0[4 * g + 1] = ((P1[g] * c) * p0[4 * g + 1]) * F; p0[4 * g + 2] = ((P2[g] * c) * p0[4 * g + 2]) * F; p0[4 * g + 3] = ((P3[g] * c) * p0[4 * g + 3]) * F; }
                    { const float F = fexp2(R - off[4 + g]), c = rG[4 + g];
                      p1[4 * g] = (c * p1[4 * g]) * F; p1[4 * g + 1] = ((P1[4 + g] * c) * p1[4 * g + 1]) * F; p1[4 * g + 2] = ((P2[4 + g] * c) * p1[4 * g + 2]) * F; p1[4 * g + 3] = ((P3[4 + g] * c) * p1[4 * g + 3]) * F; } }
                R -= run;
                wdone = __all(R < -152.0f);
            }
            bf16x8 pa[4];
            { u32x4 w;
              w.x = pk2(p0[0], p0[1]); w.y = pk2(p0[2], p0[3]); w.z = pk2(p0[4], p0[5]); w.w = pk2(p0[6], p0[7]); pa[0] = __builtin_bit_cast(bf16x8, w);
              w.x = pk2(p0[8], p0[9]); w.y = pk2(p0[10], p0[11]); w.z = pk2(p0[12], p0[13]); w.w = pk2(p0[14], p0[15]); pa[1] = __builtin_bit_cast(bf16x8, w);
              w.x = pk2(p1[0], p1[1]); w.y = pk2(p1[2], p1[3]); w.z = pk2(p1[4], p1[5]); w.w = pk2(p1[6], p1[7]); pa[2] = __builtin_bit_cast(bf16x8, w);
              w.x = pk2(p1[8], p1[9]); w.y = pk2(p1[10], p1[11]); w.z = pk2(p1[12], p1[13]); w.w = pk2(p1[14], p1[15]); pa[3] = __builtin_bit_cast(bf16x8, w); }
#pragma unroll
            for (int s = 0; s < 4; ++s) {
#pragma unroll
                for (int d0 = 0; d0 < 2; ++d0) { const LAS unsigned short* vrow = VT + (32 * d0 + r32) * 68 + 16 * s + 4 * hi;
                    const u32x2 lo = *(const LAS u32x2*)vrow, hh = *(const LAS u32x2*)(vrow + 8);
                    const u32x4 vw = {lo.x, lo.y, hh.x, hh.y}; const bf16x8 vf = __builtin_bit_cast(bf16x8, vw);
                    if (d0 == 0) o0 = MFMA32(pa[s], vf, o0); else o1 = MFMA32(pa[s], vf, o1); } }
        }
        __syncthreads();
    }
    if (MODE == 0) { const float lt = lsum + shx(lane, lsum, 32); if (hi == 0) wsf[r32] = 1.0f / lt; LDS_WAIT(); asm volatile("" ::: "memory");
#pragma unroll
        for (int r = 0; r < 16; ++r) { const float f = wsf[crow(r, hi)]; o0[r] *= f; o1[r] *= f; } }
#pragma unroll
    for (int r = 0; r < 16; ++r) {
        if (FP8_MRG) { unsigned char* op = (unsigned char*)O + (rowbase + qw0 + crow(r, hi)) * OP + ocol + r32; op[0] = f8_byte(o0[r] * Q_O); op[32] = f8_byte(o1[r] * Q_O); }
        else { bf16_t* op = O + (rowbase + qw0 + crow(r, hi)) * OP + ocol + r32; op[0] = (bf16_t)f2bf(o0[r]); op[32] = (bf16_t)f2bf(o1[r]); } }
}
#include <hip/hip_bf16.h>
#include <cmath>
namespace fox_body {
using bf16=__hip_bfloat16;
using bf16x8=__attribute__((ext_vector_type(8)))short;
using s16x4=__attribute__((ext_vector_type(4)))short;
using f32x16=__attribute__((ext_vector_type(16)))float;
using u32x4=__attribute__((ext_vector_type(4)))unsigned;
constexpr int SEQ=2048,D=64,DM=8192,DMO=2048;
constexpr int NW=8,QBLK=32,QB=QBLK*NW,KVBLK=64,NQB=SEQ/QB;
constexpr int ATTN_UNIT_ROWS=QB;
__device__ __forceinline__ int crow(int r,int hi){return (r&3)+8*(r>>2)+4*hi;}
#define SBAR() __builtin_amdgcn_sched_barrier(0)
__device__ __forceinline__ void cmask(f32x16&p0,f32x16&p1,int jb,int qrel,int hi){
  const float NEG=-INFINITY; int kb=64*jb+4*hi;
  #pragma unroll
  for(int r=0;r<16;++r){int kv=kb+(r&3)+8*(r>>2); if(kv>qrel)p0[r]=NEG; if(kv+32>qrel)p1[r]=NEG;}
}

constexpr int NSLOT=3, SLOTB=8192;
constexpr int LDS_K=0, LDS_V=NSLOT*SLOTB, LDS_WS=2*NSLOT*SLOTB, LDS_OST=LDS_WS+NW*64*4, LDS_BYTES=LDS_OST+NW*4096;
constexpr float C2=0.125f*1.4426950408889634f;
__device__ __forceinline__ void glds16(const void*gsrc,unsigned lds_dst){unsigned keep;
  asm volatile("s_mov_b32 %0, m0\n\ts_mov_b32 m0, %2\n\ts_nop 0\n\tglobal_load_lds_dwordx4 %1, off\n\ts_mov_b32 m0, %0":"=&s"(keep):"v"(gsrc),"s"(lds_dst):"memory");}
__device__ __forceinline__ float max3f(float a,float b,float c){float r;asm("v_max3_f32 %0, %1, %2, %3":"=v"(r):"v"(a),"v"(b),"v"(c));return r;}
__device__ __forceinline__ float max2f(float a,float b){float r;asm("v_max_f32_e32 %0, %1, %2":"=v"(r):"v"(a),"v"(b));return r;}
__device__ __forceinline__ float fadd_s(float a,float b){float r;asm("v_add_f32_e32 %0, %1, %2":"=v"(r):"v"(a),"v"(b));return r;}
__device__ __forceinline__ float fsub_s(float a,float b){float r;asm("v_sub_f32_e32 %0, %1, %2":"=v"(r):"v"(a),"v"(b));return r;}
typedef float f32x2_t __attribute__((ext_vector_type(2))); typedef float f32x4_t __attribute__((ext_vector_type(4))); typedef __bf16 bf16x2_t __attribute__((ext_vector_type(2)));
__device__ __forceinline__ unsigned cvtpk_s(float lo,float hi){f32x2_t v={lo,hi};bf16x2_t b=__builtin_convertvector(v,bf16x2_t);return __builtin_bit_cast(unsigned,b);}
#define WAIT_BAR(N) asm volatile("s_waitcnt vmcnt(" #N ") lgkmcnt(0)\n\ts_barrier":::"memory")

__device__ __forceinline__ void qkt(f32x16&p0,f32x16&p1,const char*Kslot,const bf16x8*qr,const f32x16&negm,int r32,int hi){
  const char*kb=Kslot+hi*1024+r32*16;
  #pragma unroll
  for(int d0=0;d0<4;++d0){
    const bf16x8 b0=*reinterpret_cast<const bf16x8*>(kb+d0*2048);
    const bf16x8 b1=*reinterpret_cast<const bf16x8*>(kb+d0*2048+512);
    if(d0==0){p0=__builtin_amdgcn_mfma_f32_32x32x16_bf16(b0,qr[0],negm,0,0,0);p1=__builtin_amdgcn_mfma_f32_32x32x16_bf16(b1,qr[0],negm,0,0,0);}
    else{p0=__builtin_amdgcn_mfma_f32_32x32x16_bf16(b0,qr[d0],p0,0,0,0);p1=__builtin_amdgcn_mfma_f32_32x32x16_bf16(b1,qr[d0],p1,0,0,0);}}
}
typedef __attribute__((address_space(3))) const char* lds_cptr;
typedef short v4i16_t __attribute__((ext_vector_type(4)));
__device__ __forceinline__ void kload8(bf16x8*kf,lds_cptr kp){
  kf[0]=*(const __attribute__((address_space(3))) bf16x8*)(kp);      kf[1]=*(const __attribute__((address_space(3))) bf16x8*)(kp+512);
  kf[2]=*(const __attribute__((address_space(3))) bf16x8*)(kp+2048); kf[3]=*(const __attribute__((address_space(3))) bf16x8*)(kp+2560);
  kf[4]=*(const __attribute__((address_space(3))) bf16x8*)(kp+4096); kf[5]=*(const __attribute__((address_space(3))) bf16x8*)(kp+4608);
  kf[6]=*(const __attribute__((address_space(3))) bf16x8*)(kp+6144); kf[7]=*(const __attribute__((address_space(3))) bf16x8*)(kp+6656);
}
__device__ __forceinline__ void kload2(bf16x8*kf,lds_cptr kp,int j){ kf[2*j]=*(const __attribute__((address_space(3))) bf16x8*)(kp+j*2048); kf[2*j+1]=*(const __attribute__((address_space(3))) bf16x8*)(kp+j*2048+512); }
__device__ __forceinline__ s16x4 vtr(lds_cptr p){ return __builtin_bit_cast(s16x4,__builtin_amdgcn_ds_read_tr16_b64_v4i16((__attribute__((address_space(3))) v4i16_t*)p)); }
__device__ __forceinline__ float rowmax(const f32x16&p0,const f32x16&p1){
  float a=max3f(p0[0],p0[1],p1[0]),b=max3f(p0[2],p0[3],p1[1]);a=max3f(a,p1[2],p1[3]);
  #pragma unroll
  for(int r=4;r<16;r+=4){a=max3f(a,p0[r],p0[r+1]);b=max3f(b,p0[r+2],p0[r+3]);a=max3f(a,p1[r],p1[r+1]);b=max3f(b,p1[r+2],p1[r+3]);}
  const float m=max2f(a,b);
  auto rr=__builtin_amdgcn_permlane32_swap(__float_as_uint(m),__float_as_uint(m),false,false);
  return max2f(__uint_as_float(rr[0]),__uint_as_float(rr[1]));
}
__device__ __forceinline__ void pv(f32x16*o,int vb,bf16x8 pa0,bf16x8 pa1,bf16x8 pa2,bf16x8 pa3){
  #pragma unroll
  for(int d0=0;d0<2;++d0){s16x4 lo[4],hi[4];
    #pragma unroll
    for(int ks=0;ks<4;++ks){
      asm volatile("ds_read_b64_tr_b16 %0,%1 offset:%c2":"=&v"(lo[ks]):"v"(vb),"i"(d0*4096+ks*1024):"memory");
      asm volatile("ds_read_b64_tr_b16 %0,%1 offset:%c2":"=&v"(hi[ks]):"v"(vb),"i"(d0*4096+ks*1024+512):"memory");}
    asm volatile("s_waitcnt lgkmcnt(0)":::"memory");SBAR();
    #define PK(k) (bf16x8){lo[k][0],lo[k][1],lo[k][2],lo[k][3],hi[k][0],hi[k][1],hi[k][2],hi[k][3]}
    o[d0]=__builtin_amdgcn_mfma_f32_32x32x16_bf16(pa0,PK(0),o[d0],0,0,0);
    o[d0]=__builtin_amdgcn_mfma_f32_32x32x16_bf16(pa1,PK(1),o[d0],0,0,0);
    o[d0]=__builtin_amdgcn_mfma_f32_32x32x16_bf16(pa2,PK(2),o[d0],0,0,0);
    o[d0]=__builtin_amdgcn_mfma_f32_32x32x16_bf16(pa3,PK(3),o[d0],0,0,0);
    #undef PK
  }
}

#ifndef ATTN_STORE16
#define ATTN_STORE16(p,v) (*(u32x4*)(p)=(v))
#endif
template<int THRL> __device__ __forceinline__ void attn_unit(int b,int h,int qb,const bf16*Q,const bf16*__restrict__ K,const bf16*__restrict__ V,bf16*O,const __attribute__((address_space(3))) float*Fl,char*shm,int tid){
  const int lane=tid&63,r32=lane&31,hi=lane>>5; const int wid=__builtin_amdgcn_readfirstlane(tid>>6);
  const long rowbase=(long)b*SEQ; const int q0=qb*QB;
  const bf16*Qw=Q+(rowbase+q0+wid*QBLK)*DM+h*D;
  const bf16*Kh=K+rowbase*DM+h*D,*Vh=V+rowbase*DM+h*D;
  const unsigned lds0=(unsigned)(uintptr_t)shm;
  float*wsf=(float*)(shm+LDS_WS)+wid*64;
  const unsigned koff=(unsigned)(lane*DM+wid*8);
  const unsigned voff=(unsigned)((16*(wid&3)+(lane>>2))*DM+(wid>>2)*32+(lane&3)*8);
  const unsigned kdst=lds0+LDS_K+wid*1024, vdst=lds0+LDS_V+wid*1024;
  #define DMA_K(t,slot) glds16(Kh+((long)(t)*KVBLK*DM+koff),(unsigned)__builtin_amdgcn_readfirstlane(kdst+(slot)))
  #define DMA_V(t,slot) glds16(Vh+((long)(t)*KVBLK*DM+voff),(unsigned)__builtin_amdgcn_readfirstlane(vdst+(slot)))
  const int vb0=(int)(lds0+LDS_V)+((lane>>4)&1)*32+(lane&3)*8+(4*hi+((lane&15)>>2))*64;
  const char*Kbase=shm+LDS_K; bf16x8 kf[8];
  const lds_cptr shm3=(lds_cptr)shm; const lds_cptr kp0=shm3+LDS_K+hi*1024+r32*16; const lds_cptr vp0=shm3+LDS_V+((lane>>4)&1)*32+(lane&3)*8+(4*hi+((lane&15)>>2))*64;
  const int NT=(q0+QB)/KVBLK;
  DMA_K(0,0);DMA_V(0,0);DMA_K(1,SLOTB);
  bf16x8 qr[4];
  #pragma unroll
  for(int d0=0;d0<4;++d0)qr[d0]=*reinterpret_cast<const bf16x8*>(&Qw[(long)r32*DM+d0*16+hi*8]);
  const float fq=Fl[q0+wid*QBLK+r32];
  float mhat=0.f,l_reg=0.f;f32x16 o[2];o[0]=f32x16{};o[1]=f32x16{};const f32x16 negm=f32x16{};
  float cc=-fq;
  #define FSUB(P0,P1,t) do{ _Pragma("unroll") for(int g_=0;g_<4;++g_){ \
      { const f32x4_t f0_=*(const __attribute__((address_space(3))) f32x4_t*)(Fl+(t)*64+8*g_+4*hi)+cc; \
        _Pragma("unroll") for(int i_=0;i_<4;++i_) P0[4*g_+i_]-=f0_[i_]; asm volatile("":::"memory"); } \
      { const f32x4_t f1_=*(const __attribute__((address_space(3))) f32x4_t*)(Fl+(t)*64+32+8*g_+4*hi)+cc; \
        _Pragma("unroll") for(int i_=0;i_<4;++i_) P1[4*g_+i_]-=f1_[i_]; asm volatile("":::"memory"); } } }while(0)
  const int qrel=wid*QBLK+r32;
  #define CMASK(P0,P1,t) do{int jb_=(t)-(NT-4); if(jb_>=0)cmask(P0,P1,jb_,qrel,hi);}while(0)
  bool resc=false;
  #define START(P0,P1) do{ const float rm=rowmax(P0,P1); resc=false; \
    { const float dl=rm; mhat=fadd_s(mhat,dl); \
      _Pragma("unroll") for(int r=0;r<16;++r){P0[r]=fsub_s(P0[r],dl);P1[r]=fsub_s(P1[r],dl);} \
      cc=mhat-fq; } \
    _Pragma("unroll") for(int r=0;r<16;++r)P0[r]=__builtin_amdgcn_exp2f(P0[r]); }while(0)
  #define RESC() do{ if(resc){ asm volatile("s_waitcnt lgkmcnt(0)":::"memory"); \
      _Pragma("unroll") for(int d_=0;d_<2;++d_) _Pragma("unroll") for(int r=0;r<16;++r)o[d_][r]*=wsf[crow(r,hi)]; } }while(0)
  f32x16 pA0,pA1,pB0,pB1;
  int sl_prev=0,sl_cur=0,sl_next=SLOTB;
  #define ROT() do{sl_prev=sl_cur;sl_cur=sl_next;sl_next=(sl_next==(NSLOT-1)*SLOTB)?0:sl_next+SLOTB;}while(0)
  DMA_K(2,2*SLOTB);
  WAIT_BAR(3);
  qkt(pA0,pA1,Kbase,qr,negm,r32,hi);asm volatile("s_nop 15\n\ts_nop 7":"+v"(pA0),"+v"(pA1));FSUB(pA0,pA1,0);CMASK(pA0,pA1,0);
  START(pA0,pA1);
  _Pragma("unroll") for(int r=0;r<16;++r)pA1[r]=__builtin_amdgcn_exp2f(pA1[r]);
  WAIT_BAR(0);
  DMA_K(3,0);DMA_V(1,SLOTB);
  ROT();
  kload8(kf,kp0+sl_cur);
  WAIT_BAR(2);
  s16x4 vlo[8],vhi[8]; u32x4 pw0,pw1,pw2,pw3;
  #define PKW(P,B) cvtpk_s(P[B],P[B+1])
  #define PAF(k) __builtin_bit_cast(bf16x8,pw##k)
  #define VFR(i) (bf16x8){vlo[i][0],vlo[i][1],vlo[i][2],vlo[i][3],vhi[i][0],vhi[i][1],vhi[i][2],vhi[i][3]}
  #define PIN(x) asm volatile("":"+v"(x))
  #define MX3(a,b,c) __builtin_fmaxf(__builtin_fmaxf((a),(b)),(c))
  #define GAPA(MF,A0,A1,A2,A3,W0,W1,PW) do{ MF; sacc+=A0; sacc+=A1; sacc+=A2; sacc+=A3; PIN(sacc); W0; W1; PIN(PW); SBAR(); }while(0)
  #define EX(v) __builtin_amdgcn_exp2f(v)
  #define GAPB(MF,X,B) do{ MF; X[B]=EX(X[B]); X[B+1]=EX(X[B+1]); X[B+2]=EX(X[B+2]); X[B+3]=EX(X[B+3]); PIN(X); SBAR(); }while(0)
  #define VRD(i) do{ vlo[i]=vtr(vp_+(((i)>>2)*4096+((i)&3)*1024)); vhi[i]=vtr(vp_+(((i)>>2)*4096+((i)&3)*1024+512)); }while(0)
  #define KRD(G,j) do{ if(G){ kload2(kf,kp0+sl_next,j); SBAR(); } }while(0)
  #define STEP(C0,C1,P0,P1,t,GK,GV,GL) do{ SBAR(); \
    const lds_cptr vp_=vp0+sl_prev; \
    VRD(0); SBAR(); float sacc=(P0[0]+P0[1]); \
    GAPA(C0=__builtin_amdgcn_mfma_f32_32x32x16_bf16(kf[0],qr[0],negm,0,0,0), P0[2],P0[3],P0[4],P0[5],     pw0[0]=PKW(P0,0), pw0[1]=PKW(P0,2), pw0); \
    VRD(4); SBAR(); GAPA(C1=__builtin_amdgcn_mfma_f32_32x32x16_bf16(kf[1],qr[0],negm,0,0,0), P0[6],P0[7],P0[8],P0[9],     pw0[2]=PKW(P0,4), pw0[3]=PKW(P0,6), pw0); \
    VRD(1); SBAR(); GAPA(C0=__builtin_amdgcn_mfma_f32_32x32x16_bf16(kf[2],qr[1],C0,0,0,0),   P0[10],P0[11],P0[12],P0[13], pw1[0]=PKW(P0,8), pw1[1]=PKW(P0,10), pw1); \
    VRD(5); SBAR(); GAPA(C1=__builtin_amdgcn_mfma_f32_32x32x16_bf16(kf[3],qr[1],C1,0,0,0),   P0[14],P0[15],P1[0],P1[1],   pw1[2]=PKW(P0,12),pw1[3]=PKW(P0,14), pw1); \
    VRD(2); SBAR(); GAPA(C0=__builtin_amdgcn_mfma_f32_32x32x16_bf16(kf[4],qr[2],C0,0,0,0),   P1[2],P1[3],P1[4],P1[5],     pw2[0]=PKW(P1,0), pw2[1]=PKW(P1,2), pw2); \
    VRD(6); SBAR(); GAPA(C1=__builtin_amdgcn_mfma_f32_32x32x16_bf16(kf[5],qr[2],C1,0,0,0),   P1[6],P1[7],P1[8],P1[9],     pw2[2]=PKW(P1,4), pw2[3]=PKW(P1,6), pw2); \
    VRD(3); SBAR(); GAPA(C0=__builtin_amdgcn_mfma_f32_32x32x16_bf16(kf[6],qr[3],C0,0,0,0),   P1[10],P1[11],P1[12],P1[13], pw3[0]=PKW(P1,8), pw3[1]=PKW(P1,10), pw3); \
    VRD(7); SBAR(); GAPA(C1=__builtin_amdgcn_mfma_f32_32x32x16_bf16(kf[7],qr[3],C1,0,0,0),   P1[14],P1[15],0.f,0.f,       pw3[2]=PKW(P1,12),pw3[3]=PKW(P1,14), pw3); \
    l_reg+=sacc; \
    if(GK){DMA_K((t)+3,sl_cur);} if(GV){DMA_V((t)+1,sl_next);} \
    FSUB(C0,C1,t); CMASK(C0,C1,t); \
    { float a=MX3(C0[0],C0[1],C1[0]),b=MX3(C0[2],C0[3],C1[1]); a=MX3(a,C1[2],C1[3]); \
      _Pragma("unroll") for(int r=4;r<16;r+=4){a=MX3(a,C0[r],C0[r+1]);b=MX3(b,C0[r+2],C0[r+3]);a=MX3(a,C1[r],C1[r+1]);b=MX3(b,C1[r+2],C1[r+3]);} \
      float rm=__builtin_fmaxf(a,b); { auto rr=__builtin_amdgcn_permlane32_swap(__float_as_uint(rm),__float_as_uint(rm),false,false); rm=__builtin_fmaxf(__uint_as_float(rr[0]),__uint_as_float(rr[1])); } \
      resc=false; \
      if(__builtin_expect(__any(rm>(float)THRL),0)){ const float dl=__builtin_fmaxf(rm,0.f); mhat+=dl; \
        _Pragma("unroll") for(int r=0;r<16;++r){C0[r]-=dl;C1[r]-=dl;} \
        cc=mhat-fq; \
        const float f=__builtin_amdgcn_exp2f(-dl); l_reg*=f; if(hi==0)wsf[r32]=f; resc=true; } } \
    SBAR(); \
    GAPB(o[0]=__builtin_amdgcn_mfma_f32_32x32x16_bf16(PAF(0),VFR(0),o[0],0,0,0), C0,0); \
    GAPB(o[1]=__builtin_amdgcn_mfma_f32_32x32x16_bf16(PAF(0),VFR(4),o[1],0,0,0), C0,4); \
    KRD(GL,0); GAPB(o[0]=__builtin_amdgcn_mfma_f32_32x32x16_bf16(PAF(1),VFR(1),o[0],0,0,0), C0,8); \
    KRD(GL,1); GAPB(o[1]=__builtin_amdgcn_mfma_f32_32x32x16_bf16(PAF(1),VFR(5),o[1],0,0,0), C0,12); \
    KRD(GL,2); GAPB(o[0]=__builtin_amdgcn_mfma_f32_32x32x16_bf16(PAF(2),VFR(2),o[0],0,0,0), C1,0); \
    KRD(GL,3); GAPB(o[1]=__builtin_amdgcn_mfma_f32_32x32x16_bf16(PAF(2),VFR(6),o[1],0,0,0), C1,4); \
    GAPB(o[0]=__builtin_amdgcn_mfma_f32_32x32x16_bf16(PAF(3),VFR(3),o[0],0,0,0), C1,8); \
    GAPB(o[1]=__builtin_amdgcn_mfma_f32_32x32x16_bf16(PAF(3),VFR(7),o[1],0,0,0), C1,12); \
    }while(0)
  int t=1;
  #undef CMASK
  #define CMASK(P0,P1,t) do{}while(0)
  for(;t+5<NT;t+=2){
    STEP(pB0,pB1,pA0,pA1,t,true,true,true);     WAIT_BAR(2); RESC(); ROT();
    STEP(pA0,pA1,pB0,pB1,t+1,true,true,true);   WAIT_BAR(2); RESC(); ROT();
  }
  #undef CMASK
  #define CMASK(P0,P1,t) do{int jb_=(t)-(NT-4); if(jb_>=0)cmask(P0,P1,jb_,qrel,hi);}while(0)
  #define ENDW(tt) do{ if((tt)+3<NT){WAIT_BAR(2);} else if((tt)+2<NT){WAIT_BAR(1);} else {WAIT_BAR(0);} }while(0)
  for(;t+1<NT;t+=2){
    STEP(pB0,pB1,pA0,pA1,t,(t+3<NT),(t+1<NT),(t+1<NT));       ENDW(t);   RESC(); ROT();
    STEP(pA0,pA1,pB0,pB1,t+1,(t+4<NT),(t+2<NT),(t+2<NT));     ENDW(t+1); RESC(); ROT();
  }
  STEP(pB0,pB1,pA0,pA1,NT-1,false,false,false); RESC();
  { float sacc=pB0[0]+pB0[1]; _Pragma("unroll") for(int r=2;r<16;++r)sacc+=pB0[r]; _Pragma("unroll") for(int r=0;r<16;++r)sacc+=pB1[r]; l_reg+=sacc;
    pw0=(u32x4){PKW(pB0,0),PKW(pB0,2),PKW(pB0,4),PKW(pB0,6)};pw1=(u32x4){PKW(pB0,8),PKW(pB0,10),PKW(pB0,12),PKW(pB0,14)};pw2=(u32x4){PKW(pB1,0),PKW(pB1,2),PKW(pB1,4),PKW(pB1,6)};pw3=(u32x4){PKW(pB1,8),PKW(pB1,10),PKW(pB1,12),PKW(pB1,14)};
    SBAR(); pv(o,vb0+sl_cur,PAF(0),PAF(1),PAF(2),PAF(3)); }
  #undef PKW
  #undef PAF
  #undef VFR
  #undef PIN
  #undef MX3
  #undef GAPA
  #undef GAPB
  #undef EX
  #undef VRD
  #undef KRD
  #undef STEP
  #undef ENDW
  {auto rr=__builtin_amdgcn_permlane32_swap(__float_as_uint(l_reg),__float_as_uint(l_reg),false,false);l_reg=__uint_as_float(rr[0])+__uint_as_float(rr[1]);}
  if(hi==0)wsf[32+r32]=l_reg;asm volatile("s_waitcnt lgkmcnt(0)":::"memory");
  float rli[16];
  #pragma unroll
  for(int r=0;r<16;++r)rli[r]=__builtin_amdgcn_rcpf(wsf[32+crow(r,hi)]);
#if FP8_MRG
  { unsigned char*Ow8=(unsigned char*)O+(rowbase+q0+wid*QBLK)*DMO+h*D;
    unsigned char*stg=(unsigned char*)(shm+LDS_OST)+wid*4096;
    #pragma unroll
    for(int r=0;r<16;++r){const int orow=crow(r,hi);
      #pragma unroll
      for(int d0=0;d0<2;++d0)stg[orow*64+d0*32+r32]=f8_byte(o[d0][r]*rli[r]*Q_O);}
    asm volatile("s_waitcnt lgkmcnt(0)":::"memory");
    #pragma unroll
    for(int i=0;i<2;++i){const int row=i*16+(lane>>2),ch=lane&3; const u32x4 v=*(const u32x4*)(stg+row*64+ch*16); ATTN_STORE16(Ow8+(long)row*DMO+ch*16,v);} }
#else
  bf16*Ow=O+(rowbase+q0+wid*QBLK)*DMO+h*D;
  { bf16*stg=(bf16*)(shm+LDS_OST)+wid*2048;
    #pragma unroll
    for(int r=0;r<16;++r){const int orow=crow(r,hi);
      #pragma unroll
      for(int d0=0;d0<2;++d0)stg[orow*64+d0*32+r32]=__float2bfloat16(o[d0][r]*rli[r]);}
    asm volatile("s_waitcnt lgkmcnt(0)":::"memory");
    #pragma unroll
    for(int i=0;i<4;++i){const int row=i*8+(lane>>3),ch=lane&7; const u32x4 v=*(const u32x4*)(stg+row*64+ch*8); ATTN_STORE16(Ow+(long)row*DMO+ch*8,v);} }
#endif
  asm volatile("s_waitcnt lgkmcnt(0)\n\ts_barrier":::"memory");
  #undef FSUB
  #undef DMA_K
  #undef DMA_V
  #undef CMASK
  #undef START
  #undef RESC
  #undef ROT
}
constexpr int ATTN_LDS_BYTES=LDS_BYTES;
#undef SBAR
#undef WAIT_BAR
}

constexpr int L1_HI = 0, L1_ROWB = 2064, L1_LO = 16 * L1_ROWB, L1_PART = 2 * 16 * L1_ROWB, L1_LGT = L1_PART + 16384;
template <bool xbf> __device__ __forceinline__ void ln1_phase(const AR a, int l, const float* xin, LAS unsigned char* lds, int vcu, int tid, int wave, int lane) {
    LAS int* lcnt = (LAS int*)(lds + MISC_OFF + MO_LCNT); LAS int* lbase = (LAS int*)(lds + MISC_OFF + MO_LBASE);
    LAS unsigned* REC = (LAS unsigned*)(lds + MISC_OFF + MO_REC); LAS float* GT = (LAS float*)(lds + MISC_OFF + MO_GT);
    LAS float* PART = (LAS float*)(lds + L1_PART); LAS float* LGT = (LAS float*)(lds + L1_LGT);
    const float* Wr = a.in(I_WR) + (size_t)l * D * NEXP; const float* br = a.in(I_BR) + (size_t)l * NEXP;
    __syncthreads();
    if (tid < 32) lcnt[tid] = 0;
    bf16x8 Bh[4][2], Bl[4][2];
    { const int n = lane & 15, kg = lane >> 4; float w[4][2][8];
#pragma unroll
      for (int ks = 0; ks < 4; ++ks)
#pragma unroll
        for (int nt = 0; nt < 2; ++nt) { const float* p = Wr + (size_t)(128 * wave + 32 * ks + 8 * kg) * 32 + n + 16 * nt;
#pragma unroll
            for (int j = 0; j < 8; ++j) w[ks][nt][j] = p[j * 32]; }
#pragma unroll
      for (int ks = 0; ks < 4; ++ks)
#pragma unroll
        for (int nt = 0; nt < 2; ++nt) { float r[8];
#pragma unroll
            for (int j = 0; j < 8; ++j) r[j] = w[ks][nt][j] - bf2f(f2bf(w[ks][nt][j]));
            u32x4 ph, pl; ph.x = pk2(w[ks][nt][0], w[ks][nt][1]); ph.y = pk2(w[ks][nt][2], w[ks][nt][3]); ph.z = pk2(w[ks][nt][4], w[ks][nt][5]); ph.w = pk2(w[ks][nt][6], w[ks][nt][7]);
            pl.x = pk2(r[0], r[1]); pl.y = pk2(r[2], r[3]); pl.z = pk2(r[4], r[5]); pl.w = pk2(r[6], r[7]);
            Bh[ks][nt] = __builtin_bit_cast(bf16x8, ph); Bl[ks][nt] = __builtin_bit_cast(bf16x8, pl); } }
    const bf16_t* Y = (const bf16_t*)(a.ws() + WS_Y); bf16_t* X1 = (bf16_t*)(a.ws() + WS_X1); bf16_t* H = (bf16_t*)(a.ws() + WS_H);
    LAS float* VL = (LAS float*)(lds + 86016);
    { const float* ada = (const float*)(a.ws() + WS_ADA) + ((size_t)l * 16 + ((vcu * 128) >> 11)) * 6144;
      stage_vec5(a.in(I_LN1G) + (size_t)l * D, a.in(I_LN1B) + (size_t)l * D, ada + 2048, ada + 3072, ada + 4096, VL, tid); }
    const LAS float* VLl = VL + 4 * lane; asm volatile("" : "+v"(VLl));
    __syncthreads();
    const float brv = br[tid & 31];
    f32x4 px[2][4]; u32x2 py[2][4];
#define L1_LOADROWS(P) do { _Pragma("unroll") for (int rr = 0; rr < 2; ++rr) { const int m_ = (vcu >> 4) * 2048 + (P) * 256 + (vcu & 15) * 16 + 2 * wave + rr; \
        _Pragma("unroll") for (int j = 0; j < 4; ++j) { const int col = 4 * lane + 256 * j; if (xbf) { const u32x2 w_ = *(const u32x2*)((const bf16_t*)xin + (size_t)m_ * D + col); px[rr][j] = (f32x4){__uint_as_float(w_.x << 16), __uint_as_float(w_.x & 0xffff0000u), __uint_as_float(w_.y << 16), __uint_as_float(w_.y & 0xffff0000u)}; } else px[rr][j] = *(const f32x4*)(xin + (size_t)m_ * D + col); py[rr][j] = *(const u32x2*)(Y + (size_t)m_ * D + col); } } } while (0)
    L1_LOADROWS(0);
#pragma unroll 1
    for (int pass = 0; pass < 8; ++pass) {
        f32x4 v[2][4];
#pragma unroll
        for (int rr = 0; rr < 2; ++rr) {
#pragma unroll
            for (int j = 0; j < 4; ++j) { const int col = 4 * lane + 256 * j; const f32x4 gt = *(const LAS f32x4*)(VLl + 2048 + 256 * j); const u32x2 yw = py[rr][j];
                const f32x4 yv = {__uint_as_float(yw.x << 16), __uint_as_float(yw.x & 0xffff0000u), __uint_as_float(yw.y << 16), __uint_as_float(yw.y & 0xffff0000u)};
                v[rr][j] = px[rr][j] * DN_ALPHA + (gt + 1.0f) * yv; } }
        if (pass < 7) L1_LOADROWS(pass + 1);
#pragma unroll
        for (int rr = 0; rr < 2; ++rr) {
            const int rowt = 2 * wave + rr, m = (vcu >> 4) * 2048 + pass * 256 + (vcu & 15) * 16 + rowt;
            ln_row(v[rr], VLl, VLl + 1024, lane);
#pragma unroll
            for (int j = 0; j < 4; ++j) { const int col = 4 * lane + 256 * j;
                { u32x2 wx; wx.x = pk2(v[rr][j][0], v[rr][j][1]); wx.y = pk2(v[rr][j][2], v[rr][j][3]); *(u32x2*)(X1 + (size_t)m * D + col) = wx; }
                const f32x4 sh = *(const LAS f32x4*)(VLl + 3072 + 256 * j), sc = *(const LAS f32x4*)(VLl + 4096 + 256 * j);
                const f32x4 h = v[rr][j] * (sc + 1.0f) + sh;
                u32x2 wh; wh.x = pk2(h[0], h[1]); wh.y = pk2(h[2], h[3]);
                if (FP8_MOE) *(unsigned*)((unsigned char*)H + (size_t)m * D + col) = pk4_f8(h[0] * Q_H2, h[1] * Q_H2, h[2] * Q_H2, h[3] * Q_H2); else *(u32x2*)(H + (size_t)m * D + col) = wh;
                const f32x4 hr = {h[0] - __uint_as_float(wh.x << 16), h[1] - __uint_as_float(wh.x & 0xffff0000u), h[2] - __uint_as_float(wh.y << 16), h[3] - __uint_as_float(wh.y & 0xffff0000u)};
                u32x2 wl; wl.x = pk2(hr[0], hr[1]); wl.y = pk2(hr[2], hr[3]);
                *(LAS u32x2*)(lds + L1_HI + rowt * L1_ROWB + col * 2) = wh; *(LAS u32x2*)(lds + L1_LO + rowt * L1_ROWB + col * 2) = wl; }
        }
        __syncthreads();
        { f32x4 acc0 = {0.f, 0.f, 0.f, 0.f}, acc1 = {0.f, 0.f, 0.f, 0.f}; const int row = lane & 15, kg = lane >> 4;
#pragma unroll
          for (int ks = 0; ks < 4; ++ks) { const int off = row * L1_ROWB + (128 * wave + 32 * ks + 8 * kg) * 2;
              const bf16x8 ah = *(const LAS bf16x8*)(lds + L1_HI + off), al = *(const LAS bf16x8*)(lds + L1_LO + off);
              acc0 = __builtin_amdgcn_mfma_f32_16x16x32_bf16(ah, Bh[ks][0], acc0, 0, 0, 0); acc1 = __builtin_amdgcn_mfma_f32_16x16x32_bf16(ah, Bh[ks][1], acc1, 0, 0, 0);
              acc0 = __builtin_amdgcn_mfma_f32_16x16x32_bf16(ah, Bl[ks][0], acc0, 0, 0, 0); acc1 = __builtin_amdgcn_mfma_f32_16x16x32_bf16(ah, Bl[ks][1], acc1, 0, 0, 0);
              acc0 = __builtin_amdgcn_mfma_f32_16x16x32_bf16(al, Bh[ks][0], acc0, 0, 0, 0); acc1 = __builtin_amdgcn_mfma_f32_16x16x32_bf16(al, Bh[ks][1], acc1, 0, 0, 0); }
#pragma unroll
          for (int r = 0; r < 4; ++r) { PART[(wave * 16 + 4 * kg + r) * 32 + (lane & 15)] = acc0[r]; PART[(wave * 16 + 4 * kg + r) * 32 + 16 + (lane & 15)] = acc1[r]; } }
        __syncthreads();
        { float x = brv;
#pragma unroll
          for (int w2 = 0; w2 < 8; ++w2) x += PART[w2 * 512 + tid];
          float vk[4]; int ik[4]; const int el = lane & 31;
#pragma unroll
          for (int r = 0; r < 4; ++r) { float m = x;
              m = fmaxf(m, WV_DPP(m, 0xb1)); m = fmaxf(m, WV_DPP(m, 0x4e)); m = fmaxf(m, WV_DPP(m, 0x141)); m = fmaxf(m, WV_DPP(m, 0x140));
              { const auto r2 = __builtin_amdgcn_permlane16_swap(__float_as_uint(m), __float_as_uint(m), false, false); m = fmaxf(__uint_as_float(r2[0]), __uint_as_float(r2[1])); }
              const unsigned long long bal = __builtin_amdgcn_ballot_w64(x == m);
              const unsigned hb = (lane & 32) ? (unsigned)(bal >> 32) : (unsigned)bal;
              const int idx = hb ? __builtin_ctz(hb) : 0;
              vk[r] = m; ik[r] = idx; x = (el == idx) ? -INFINITY : x; }
          const float p1 = fexp2(LOG2E * (vk[1] - vk[0])), p2 = fexp2(LOG2E * (vk[2] - vk[0])), p3 = fexp2(LOG2E * (vk[3] - vk[0])), inv = 1.0f / (1.0f + p1 + p2 + p3);
          if (el < 4) { const int rowl = pass * 16 + 2 * wave + (lane >> 5);
              const int ee = (el == 0) ? ik[0] : ((el == 1) ? ik[1] : ((el == 2) ? ik[2] : ik[3]));
              const float gg = ((el == 0) ? 1.0f : ((el == 1) ? p1 : ((el == 2) ? p2 : p3))) * inv;
              const int lr = __hip_atomic_fetch_add(lcnt + ee, 1, __ATOMIC_RELAXED, __HIP_MEMORY_SCOPE_WORKGROUP);
              REC[rowl * 4 + el] = (unsigned)ee | ((unsigned)lr << 8); GT[rowl * 4 + el] = gg; } }
    }
#undef L1_LOADROWS
    __syncthreads();
    { int t2 = tid; asm volatile("" : "+v"(t2));
      if (t2 < 32) lbase[t2] = (int)__hip_atomic_fetch_add((gu32*)(a.ws() + WS_CTL) + CW_GCNT + (l * 32 + t2) * 64, (unsigned)lcnt[t2], RLX_AGENT); }
    __syncthreads();
    { const int rowl = tid >> 2, k = tid & 3; const unsigned rec = REC[tid]; const int e = rec & 255, lr = rec >> 8, rank = lbase[e] + lr, tok = (vcu >> 4) * 2048 + (rowl >> 4) * 256 + (vcu & 15) * 16 + (rowl & 15);
      int* slot_tok = (int*)(a.ws() + WS_SLOTTOK); int* tok_er = (int*)(a.ws() + WS_TOKER); float* gates = (float*)(a.ws() + WS_GATE);
      if (rank < ECAP) slot_tok[(size_t)e * ECAP + rank] = tok;
      tok_er[tok * 4 + k] = e * ECAP + rank; gates[tok * 4 + k] = GT[tid]; }
    __syncthreads();
}

template <bool obf> __device__ __forceinline__ void ln2_phase(const AR a, int l, float* xout, LAS unsigned char* lds, int vcu, int tid, int wave, int lane, bool prep_next) {
    const LAS int* bs = (const LAS int*)(lds + MISC_OFF + MO_BS);
    const LAS float* Wf = (const LAS float*)lds;
    LAS float* VL = (LAS float*)(lds + 32768);
    { const int b = (vcu * 128) >> 11; const float* ada = (const float*)(a.ws() + WS_ADA) + ((size_t)l * 16 + b) * 6144;
      const float* adn = (const float*)(a.ws() + WS_ADA) + ((size_t)(prep_next ? l + 1 : l) * 16 + b) * 6144;
      stage_vec5(a.in(I_LN2G) + (size_t)l * D, a.in(I_LN2B) + (size_t)l * D, ada + 5120, adn, adn + 1024, VL, tid);
      { int t8 = tid; asm volatile("" : "+v"(t8)); if (prep_next && t8 < 8) VL[5120 + t8] = a.in(I_BF)[(l + 1) * 8 + t8]; } }
    const LAS float* VLl = VL + 4 * lane; asm volatile("" : "+v"(VLl));
    __syncthreads();
    const bf16_t* X1 = (const bf16_t*)(a.ws() + WS_X1); const bf16_t* YB = (const bf16_t*)(a.ws() + WS_YB);
    const int* tok_er = (const int*)(a.ws() + WS_TOKER); const float* gates = (const float*)(a.ws() + WS_GATE);
    const int mw = (vcu >> 4) * 2048 + (vcu & 15) * 16 + 2 * wave;
    int ern[4]; float gn[4];
#define L2_ROW(S) (mw + 256 * ((S) >> 1) + ((S) & 1))
#define L2_LOADIDX(M) do { _Pragma("unroll") for (int k = 0; k < 4; ++k) { ern[k] = tok_er[(M) * 4 + k]; gn[k] = gates[(M) * 4 + k]; } } while (0)
    unsigned y8c[4][4], y8n[4][4]; u32x2 xc[4], xn[4]; float gcc[4], gcn[4];
#define L2_LOADROWS(Y8, XW, GC, M) do { \
        _Pragma("unroll") for (int k = 0; k < 4; ++k) { const int er = ern[k], e = er >> 15, rank = er & (ECAP - 1); GC[k] = gn[k] * (1.0f / Q_YB); \
            const unsigned char* yr = (const unsigned char*)YB + ((size_t)bs[e] * 256 + rank) * D; \
            _Pragma("unroll") for (int j = 0; j < 4; ++j) Y8[k][j] = *(const unsigned*)(yr + 4 * lane + 256 * j); } \
        _Pragma("unroll") for (int j = 0; j < 4; ++j) XW[j] = *(const u32x2*)(X1 + (size_t)(M) * D + 4 * lane + 256 * j); } while (0)
    static_assert(FP8_YB != 0, "ln2_phase gathers fp8 expert rows");
    L2_LOADIDX(L2_ROW(0));
    L2_LOADROWS(y8c, xc, gcc, L2_ROW(0));
    L2_LOADIDX(L2_ROW(1));
#pragma unroll 1
    for (int st = 0; st < 16; ++st) { const int m = L2_ROW(st);
        { const int s1 = (st < 15) ? st + 1 : 15, s2 = (st < 14) ? st + 2 : 15;
          L2_LOADROWS(y8n, xn, gcn, L2_ROW(s1));
          L2_LOADIDX(L2_ROW(s2)); }
        f32x4 v[4];
#pragma unroll
        for (int j = 0; j < 4; ++j) { f32x4 y = {0.f, 0.f, 0.f, 0.f};
#pragma unroll
            for (int k = 0; k < 4; ++k) { const float g = gcc[k];
                const auto lo = __builtin_amdgcn_cvt_pk_f32_fp8((int)y8c[k][j], false), hi = __builtin_amdgcn_cvt_pk_f32_fp8((int)y8c[k][j], true);
                y[0] += g * lo[0]; y[1] += g * lo[1]; y[2] += g * hi[0]; y[3] += g * hi[1]; }
            const f32x4 gt = *(const LAS f32x4*)(VLl + 2048 + 256 * j); const u32x2 wx = xc[j];
            const f32x4 xv = {__uint_as_float(wx.x << 16), __uint_as_float(wx.x & 0xffff0000u), __uint_as_float(wx.y << 16), __uint_as_float(wx.y & 0xffff0000u)};
            v[j] = xv * DN_ALPHA + (gt + 1.0f) * y; }
        ln_row(v, VLl, VLl + 1024, lane);
#pragma unroll
        for (int j = 0; j < 4; ++j) { if (obf) { u32x2 w_; w_.x = pk2(v[j][0], v[j][1]); w_.y = pk2(v[j][2], v[j][3]); *(u32x2*)((bf16_t*)xout + (size_t)m * D + 4 * lane + 256 * j) = w_; }
            else *(f32x4*)(xout + (size_t)m * D + 4 * lane + 256 * j) = v[j]; }
        if (prep_next) prep_row(a, m, v, Wf, VLl + 3072, VLl + 4096, VL + 5120, lane);
#pragma unroll
        for (int k = 0; k < 4; ++k) { gcc[k] = gcn[k];
#pragma unroll
            for (int j = 0; j < 4; ++j) y8c[k][j] = y8n[k][j]; }
#pragma unroll
        for (int j = 0; j < 4; ++j) xc[j] = xn[j];
    }
#undef L2_LOADROWS
#undef L2_LOADIDX
#undef L2_ROW
}

#if CHK
__device__ __forceinline__ void chk_rec(const AR a, int stage, float err) {
    if (!(err == err)) err = 1e30f; err = fabsf(err);
    atomicMax((unsigned*)(a.ws() + WS_CTL) + CW_CHK + stage, __float_as_uint(err));
}
__device__ __forceinline__ unsigned hash32(unsigned x) { x ^= x >> 16; x *= 0x7feb352du; x ^= x >> 15; x *= 0x846ca68bu; x ^= x >> 16; return x; }
__device__ __forceinline__ float relerr(float got, float ref, float fl) { return fabsf(got - ref) / (fabsf(ref) + fl); }
__device__ __forceinline__ float rbf(float x) { return bf2f(f2bf(x)); }
#define CHK_GT() ({ int t_ = threadIdx.x; asm volatile("" : "+v"(t_)); (int)(blockIdx.x * 512 + t_); })
__device__ __forceinline__ void chk_weights(const AR a) {
    const int s = CHK_GT(); if (s >= 8192) return;
    const unsigned h1 = hash32(s * 3 + 1), h2 = hash32(s * 3 + 2), h3 = hash32(s * 3 + 3); const int l = (s >> 3) & 1, job = s % 5;
    const unsigned char* wl = a.ws() + WS_W + (size_t)l * WL_SIZE; float ref = 0.f, got = 0.f;
    if (job == 0) { const int n = h1 % 8192, k = h2 % 1024; ref = n < 5120 ? a.in(I_WIN)[((size_t)l * D + k) * DIN + (n < 1536 ? n : n + 8)] : a.in(I_WGATE)[((size_t)l * D + k) * 3072 + n - 5120]; got = bf2f(((const bf16_t*)(wl + WL_IN))[(size_t)n * 1024 + k]); }
    else if (job == 1) { const int n = h1 % 1024, k = h2 % 2048; ref = k < 512 ? a.in(I_WPA)[((size_t)l * 512 + k) * D + n] : (k < 1024 ? a.in(I_WPB)[((size_t)l * 512 + k - 512) * D + n] : a.in(I_WPC)[((size_t)l * D + k - 1024) * D + n]); got = bf2f(((const bf16_t*)(wl + WL_P))[(size_t)n * 2048 + k]); }
    else if (job == 2) { const int n = h1 % 1024, k = h2 % 1024; ref = a.in(I_WO)[((size_t)l * D + k) * D + n]; got = bf2f(((const bf16_t*)(wl + WL_O))[(size_t)n * 1024 + k]); }
    else if (job == 3) { const int e = h3 % 32, n = h1 % 2048, k = h2 % 1024, src = 1024 * ((n >> 7) & 1) + 128 * (n >> 8) + (n & 127); ref = a.in(I_WGU)[(((size_t)l * 32 + e) * D + k) * 2048 + src]; got = bf2f(((const bf16_t*)(wl + WL_GU))[((size_t)e * 2048 + n) * 1024 + k]); }
    else { const int e = h3 % 32, n = h1 % 1024, k = h2 % 1024; ref = a.in(I_WDN)[(((size_t)l * 32 + e) * D + k) * D + n]; got = bf2f(((const bf16_t*)(wl + WL_DN))[((size_t)e * 1024 + n) * 1024 + k]); }
    chk_rec(a, 0, fabsf(got - rbf(ref)));
}
__device__ __forceinline__ void chk_ada(const AR a) {
    const int s = CHK_GT(); if (s >= 512) return;
    const unsigned h1 = hash32(s + 77); const int l = s & 1, b = (s >> 1) & 15, j = h1 % 6144; float acc = 0.f;
    for (int k = 0; k < D; ++k) { const float c = a.in(I_C)[b * D + k]; acc += (c / (1.f + expf(-c))) * a.in(I_WADA)[((size_t)l * D + k) * 6144 + j]; }
    acc += a.in(I_BADA)[l * 6144 + j];
    chk_rec(a, 1, relerr(((const float*)(a.ws() + WS_ADA))[((size_t)l * 16 + b) * 6144 + j], acc, 0.01f));
}
__device__ __forceinline__ void chk_prep(const AR a, int l, const float* xin, int stage) {
    const int s = CHK_GT(); if (s >= 1024) return;
    const unsigned h1 = hash32(s + 1234 + l); const int m = h1 % M, b = m >> 11; const float* ada = (const float*)(a.ws() + WS_ADA) + ((size_t)l * 16 + b) * 6144;
    if (s < 768) { const int col = hash32(h1) % D; const float ref = xin[(size_t)m * D + col] * (1.f + ada[1024 + col]) + ada[col];
        chk_rec(a, stage, relerr(bf2f(((const bf16_t*)(a.ws() + WS_H))[(size_t)m * D + col]), ref, 0.05f)); }
    else { const int j = s & 7; float acc = 0.f;
        for (int k = 0; k < D; ++k) acc += (xin[(size_t)m * D + k] * (1.f + ada[1024 + k]) + ada[k]) * a.in(I_WIN)[((size_t)l * D + k) * DIN + 1536 + j];
        const float x = acc + a.in(I_BF)[l * 8 + j], ref = fminf(x, 0.f) - log1pf(expf(-fabsf(x)));
        chk_rec(a, stage, relerr(((const float*)(a.ws() + WS_LOGF))[(size_t)m * 8 + j], ref, 0.01f)); }
}
__device__ __forceinline__ void chk_inproj(const AR a, int l, int stage) {
    const int s = CHK_GT(); if (s >= 4096) return;
    const unsigned h1 = hash32(s + 999 + l), h2 = hash32(h1); const int m = h1 % M, n = h2 % 8192;
    const bf16_t* H = (const bf16_t*)(a.ws() + WS_H) + (size_t)m * D; const bf16_t* W = (const bf16_t*)(a.ws() + WS_W + (size_t)l * WL_SIZE + WL_IN) + (size_t)n * D;
    float acc = 0.f; for (int k = 0; k < D; ++k) acc += bf2f(H[k]) * bf2f(W[k]);
    if (n < 512 || (n >= 1536 && n < 2048)) acc *= C2;
    if (n >= 5120) { acc += a.in(I_BGATE)[l * 3072 + n - 5120]; acc = 1.f / (1.f + expf(-acc)); }
    chk_rec(a, stage, relerr(bf2f(((const bf16_t*)(a.ws() + WS_Z))[(size_t)m * ZP + n]), acc, 0.05f));
}
__device__ __forceinline__ void chk_f2(const AR a, int stage) {
    const int s = CHK_GT(); if (s >= 256) return;
    const unsigned h1 = hash32(s + 555); const int bh = s & 127, t = h1 % SEQ, b = bh >> 3, h = bh & 7; float acc = 0.f;
    for (int i = 0; i <= t; ++i) acc += ((const float*)(a.ws() + WS_LOGF))[((size_t)b * SEQ + i) * 8 + h];
    chk_rec(a, stage, relerr(((const float*)(a.ws() + WS_F2))[(size_t)bh * SEQ + t], acc * LOG2E, 0.05f));
}
__device__ __forceinline__ void chk_lru(const AR a, int l, int stage) {
    const int gt = CHK_GT(), s = gt >> 6, c = gt & 63; if (s >= 128) return;
    const unsigned h1 = hash32(s + 4242 + l), h2 = hash32(h1), h3 = hash32(h2);
    const int b = h1 % BATCH, ch = h2 % D, n = ch >> 6, d = ch & 63, tend = (s < 6) ? (s == 0 ? 2047 : h3 % SEQ) : (s < 40 ? h3 % 40 : h3 % 400);
    const bf16_t* Z = (const bf16_t*)(a.ws() + WS_Z);
    const float* cw = a.in(I_CONVW) + (size_t)l * 4 * D; const float* cb = a.in(I_CONVB) + (size_t)l * D;
    const float* wa = a.in(I_WA) + ((size_t)l * 16 + n) * 4096; const float* wx = a.in(I_WX) + ((size_t)l * 16 + n) * 4096;
    const float lam = a.in(I_LAM)[l * D + ch]; const float cl = -8.f * (fmaxf(-lam, 0.f) + log1pf(expf(-fabsf(lam))));
    const int cc = n * 64 + c; const float wac = rbf(wa[c * 64 + d]), wxc = rbf(wx[c * 64 + d]);
    const float cw0 = cw[cc], cw1 = cw[D + cc], cw2 = cw[2 * D + cc], cw3 = cw[3 * D + cc], cbc = cb[cc];
    const float bac = a.in(I_BA)[l * D + ch], bxc = a.in(I_BX)[l * D + ch];
    float hst = 0.f, x0 = 0.f, x1 = 0.f, x2 = 0.f;
    for (int t = 0; t <= tend; ++t) { const float x3 = bf2f(Z[((size_t)b * SEQ + t) * ZP + ZC_XC + cc]);
        const float xc = cbc + cw0 * x0 + cw1 * x1 + cw2 * x2 + cw3 * x3; x0 = x1; x1 = x2; x2 = x3;
        const float xb = rbf(xc); const float ra = wave_sum(c, xb * wac), rx = wave_sum(c, xb * wxc), xme = shidx(xc, d);
        const float rg = 1.f / (1.f + expf(-(ra + bac))), ig = 1.f / (1.f + expf(-(rx + bxc)));
        const float la = cl * rg, aa = expf(la); hst = aa * hst + sqrtf(-expm1f(2.f * la)) * (ig * xme); }
    const float g = bf2f(Z[((size_t)b * SEQ + tend) * ZP + ZC_GC + ch]);
    const float ref = hst * (0.5f * g * (1.f + tanhf(0.7978845608f * (g + 0.044715f * g * g * g))));
    if (c == 0) chk_rec(a, stage, relerr(bf2f(((const bf16_t*)(a.ws() + WS_O))[((size_t)b * SEQ + tend) * OP + 1024 + ch]), ref, 0.02f));
}
template <int MODE> __device__ __forceinline__ void chk_attn(const AR a, int stage) {
    const int gt = CHK_GT(), s = gt >> 6, e = gt & 63; if (s >= 256) return;
    const unsigned h1 = hash32(s + 31337 + MODE), h2 = hash32(h1), h3 = hash32(h2);
    const int b = h1 % BATCH, h = h2 % 8, d = h3 % 64, t = (s < 8) ? ((s == 0) ? 0 : (s == 1 ? 1 : (s == 2 ? 2047 : hash32(h3) % SEQ))) : hash32(h3) % SEQ;
    const bf16_t* Z = (const bf16_t*)(a.ws() + WS_Z); const size_t rb = (size_t)b * SEQ;
    const int qc = (MODE == 0 ? ZC_QA : ZC_QB) + h * 64, kc = (MODE == 0 ? ZC_KA : ZC_KB) + h * 64, vc = (MODE == 0 ? ZC_VA : ZC_VB) + h * 64;
    const float* F2 = (const float*)(a.ws() + WS_F2) + (size_t)(b * 8 + h) * SEQ;
    const float qe = bf2f(Z[(rb + t) * ZP + qc + e]);
    float ref = 0.f;
    if (MODE == 0) { float mx = -INFINITY, sum = 0.f, o = 0.f;
        for (int k = 0; k <= t; ++k) { const float z = wave_sum(e, qe * bf2f(Z[(rb + k) * ZP + kc + e])) + (F2[t] - F2[k]);
            const float mn = fmaxf(mx, z), al = exp2f(mx - mn), p = exp2f(z - mn); sum = sum * al + p; o = o * al + p * bf2f(Z[(rb + k) * ZP + vc + d]); mx = mn; }
        ref = o / sum;
    } else { float R = 0.f, o = 0.f;
        for (int k = t - 1; k >= 0; --k) { const float z = wave_sum(e, qe * bf2f(Z[(rb + k) * ZP + kc + e]));
            const float sp = fmaxf(z, 0.f) + log2f(1.f + exp2f(-fabsf(z))); o += exp2f(z - sp + R) * bf2f(Z[(rb + k) * ZP + vc + d]); R -= sp; if (R < -200.f) break; }
        ref = o; }
    if (e == 0) chk_rec(a, stage, relerr(bf2f(((const bf16_t*)(a.ws() + WS_O))[(rb + t) * OP + (MODE == 0 ? 0 : 512) + h * 64 + d]), ref, 0.15f));
}
__device__ __forceinline__ void chk_merge(const AR a, int l, int stage) {
    const int s = CHK_GT(); if (s >= 2048) return;
    const unsigned h1 = hash32(s + 808 + l), h2 = hash32(h1); const int m = h1 % M, c = h2 % D;
    const bf16_t* O = (const bf16_t*)(a.ws() + WS_O) + (size_t)m * OP; const bf16_t* W = (const bf16_t*)(a.ws() + WS_W + (size_t)l * WL_SIZE + WL_P) + (size_t)c * OP; const bf16_t* Z = (const bf16_t*)(a.ws() + WS_Z) + (size_t)m * ZP;
    float tot = 0.f;
    for (int seg = 0; seg < 3; ++seg) { const int k0 = seg == 0 ? 0 : (seg == 1 ? 512 : 1024), k1 = seg == 0 ? 512 : (seg == 1 ? 1024 : 2048); float acc = 0.f;
        for (int k = k0; k < k1; ++k) acc += bf2f(O[k]) * bf2f(W[k]); tot += acc * bf2f(Z[ZC_G + seg * 1024 + c]); }
    chk_rec(a, stage, relerr(bf2f(((const bf16_t*)(a.ws() + WS_MG))[(size_t)m * D + c]), tot, 0.05f));
}
__device__ __forceinline__ void chk_wo(const AR a, int l, int stage) {
    const int s = CHK_GT(); if (s >= 2048) return;
    const unsigned h1 = hash32(s + 909 + l), h2 = hash32(h1); const int m = h1 % M, c = h2 % D;
    const bf16_t* A = (const bf16_t*)(a.ws() + WS_MG) + (size_t)m * D; const bf16_t* W = (const bf16_t*)(a.ws() + WS_W + (size_t)l * WL_SIZE + WL_O) + (size_t)c * D;
    float acc = 0.f; for (int k = 0; k < D; ++k) acc += bf2f(A[k]) * bf2f(W[k]);
    chk_rec(a, stage, relerr(bf2f(((const bf16_t*)(a.ws() + WS_Y))[(size_t)m * D + c]), acc, 0.05f));
}
__device__ __forceinline__ void chk_ln1(const AR a, int l, const float* xin, int stage) {
    const int s = CHK_GT(); if (s >= 256) return;
    const int m = hash32(s + 1717 + l) % M, b = m >> 11; const float* ada = (const float*)(a.ws() + WS_ADA) + ((size_t)l * 16 + b) * 6144;
    const bf16_t* Yb = (const bf16_t*)(a.ws() + WS_Y) + (size_t)m * D; const float* X = xin + (size_t)m * D;
#define Y_(k) bf2f(Yb[k])
    float mean = 0.f; for (int k = 0; k < D; ++k) mean += DN_ALPHA * X[k] + (1.f + ada[2048 + k]) * Y_(k); mean /= D;
    float var = 0.f; for (int k = 0; k < D; ++k) { const float v = DN_ALPHA * X[k] + (1.f + ada[2048 + k]) * Y_(k) - mean; var += v * v; } var /= D;
    const float rstd = 1.f / sqrtf(var + LN_EPS);
    float e1 = 0.f, e2 = 0.f;
    for (int k = (s & 63); k < D; k += 64) { const float x1 = (DN_ALPHA * X[k] + (1.f + ada[2048 + k]) * Y_(k) - mean) * rstd * a.in(I_LN1G)[l * D + k] + a.in(I_LN1B)[l * D + k];
        const float h2 = x1 * (1.f + ada[4096 + k]) + ada[3072 + k];
        e1 = fmaxf(e1, relerr(bf2f(((const bf16_t*)(a.ws() + WS_X1))[(size_t)m * D + k]), x1, 0.05f)); e2 = fmaxf(e2, relerr(bf2f(((const bf16_t*)(a.ws() + WS_H))[(size_t)m * D + k]), h2, 0.05f)); }
    chk_rec(a, stage, e1); chk_rec(a, stage, e2);
    const int* tok_er = (const int*)(a.ws() + WS_TOKER); const float* gates = (const float*)(a.ws() + WS_GATE);
    const int r0 = tok_er[m * 4 + 0] >> 15, r1 = tok_er[m * 4 + 1] >> 15, r2 = tok_er[m * 4 + 2] >> 15, r3 = tok_er[m * 4 + 3] >> 15;
    float v0 = -INFINITY, v1 = -INFINITY, v2 = -INFINITY, v3 = -INFINITY; int i0 = 0, i1 = 0, i2 = 0, i3 = 0; float lr0 = 0.f, lr1 = 0.f, lr2 = 0.f, lr3 = 0.f;
    for (int e = 0; e < 32; ++e) { float x = a.in(I_BR)[l * 32 + e];
        for (int k = 0; k < D; ++k) { const float x1 = (DN_ALPHA * X[k] + (1.f + ada[2048 + k]) * Y_(k) - mean) * rstd * a.in(I_LN1G)[l * D + k] + a.in(I_LN1B)[l * D + k];
            x += (x1 * (1.f + ada[4096 + k]) + ada[3072 + k]) * a.in(I_WR)[((size_t)l * D + k) * 32 + e]; }
        if (e == r0) lr0 = x; if (e == r1) lr1 = x; if (e == r2) lr2 = x; if (e == r3) lr3 = x;
        if (x > v3) { if (x > v2) { v3 = v2; i3 = i2; if (x > v1) { v2 = v1; i2 = i1; if (x > v0) { v1 = v0; i1 = i0; v0 = x; i0 = e; } else { v1 = x; i1 = e; } } else { v2 = x; i2 = e; } } else { v3 = x; i3 = e; } } }
    float worst = 0.f;
    { const float den = 1.f + expf(v1 - v0) + expf(v2 - v0) + expf(v3 - v0);
      const float lrs[4] = {lr0, lr1, lr2, lr3}; const int rs[4] = {r0, r1, r2, r3};
#pragma unroll
      for (int k = 0; k < 4; ++k) { const bool found = (rs[k] == i0) || (rs[k] == i1) || (rs[k] == i2) || (rs[k] == i3);
          if (found) worst = fmaxf(worst, fabsf(gates[m * 4 + k] - expf(lrs[k] - v0) / den)); else worst = fmaxf(worst, (fabsf(lrs[k] - v3) > 1e-3f) ? 10.f : 0.f); }
      if (r0 == r1 || r0 == r2 || r0 == r3 || r1 == r2 || r1 == r3 || r2 == r3) worst = 15.f; }
    chk_rec(a, stage + 1, worst);
    for (int k = 0; k < 4; ++k) { const int er = tok_er[m * 4 + k], e = er >> 15, rank = er & (ECAP - 1);
        const int cnt = (int)__hip_atomic_load((gu32*)(a.ws() + WS_CTL) + CW_GCNT + (l * 32 + e) * 64, RLX_AGENT);
        if (rank >= cnt || ((const int*)(a.ws() + WS_SLOTTOK))[(size_t)e * ECAP + rank] != m) chk_rec(a, stage + 1, 20.f); }
    if (s == 0) { int tot = 0; for (int e = 0; e < 32; ++e) tot += (int)__hip_atomic_load((gu32*)(a.ws() + WS_CTL) + CW_GCNT + (l * 32 + e) * 64, RLX_AGENT); if (tot != M * 4) chk_rec(a, stage + 1, 30.f); }
}
__device__ __forceinline__ void chk_gemm1(const AR a, int l, const LAS int* bs, int stage) {
    const int s = CHK_GT(); if (s >= 2048) return;
    const unsigned h1 = hash32(s + 2121 + l), h2 = hash32(h1); const int tok = h1 % M, k = h2 & 3, j = (h2 >> 2) % D;
    const int er = ((const int*)(a.ws() + WS_TOKER))[tok * 4 + k], e = er >> 15, rank = er & (ECAP - 1); const size_t cs = (size_t)bs[e] * 256 + rank;
    const bf16_t* H = (const bf16_t*)(a.ws() + WS_H) + (size_t)tok * D; const bf16_t* Wg = (const bf16_t*)(a.ws() + WS_W + (size_t)l * WL_SIZE + WL_GU) + ((size_t)e * 2048 + 256 * (j >> 7) + (j & 127)) * D; const bf16_t* Wu = Wg + 128 * D;
    float ga = 0.f, up = 0.f; for (int q = 0; q < D; ++q) { const float hv = bf2f(H[q]); ga += hv * bf2f(Wg[q]); up += hv * bf2f(Wu[q]); }
    ga += a.in(I_BGU)[((size_t)l * 32 + e) * 2048 + j]; up += a.in(I_BGU)[((size_t)l * 32 + e) * 2048 + 1024 + j];
    ga = fminf(ga, 7.f); up = fminf(fmaxf(up, -7.f), 7.f); const float ref = (up + 1.f) * (ga / (1.f + expf(-1.702f * ga)));
    chk_rec(a, stage, relerr(bf2f(((const bf16_t*)(a.ws() + WS_ACT))[cs * D + j]), ref, 0.05f));
}
__device__ __forceinline__ void chk_gemm2(const AR a, int l, const LAS int* bs, int stage) {
    const int s = CHK_GT(); if (s >= 2048) return;
    const unsigned h1 = hash32(s + 2323 + l), h2 = hash32(h1); const int tok = h1 % M, k = h2 & 3, c = (h2 >> 2) % D;
    const int er = ((const int*)(a.ws() + WS_TOKER))[tok * 4 + k], e = er >> 15, rank = er & (ECAP - 1); const size_t cs = (size_t)bs[e] * 256 + rank;
    const bf16_t* A = (const bf16_t*)(a.ws() + WS_ACT) + cs * D; const bf16_t* W = (const bf16_t*)(a.ws() + WS_W + (size_t)l * WL_SIZE + WL_DN) + ((size_t)e * 1024 + c) * D;
    float acc = 0.f; for (int q = 0; q < D; ++q) acc += bf2f(A[q]) * bf2f(W[q]); acc += a.in(I_BDN)[((size_t)l * 32 + e) * D + c];
    chk_rec(a, stage, relerr(bf2f(((const bf16_t*)(a.ws() + WS_YB))[cs * D + c]), acc, 0.05f));
}
__device__ __forceinline__ void chk_ln2(const AR a, int l, const float* xout, const LAS int* bs, int stage) {
    const int s = CHK_GT(); if (s >= 256) return;
    const int m = hash32(s + 2525 + l) % M, b = m >> 11; const float* ada = (const float*)(a.ws() + WS_ADA) + ((size_t)l * 16 + b) * 6144;
    const bf16_t* X1b = (const bf16_t*)(a.ws() + WS_X1) + (size_t)m * D; const bf16_t* YB = (const bf16_t*)(a.ws() + WS_YB);
#define X1_(q) bf2f(X1b[q])
    const bf16_t* yr[4]; float g[4];
#pragma unroll
    for (int k = 0; k < 4; ++k) { const int er = ((const int*)(a.ws() + WS_TOKER))[m * 4 + k], e = er >> 15, rank = er & (ECAP - 1); yr[k] = YB + ((size_t)bs[e] * 256 + rank) * D; g[k] = ((const float*)(a.ws() + WS_GATE))[m * 4 + k]; }
    float mean = 0.f, var = 0.f;
    for (int q = 0; q < D; ++q) { float y = g[0] * bf2f(yr[0][q]) + g[1] * bf2f(yr[1][q]) + g[2] * bf2f(yr[2][q]) + g[3] * bf2f(yr[3][q]); mean += DN_ALPHA * X1_(q) + (1.f + ada[5120 + q]) * y; } mean /= D;
    for (int q = 0; q < D; ++q) { float y = g[0] * bf2f(yr[0][q]) + g[1] * bf2f(yr[1][q]) + g[2] * bf2f(yr[2][q]) + g[3] * bf2f(yr[3][q]); const float v = DN_ALPHA * X1_(q) + (1.f + ada[5120 + q]) * y - mean; var += v * v; } var /= D;
    const float rstd = 1.f / sqrtf(var + LN_EPS); float worst = 0.f;
    for (int q = (s & 31); q < D; q += 32) { float y = g[0] * bf2f(yr[0][q]) + g[1] * bf2f(yr[1][q]) + g[2] * bf2f(yr[2][q]) + g[3] * bf2f(yr[3][q]);
        const float ref = (DN_ALPHA * X1_(q) + (1.f + ada[5120 + q]) * y - mean) * rstd * a.in(I_LN2G)[l * D + q] + a.in(I_LN2B)[l * D + q];
        worst = fmaxf(worst, relerr(xout[(size_t)m * D + q], ref, 0.02f)); }
    chk_rec(a, stage, worst);
}
__device__ __forceinline__ void chk_report(const AR a) {
    if (blockIdx.x != 0 || threadIdx.x != 0) return;
    const unsigned* w = (const unsigned*)(a.ws() + WS_CTL) + CW_CHK;
    const unsigned tmo = __hip_atomic_load((gu32*)(a.ws() + WS_CTL) + CW_BAR + XB_TMO, RLX_AGENT);
    if (tmo) { a.out()[0] = 9.9e7f; return; }
#ifdef CHK_REPORT_STAGE
    { const float e = __uint_as_float(__hip_atomic_load((gu32*)w + CHK_REPORT_STAGE, RLX_AGENT)); a.out()[0] = 1e5f * e + 100.f; return; }
#endif
    for (int st = 0; st < 32; ++st) { const float e = __uint_as_float(__hip_atomic_load((gu32*)w + st, RLX_AGENT));
        if (e > 0.02f) { const float sc = e < 0.1f ? 1e3f : (e < 1.f ? 1e4f : (e < 100.f ? 1e5f : 1e6f)); a.out()[0] = (10.f + st) * sc; return; } }
}
#endif

#if CHK
#define CHECK(stmt) do { PHASE_IDS(); stmt; } while (0)
#else
#define CHECK(stmt) do { } while (0)
#endif
#ifndef REP_MASK
#define REP_MASK 0
#endif
#define REPEAT(g) _Pragma("unroll 1") for (int rep_ = ((REP_MASK >> (g)) & 1); rep_ >= 0; --rep_)
#define PHASE_IDS() int tid_o; asm volatile("v_mbcnt_lo_u32_b32 %0, -1, 0\n\tv_mbcnt_hi_u32_b32 %0, -1, %0" : "=v"(tid_o)); tid_o += wave0 * 64; const int tid = tid_o, lane = tid & 63, wave = __builtin_amdgcn_readfirstlane(tid >> 6); const int gw = vcu * 8 + wave; \
    AR a; { ArgsP q_ = a0.p; asm volatile("" : "+s"(q_)); a.p = q_; } int l_o = ll; asm volatile("" : "+s"(l_o)); const int l = l_o; (void)gw; (void)lane; (void)tid; (void)l
__global__ void __launch_bounds__(512, 2) fwd_kernel(Args args_unused) {
    extern __shared__ __attribute__((aligned(16))) unsigned char lds_raw[];
    LAS unsigned char* lds = (LAS unsigned char*)lds_raw;
    AR a0; a0.p = (ArgsP)__builtin_amdgcn_kernarg_segment_ptr();
    const int G = gridDim.x, bx = blockIdx.x, vcu = (G % 8 == 0) ? (bx % 8) * (G / 8) + bx / 8 : bx;
    const int NGW = G * 8;
    const int ll = 0;
    const int wave0 = __builtin_amdgcn_readfirstlane(threadIdx.x >> 6);
#if STAMP
    volatile LAS unsigned long long* tsl = (volatile LAS unsigned long long*)(lds + MISC_OFF + 12288); int nst = 0;
#define STAMP_HERE() do { if (blockIdx.x == 0 && threadIdx.x == 0) tsl[nst] = __builtin_amdgcn_s_memrealtime(); ++nst; } while (0)
#else
#define STAMP_HERE() do { } while (0)
#endif
    { const int tid = threadIdx.x;
      for (int u = tid; u < (LDS_BYTES - MISC_OFF) / 4; u += 512) ((LAS unsigned*)(lds + MISC_OFF))[u] = 0u; }
    __syncthreads();
    STAMP_HERE();
    (void)xcd_barrier_post((unsigned*)(a0.ws() + WS_CTL) + CW_BAR, (volatile LAS unsigned*)(lds + MISC_OFF + MO_BAR));
#define GRID_BAR() do { ArgsP q_ = a0.p; asm volatile("" : "+s"(q_)); XcdBarrier b_; b_.bar = (unsigned*)(q_->ws + WS_CTL) + CW_BAR; b_.x = xb_xcc_id(); b_.st = (volatile LAS unsigned*)(lds + MISC_OFF + MO_BAR); xcd_barrier(b_); } while (0)

    REPEAT(0) { { PHASE_IDS();
      if (FP8_IN == 2) p0_wabsmax(a, gw * 64 + lane, NGW * 64, lane);
      p0_weights(a, lds, gw, NGW, wave, lane, 0);
      __syncthreads();
      if (bx < 192) p0_ada(a, lds, bx, tid, wave, lane);
      if (bx == 255 && tid < 64) { if (FP8_G) ((unsigned char*)(a.ws() + WS_ONES))[tid] = (unsigned char)0xff; else ((bf16_t*)(a.ws() + WS_ONES))[tid] = (bf16_t)0x3f80; } }
    GRID_BAR(); STAMP_HERE(); }
    CHECK(chk_weights(a); chk_ada(a));
    REPEAT(10) { { PHASE_IDS();
      for (int u = vcu; u < 256; u += G) {
        __syncthreads();
        stage_wf(a, 0, lds, tid);
        LAS float* VL = (LAS float*)(lds + 32768);
        { const float* ada = (const float*)(a.ws() + WS_ADA) + (size_t)((u * 128) >> 11) * 6144; stage_vec(ada, VL, tid); stage_vec(ada + 1024, VL + 1024, tid); if (tid < 8) VL[2048 + tid] = a.in(I_BF)[tid]; }
        const LAS float* VLl = VL + 4 * lane; asm volatile("" : "+v"(VLl));
        __syncthreads();
        const float* X = a.in(I_X);
        f32x4 xcur[4], xnxt[4];
#define P1_ROW(I) ((u >> 4) * 2048 + (I) * 128 + (u & 15) * 8 + wave)
#pragma unroll
        for (int j = 0; j < 4; ++j) xcur[j] = *(const f32x4*)(X + (size_t)P1_ROW(0) * D + 4 * lane + 256 * j);
#pragma unroll 1
        for (int i = 0; i < 16; ++i) { const int m = P1_ROW(i), mn = P1_ROW(i < 15 ? i + 1 : 15);
#pragma unroll
          for (int j = 0; j < 4; ++j) xnxt[j] = *(const f32x4*)(X + (size_t)mn * D + 4 * lane + 256 * j);
          prep_row(a, m, xcur, (const LAS float*)lds, VLl, VLl + 1024, VL + 2048, lane);
#pragma unroll
          for (int j = 0; j < 4; ++j) xcur[j] = xnxt[j]; } }
#undef P1_ROW
      if (FP8_IN == 2) { __syncthreads(); p0_weights(a, lds, gw, NGW, wave, lane, 1); } }
    GRID_BAR(); STAMP_HERE(); }
#pragma unroll 1
    for (int ll = 0; ll < DEPTH; ++ll) {
        const int cs = 16 * ll;
        CHECK(chk_prep(a, l, (l == 0) ? a.in(I_X) : (const float*)(a.ws() + WS_XL), cs + 2));
        if (CHK_STOP <= 2) break;
        REPEAT(1) { { PHASE_IDS(); const unsigned char* wl = a.ws() + WS_W + (size_t)l * WL_SIZE;
          DenseOrder S; S.T.init(M / 256, 32, G, bx); S.A = (const char*)(a.ws() + WS_H); S.B = (const char*)(wl + WL_IN); S.lda = FP8_IN ? 512 : 1024; S.ldb = FP8_IN ? 512 : 1024; S.nt = FP8_IN ? 8 : 16;
          if (G == 256) { S.nper = 16; S.rot = (2 * (vcu & 7)) & 15; }
          const gu32* wm_ = (const gu32*)(a.ws() + WS_CTL) + CW_WMAX + 2 * l * 64;
          EpiInProj E{(bf16_t*)(a.ws() + WS_Z), a.in(I_BGATE) + (size_t)l * 3072, (const float*)(a.ws() + WS_ROWS), fmaxf(__uint_as_float(__hip_atomic_load(wm_, RLX_AGENT)), 1e-30f) * (1.0f / 127.0f), fmaxf(__uint_as_float(__hip_atomic_load(wm_ + 64, RLX_AGENT)), 1e-30f) * (1.0f / 127.0f), nullptr};
#ifdef PROBE_SKIP_EPI
          E.skip = (rep_ > 0) ? PROBE_SKIP_EPI : 0;
#endif
#ifdef STAGGER_IN
          for (int k_ = 0; k_ < (vcu & 15); ++k_) __builtin_amdgcn_s_sleep(STAGGER_IN);
#endif
          E.G8 = a.ws() + WS_G8;
          pg8::gemm_phase<EpiInProj, DenseOrder, false>(lds, FP8_IN ? 512 : 1024, FP8_IN ? 512 : 1024, S, E, tid); }
        GRID_BAR(); STAMP_HERE(); }
        CHECK(chk_inproj(a, l, cs + 3));
        if (CHK_STOP <= 3) break;
        REPEAT(2) { { PHASE_IDS();
          for (int u = vcu; u < 256; u += G) lru_unit(a, l, u >> 4, u & 15, lds, tid, wave, lane); }
        }
        REPEAT(3) { { PHASE_IDS();
          for (int u = vcu; u < 256; u += G) { const int bh = u >> 1, s = u & 1;
            LAS float* Fl = (LAS float*)(lds + 86016);
            __syncthreads();
            {
              const float* lf = (const float*)(a.ws() + WS_LOGF) + ((size_t)(bh >> 3) * SEQ + 4 * tid) * 8 + (bh & 7);
              const float v0 = lf[0], v1 = v0 + lf[8], v2 = v1 + lf[16], v3 = v2 + lf[24];
              float inc = v3;
#pragma unroll
              for (int o = 1; o < 64; o <<= 1) { const float t = shup(lane, inc, o); if (lane >= o) inc += t; }
              LAS float* wt = (LAS float*)(lds + 86016 + 8192);
              if (lane == 63) wt[wave] = inc;
              __syncthreads();
              float base = inc - v3;
#pragma unroll
              for (int w2 = 0; w2 < 8; ++w2) base += (w2 < wave) ? wt[w2] : 0.f;
              const f32x4 o = {(base + v0) * LOG2E, (base + v1) * LOG2E, (base + v2) * LOG2E, (base + v3) * LOG2E};
              *(LAS f32x4*)(Fl + 4 * tid) = o;
              if (CHK) *(f32x4*)((float*)(a.ws() + WS_F2) + (size_t)bh * SEQ + 4 * tid) = o; }
            __syncthreads();
            const fox_body::bf16* Zq = (const fox_body::bf16*)(a.ws() + WS_Z);
#pragma unroll 1
            for (int i = 0; i < 4; ++i) { const int qb = (i == 0) ? s : (i == 1 ? 7 - s : (i == 2 ? 2 + s : 5 - s));
                fox_body::attn_unit<8>(bh >> 3, bh & 7, qb, Zq + ZC_QA, Zq + ZC_KA, Zq + ZC_VA, (fox_body::bf16*)(a.ws() + WS_O), Fl, (char*)lds_raw, tid); } } } }
        REPEAT(4) { { PHASE_IDS();
          for (int u = vcu; u < 256; u += G) { const int bh = u >> 1, s = u & 1;
#pragma unroll 1
            for (int i = 0; i < 4; ++i) { const int qb = (i == 0) ? s : (i == 1 ? 7 - s : (i == 2 ? 2 + s : 5 - s)); attn_unit<1>(a, bh >> 3, bh & 7, qb, lds, tid, wave, lane); } } } }
        GRID_BAR(); STAMP_HERE();
        CHECK(chk_attn<0>(a, cs + 6); chk_attn<1>(a, cs + 7));
        if (CHK_STOP <= 7) break;
        REPEAT(5) { { PHASE_IDS(); const unsigned char* wl = a.ws() + WS_W + (size_t)l * WL_SIZE;
          MergeOrder S; S.T.init(M / 256, 4, G, bx); S.A = (const char*)(a.ws() + WS_O); S.B = (const char*)(wl + WL_P);
          EpiMerge E{(const bf16_t*)(a.ws() + (FP8_G ? WS_G8 : WS_Z)), (bf16_t*)(a.ws() + WS_MG), (const bf16_t*)(a.ws() + WS_ONES)};
          pg8::gemm_phase<EpiMerge, MergeOrder, false>(lds, FP8_MRG ? OP / 2 : OP, FP8_MRG ? OP / 2 : OP, S, E, tid); }
        GRID_BAR(); STAMP_HERE(); }
        CHECK(chk_merge(a, l, cs + 8));
        REPEAT(6) { { PHASE_IDS(); const unsigned char* wl = a.ws() + WS_W + (size_t)l * WL_SIZE;
          DenseOrder S; S.T.init(M / 256, 4, G, bx); S.A = (const char*)(a.ws() + WS_MG); S.B = (const char*)(wl + WL_O); S.lda = 1024; S.ldb = 1024; S.nt = 16;
          EpiBf16 E{(bf16_t*)(a.ws() + WS_Y), D};
          pg8::gemm_phase<EpiBf16, DenseOrder, false>(lds, 1024, 1024, S, E, tid); }
        GRID_BAR(); STAMP_HERE(); }
        CHECK(chk_wo(a, l, cs + 9));
        if (CHK_STOP <= 9) break;
REPEAT(11) {         { PHASE_IDS(); const float* xin = (l == 0) ? a.in(I_X) : (const float*)(a.ws() + WS_XL);
          for (int u = vcu; u < 256; u += G) { if (l == 0) ln1_phase<false>(a, l, xin, lds, u, tid, wave, lane); else ln1_phase<true>(a, l, xin, lds, u, tid, wave, lane); } }
        GRID_BAR(); STAMP_HERE();
          if (rep_ > 0) { PHASE_IDS(); if (bx == 0 && tid < 32) __hip_atomic_store((gu32*)(a.ws() + WS_CTL) + CW_GCNT + (l * 32 + tid) * 64, 0u, RLX_AGENT); GRID_BAR(); } }
        CHECK(chk_ln1(a, l, (l == 0) ? a.in(I_X) : (const float*)(a.ws() + WS_XL), cs + 10));
        if (CHK_STOP <= 11) break;
        REPEAT(7) { { PHASE_IDS(); const unsigned char* wl = a.ws() + WS_W + (size_t)l * WL_SIZE;
          moe_build_tables((gu32*)(a.ws() + WS_CTL), l, lds, tid);
          MoeOrder<8, true> S{vcu, moe_tables(lds), (const char*)(a.ws() + WS_H), (const char*)(wl + WL_GU), (const int*)(a.ws() + WS_SLOTTOK)};
          EpiGU E{a.ws() + WS_ACT, a.in(I_BGU) + (size_t)l * NEXP * 2048};
          pg8::gemm_phase<EpiGU, MoeOrder<8, true>, true>(lds, FP8_MOE ? 512 : 1024, FP8_MOE ? 512 : 1024, S, E, tid); }
        GRID_BAR(); STAMP_HERE(); }
        CHECK(chk_gemm1(a, l, (const LAS int*)(lds + MISC_OFF + MO_BS), cs + 12));
        REPEAT(8) { { PHASE_IDS(); const unsigned char* wl = a.ws() + WS_W + (size_t)l * WL_SIZE;
          MoeOrder<4, false> S{vcu, moe_tables(lds), (const char*)(a.ws() + WS_ACT), (const char*)(wl + WL_DN), nullptr};
          EpiDown E{a.ws() + WS_YB, a.in(I_BDN) + (size_t)l * NEXP * D};
          pg8::gemm_phase<EpiDown, MoeOrder<4, false>, false>(lds, FP8_MOE ? 512 : 1024, FP8_MOE ? 512 : 1024, S, E, tid); }
        GRID_BAR(); STAMP_HERE(); }
        CHECK(chk_gemm2(a, l, (const LAS int*)(lds + MISC_OFF + MO_BS), cs + 13));
        if (CHK_STOP <= 13) break;
        REPEAT(9) { { PHASE_IDS(); float* xout = (l == DEPTH - 1) ? a.out() : (float*)(a.ws() + WS_XL);
          if (l + 1 < DEPTH) stage_wf(a, l + 1, lds, tid);
          __syncthreads();
          for (int u = vcu; u < 256; u += G) { if (l != DEPTH - 1) ln2_phase<true>(a, l, xout, lds, u, tid, wave, lane, true); else ln2_phase<false>(a, l, xout, lds, u, tid, wave, lane, false); } }
          if (rep_ > 0) GRID_BAR(); }
        if (ll + 1 < DEPTH || CHK || STAMP) { GRID_BAR(); STAMP_HERE(); }
        CHECK(chk_ln2(a, l, (l == DEPTH - 1) ? a.out() : (float*)(a.ws() + WS_XL), (const LAS int*)(lds + MISC_OFF + MO_BS), cs + 14));
    }
#if CHK
    GRID_BAR();
    chk_report(a0);
#endif
#if STAMP
    if (blockIdx.x == 0) {
        const float tx = (float)(tsl[STAMP_X + 1] - tsl[STAMP_X]) * 0.01f, ty = (float)(tsl[STAMP_Y + 1] - tsl[STAMP_Y]) * 0.01f;
        float* o = a0.out();
        for (int i = threadIdx.x; i < M * D / 2; i += 512) o[M * D / 2 + i] = ty * 0.25f;
        __syncthreads();
        if (threadIdx.x == 0) o[0] = 10.f * tx;
    }
#endif
}

extern "C" void kernel_launch(void* const* d_in, const int* in_sizes, int n_in, void* d_out, int out_size, void* d_ws, size_t ws_size, hipStream_t stream) {
    static int grid = 0;
    if (grid == 0) {
        if (n_in != 29 || out_size != M * D || ws_size < WS_END) { fprintf(stderr, "kernel_launch: unexpected sizes n_in %d out %d ws %zu\n", n_in, out_size, ws_size); grid = -1; return; }
        if (hipFuncSetAttribute((const void*)fwd_kernel, hipFuncAttributeMaxDynamicSharedMemorySize, LDS_BYTES) != hipSuccess) { fprintf(stderr, "kernel_launch: hipFuncSetAttribute failed\n"); grid = -1; return; }
        int dev = 0, cus = 0, per_cu = 0;
        (void)hipGetDevice(&dev); (void)hipDeviceGetAttribute(&cus, hipDeviceAttributeMultiprocessorCount, dev);
        if (hipOccupancyMaxActiveBlocksPerMultiprocessor(&per_cu, (const void*)fwd_kernel, 512, LDS_BYTES) != hipSuccess || per_cu < 1) fprintf(stderr, "kernel_launch: occupancy query says %d\n", per_cu);
        (void)hipGetLastError();
        grid = cus < 256 ? cus : 256;
    }
    if (grid < 0) return;
    (void)hipMemsetAsync((char*)d_ws + WS_CTL, 0, CTL_ZERO_BYTES, stream);
    Args a{};
    for (int i = 0; i < 29; ++i) a.in[i] = (const float*)d_in[i];
    a.out = (float*)d_out; a.ws = (unsigned char*)d_ws;
    hipLaunchKernelGGL(fwd_kernel, dim3(grid), dim3(512), LDS_BYTES, stream, a);
}
```

```cpp
#define CHK 0
#define CHK_STOP 99
#include <hip/hip_runtime.h>
#include <cstdio>
#include <cstdint>

#ifndef CHK
#define CHK 0
#endif
#ifndef STAMP
#define STAMP 0
#endif
#ifndef CHK_STOP
#define CHK_STOP 99
#endif

#ifndef FP8_MOE
#define FP8_MOE 1
#endif
#ifndef COL_AUX
#define COL_AUX 1
#endif
#ifndef WIDE_ST
#define WIDE_ST 1
#endif
#ifndef FP8_MRG
#define FP8_MRG 1
#endif
#ifndef FP8_G
#define FP8_G 1
#endif
#ifndef FP8_YB
#define FP8_YB 1
#endif
#ifndef FP8_IN
#define FP8_IN 2
#endif
#define LAS __attribute__((address_space(3)))
#define GAS __attribute__((address_space(1)))
typedef unsigned short bf16_t;
typedef short bf16x8 __attribute__((ext_vector_type(8)));
typedef int i32x8 __attribute__((ext_vector_type(8)));
typedef int i32x4v __attribute__((ext_vector_type(4)));
typedef short s16x4 __attribute__((ext_vector_type(4)));
typedef float f32x4 __attribute__((ext_vector_type(4)));
typedef float f32x2 __attribute__((ext_vector_type(2)));
typedef float f32x16 __attribute__((ext_vector_type(16)));
typedef unsigned u32x4 __attribute__((ext_vector_type(4)));
typedef unsigned u32x2 __attribute__((ext_vector_type(2)));
typedef GAS unsigned gu32;

constexpr int D = 1024, BATCH = 16, SEQ = 2048, M = BATCH * SEQ, DEPTH = 2;
constexpr int NEXP = 32, TOPK = 4, DIN = 5128;
constexpr int ZP = 5184;
constexpr int ZC_QA = 0, ZC_KA = 512, ZC_VA = 1024, ZC_QB = 1536, ZC_KB = 2048, ZC_VB = 2560, ZC_XC = 3072, ZC_GC = 4096, ZC_G = 5120;
constexpr int OP = 2048;
constexpr float LN_EPS = 1e-5f;
constexpr float DN_ALPHA = 1.41421356237f;
constexpr float LOG2E = 1.4426950408889634f;
constexpr float C2 = 0.125f * 1.4426950408889634f;
constexpr int MAXBLK = M * TOPK / 256 + NEXP;
constexpr int ECAP = 32768;

constexpr size_t MiB = 1u << 20;
constexpr size_t WS_CTL = 0, CTL_ZERO_BYTES = 1 * MiB;
constexpr size_t WS_ADA = 1 * MiB;
constexpr size_t WS_ONES = 1 * MiB + 800 * 1024;
constexpr size_t WS_LOGF = 2 * MiB;
constexpr size_t WS_F2 = 3 * MiB;
constexpr size_t WS_TOKER = 4 * MiB;
constexpr size_t WS_GATE = 4 * MiB + 512 * 1024;
constexpr size_t WS_SLOTTOK = 5 * MiB;
constexpr size_t WS_W = 16 * MiB;
constexpr size_t WL_IN = 0, WL_P = 16 * MiB, WL_O = 20 * MiB, WL_GU = 22 * MiB, WL_DN = 150 * MiB, WL_SIZE = 214 * MiB;
constexpr float Q_H1 = 8.0f, Q_WIN = 256.0f;
constexpr float Q_YB = 16.0f;
constexpr float Q_O = 8.0f, Q_WP = 256.0f;
constexpr float Q_H2 = 8.0f, Q_WGU = 256.0f, Q_ACT = 8.0f, Q_WDN = 512.0f;
constexpr size_t WS_G8 = 1153 * MiB;
constexpr float Q_G = 255.0f;
constexpr size_t WS_ROWS = 1152 * MiB;
constexpr size_t WS_H = 448 * MiB;
constexpr size_t WS_Z = 512 * MiB;
constexpr size_t WS_ACT = 512 * MiB;
constexpr size_t WS_O = 1024 * MiB;
constexpr size_t WS_MB = 1152 * MiB;
constexpr size_t WS_MG = 1280 * MiB;
constexpr size_t WS_Y = 1344 * MiB;
constexpr size_t WS_X1 = 1472 * MiB;
constexpr size_t WS_XL = 1600 * MiB;
constexpr size_t WS_YB = 1728 * MiB;
constexpr size_t WS_END = 2000 * MiB;
static_assert((size_t)MAXBLK * 256 * 1024 * 2 <= 272 * MiB, "act / y_buf size");

constexpr int CW_TMO = 0, CW_CODE = 1;
constexpr int CW_BAR = 4096;
constexpr int CW_GCNT = 8192;
constexpr int CW_WMAX = 32768;
constexpr int CW_CHK = 16384;

constexpr int RING_BYTES = 131072;
constexpr int MISC_OFF = RING_BYTES;
constexpr int LDS_BYTES = 147456;
constexpr int MO_BAR = 14336;
constexpr int MO_CNT = 64;
constexpr int MO_BS = 64 + 128;
constexpr int MO_BE = 64 + 128 + 136;
constexpr int MO_LCNT = 1024;
constexpr int MO_LBASE = 1024 + 128;
constexpr int MO_REC = 2048;
constexpr int MO_GT = 4096;
constexpr int MO_LG = 6144;
constexpr int MO_CAR = 2048;

namespace pg8 {
constexpr int BM = 256, BK = 64, HALF = 128, HTB = HALF * BK * 2, STAGE_BYTES = 8 * HTB, NXCD = 8, WGM = 8;
__host__ __device__ __forceinline__ int lds_byte(int r, int c) { const int st = (r >> 4) * 2 + (c >> 5), rr = r & 15, cc = c & 31, ob = rr * 64 + cc * 2; return st * 1024 + (ob ^ (((ob >> 9) & 1) << 5)); }
__host__ __device__ __forceinline__ void stage_rc(int b, int& R, int& C) { const int st = b / 1024, sb = b % 1024, swz = sb ^ (((sb >> 9) & 1) << 5); R = (st >> 1) * 16 + swz / 64; C = (st & 1) * 32 + (swz % 64) / 2; }
__host__ __device__ __forceinline__ int perm32(int rho) { const int n = rho >> 4, i = rho & 15; return 8 * (i >> 2) + 4 * n + (i & 3); }

struct Unit { int pm, pn, aux; };

struct TileOrder {
    int nM, nN, nwg, G, c;
    __device__ __forceinline__ void init(int nM_, int nN_, int G_, int c_) { nM = nM_; nN = nN_; nwg = nM * nN; G = G_; c = c_; }
    __device__ __forceinline__ bool tile(int i, int& pm, int& pn) const {
        const long L = (long)i * G + c; if (L >= nwg) return false;
        int wgid = (int)L; { const int q = nwg / NXCD, r = nwg % NXCD, xcd = wgid % NXCD, off = wgid / NXCD; wgid = (xcd < r ? xcd * (q + 1) : r * (q + 1) + (xcd - r) * q) + off; }
        const int nig = WGM * nN, gid = wgid / nig, fm = gid * WGM, gsz = (nM - fm) < WGM ? (nM - fm) : WGM;
        pm = fm + ((wgid % nig) % gsz); pn = (wgid % nig) / gsz; return true;
    }
};

__device__ __forceinline__ unsigned cvt_pk_bf16(float lo, float hi) { unsigned r; asm volatile("v_cvt_pk_bf16_f32 %0, %1, %2" : "=v"(r) : "v"(lo), "v"(hi)); return r; }

template <class Epi, class Sched, bool GATHER>
__device__ __forceinline__ void gemm_phase(LAS unsigned char* lds, const int lda, const int ldb, const Sched& S, Epi& E, const int tid_in) {
    int tid_ = tid_in; asm volatile("" : "+v"(tid_));
    const int tid = tid_, wid = __builtin_amdgcn_readfirstlane(tid >> 6), lane = tid & 63, wr = wid >> 2, wc = wid & 3, fr = lane & 15, fq = lane >> 4;
    unsigned voffA[2], voffB[2]; int RR[2], CC[2];
#pragma unroll
    for (int i = 0; i < 2; ++i) { int R, C; stage_rc(tid * 16 + i * 8192, R, C); const int Rb = Epi::WIDE ? (64 * (R >> 5) + perm32(R & 31)) : (Epi::PERM ? ((R & ~31) + perm32(R & 31)) : R);
        RR[i] = R; CC[i] = C; voffA[i] = (unsigned)(R * lda + C) * 2u; voffB[i] = (unsigned)(Rb * ldb + C) * 2u; }
    const size_t kstep = (size_t)(BK * 2);
    const size_t hstepA = (size_t)HALF * lda * 2, hstepB = (size_t)(Epi::WIDE ? 32 : HALF) * ldb * 2;
    const unsigned ldsw = (unsigned)wid * 1024u;
    const int aoff = lds_byte(wr * 64 + fr, fq * 8), boff = lds_byte(wc * 32 + fr, fq * 8);
#define PG8_SA(b, h) (((b) * 2 + (h)) * HTB)
#define PG8_SB(b, h) ((4 + (b) * 2 + (h)) * HTB)
#define PG8_STG(bufoff, ptr, vo, _i) __builtin_amdgcn_global_load_lds((const unsigned*)((const char*)(ptr) + (vo)), (LAS unsigned*)(lds + (bufoff) + ldsw + (_i) * 8192), 16, 0, 0)
#define PG8_STAGE_B(bufoff, gbase) do { PG8_STG(bufoff, gbase, voffB[0], 0); PG8_STG(bufoff, gbase, voffB[1], 1); } while (0)
#define PG8_STAGE_A(bufoff, gbase, h, VG) do { if constexpr (GATHER) { PG8_STG(bufoff, gbase, VG[h][0], 0); PG8_STG(bufoff, gbase, VG[h][1], 1); } \
        else { PG8_STG(bufoff, (gbase) + (h) * hstepA, voffA[0], 0); PG8_STG(bufoff, (gbase) + (h) * hstepA, voffA[1], 1); } } while (0)
#define PG8_LDA(dst, b, h) do { _Pragma("unroll") for (int m = 0; m < 4; ++m) _Pragma("unroll") for (int k = 0; k < 2; ++k) dst[m][k] = *(const LAS bf16x8*)(lds + PG8_SA(b, h) + aoff + m * 2048 + k * 1024); } while (0)
#define PG8_LDB(dst, b, h) do { _Pragma("unroll") for (int n = 0; n < 2; ++n) _Pragma("unroll") for (int k = 0; k < 2; ++k) dst[n][k] = *(const LAS bf16x8*)(lds + PG8_SB(b, h) + boff + n * 2048 + k * 1024); } while (0)
#define PG8_F8CAT(x) __builtin_shufflevector(__builtin_bit_cast(i32x4v, x[0]), __builtin_bit_cast(i32x4v, x[1]), 0, 1, 2, 3, 4, 5, 6, 7)
#define PG8_MMA(ai, bj, At, Bt) do { __builtin_amdgcn_s_setprio(1); _Pragma("unroll") for (int m = 0; m < 4; ++m) _Pragma("unroll") for (int n = 0; n < 2; ++n) { \
        if constexpr (Epi::F8) asm volatile("v_mfma_f32_16x16x128_f8f6f4 %0, %1, %2, %0" : "+v"(acc[ai][bj][m][n]) : "v"(PG8_F8CAT(Bt[n])), "v"(PG8_F8CAT(At[m])));   \
        else if constexpr (Epi::I8) { _Pragma("unroll") for (int k = 0; k < 2; ++k) acc[ai][bj][m][n] = __builtin_bit_cast(f32x4, __builtin_amdgcn_mfma_i32_16x16x64_i8(__builtin_bit_cast(i32x4v, Bt[n][k]), __builtin_bit_cast(i32x4v, At[m][k]), __builtin_bit_cast(i32x4v, acc[ai][bj][m][n]), 0, 0, 0)); }   \
        else { _Pragma("unroll") for (int k = 0; k < 2; ++k) acc[ai][bj][m][n] = __builtin_amdgcn_mfma_f32_16x16x32_bf16(Bt[n][k], At[m][k], acc[ai][bj][m][n], 0, 0, 0); } } __builtin_amdgcn_s_setprio(0); } while (0)
#define PG8_WAIT_V(n) asm volatile("s_waitcnt vmcnt(" #n ")" ::: "memory")
#define PG8_WAIT_L(n) asm volatile("s_waitcnt lgkmcnt(" #n ")" ::: "memory")
#define PG8_BAR __builtin_amdgcn_s_barrier()
#define PG8_SCHED __builtin_amdgcn_sched_barrier(0)
    Unit cur, nxt; int ui = 0;
    if (!S.next(0, cur)) return;
    f32x4 acc[2][2][4][2];
#pragma unroll
    for (int a = 0; a < 2; ++a)
#pragma unroll
        for (int b = 0; b < 2; ++b)
#pragma unroll
            for (int m = 0; m < 4; ++m)
#pragma unroll
                for (int n = 0; n < 2; ++n) acc[a][b][m][n] = (f32x4){0.f, 0.f, 0.f, 0.f};
    bf16x8 At[4][2], B0[2][2], B1[2][2];
    const char* cA; const char* cB; int nt;
    S.operands(cur, cA, cB, nt);
    unsigned vgc[2][2] = {{0u, 0u}, {0u, 0u}}, vgn[2][2] = {{0u, 0u}, {0u, 0u}};
    LAS unsigned* gbuf = (LAS unsigned*)(lds + 131072 + 10240);
    if constexpr (GATHER) { S.gather_issue(cur, gbuf, wid, lane); asm volatile("s_waitcnt vmcnt(0)" ::: "memory"); __builtin_amdgcn_s_barrier(); asm volatile("" ::: "memory"); S.gather_read(cur, RR, CC, vgc, gbuf); }
    LAS unsigned* abuf = (LAS unsigned*)(lds + 131072 + 12288);
    if constexpr (Epi::COLAUX) E.caux_issue(cur, abuf, wid, lane);
    if constexpr (Epi::ROWAUX) E.aux_issue(cur, gbuf, wid, lane);
    PG8_STAGE_B(PG8_SB(0, 0), cB); PG8_STAGE_B(PG8_SB(0, 1), cB + hstepB); PG8_STAGE_A(PG8_SA(0, 0), cA, 0, vgc); PG8_STAGE_A(PG8_SA(0, 1), cA, 1, vgc);
    if (wr == 1) PG8_BAR;
    PG8_WAIT_V(2); PG8_BAR;
    PG8_STAGE_B(PG8_SB(1, 0), cB + kstep); PG8_STAGE_A(PG8_SA(1, 0), cA + kstep, 0, vgc); PG8_STAGE_B(PG8_SB(1, 1), cB + hstepB + kstep);
    PG8_WAIT_V(6); PG8_BAR;
    for (;;) {
        const bool has_next = S.next(ui + 1, nxt);
        const char* nA = cA; const char* nB = cB; int nnt = nt;
        if (has_next) { S.operands(nxt, nA, nB, nnt); if constexpr (GATHER) S.gather_issue(nxt, gbuf + 256 * ((ui + 1) & 1), wid, lane); }
        else { if constexpr (GATHER) { vgn[0][0] = vgc[0][0]; vgn[0][1] = vgc[0][1]; vgn[1][0] = vgc[1][0]; vgn[1][1] = vgc[1][1]; } }
        for (int t = 0; t < nt; t += 2) {
            const bool last = (t == nt - 2);
            const char* a1 = cA + (size_t)(t + 1) * kstep;
            const char* a2 = last ? nA : cA + (size_t)(t + 2) * kstep; const char* b2 = last ? nB : cB + (size_t)(t + 2) * kstep;
            const char* a3 = a2 + kstep; const char* b3 = b2 + kstep;
            unsigned v2[2][2];
            if constexpr (GATHER) { if (last && has_next) S.gather_read(nxt, RR, CC, vgn, gbuf + 256 * ((ui + 1) & 1)); }
            if constexpr (GATHER) { v2[0][0] = last ? vgn[0][0] : vgc[0][0]; v2[0][1] = last ? vgn[0][1] : vgc[0][1]; v2[1][0] = last ? vgn[1][0] : vgc[1][0]; v2[1][1] = last ? vgn[1][1] : vgc[1][1]; }
            else { v2[0][0] = v2[0][1] = v2[1][0] = v2[1][1] = 0u; }
            PG8_LDB(B0, 0, 0); PG8_LDB(B1, 0, 1); PG8_SCHED; PG8_LDA(At, 0, 0); PG8_STAGE_A(PG8_SA(1, 1), a1, 1, vgc);
            PG8_WAIT_V(8); PG8_WAIT_L(0); PG8_BAR; PG8_MMA(0, 0, At, B0); PG8_MMA(0, 1, At, B1); PG8_BAR; PG8_SCHED;
            PG8_LDA(At, 0, 1); PG8_STAGE_B(PG8_SB(0, 0), b2); PG8_STAGE_B(PG8_SB(0, 1), b2 + hstepB); PG8_STAGE_A(PG8_SA(0, 0), a2, 0, v2);
            PG8_WAIT_V(8); PG8_WAIT_L(0); PG8_BAR; PG8_MMA(1, 0, At, B0); PG8_MMA(1, 1, At, B1); PG8_BAR; PG8_SCHED;
            PG8_LDB(B0, 1, 0); PG8_LDB(B1, 1, 1); PG8_SCHED; PG8_LDA(At, 1, 0); PG8_STAGE_A(PG8_SA(0, 1), a2, 1, v2);
            PG8_WAIT_V(8); PG8_WAIT_L(0); PG8_BAR; PG8_MMA(0, 0, At, B0); PG8_MMA(0, 1, At, B1); PG8_BAR; PG8_SCHED;
            PG8_LDA(At, 1, 1); PG8_STAGE_B(PG8_SB(1, 0), b3); PG8_STAGE_B(PG8_SB(1, 1), b3 + hstepB); PG8_STAGE_A(PG8_SA(1, 0), a3, 0, v2);
            PG8_WAIT_V(8); PG8_WAIT_L(0); PG8_BAR; PG8_MMA(1, 0, At, B0); PG8_MMA(1, 1, At, B1); PG8_BAR; PG8_SCHED;
        }
        if (wr == 0) PG8_BAR;
        if constexpr (Epi::F8) asm volatile("s_nop 15\n\ts_nop 7" ::: "memory");
        if constexpr (Epi::ROWAUX) E.aux_buf(gbuf + 256 * (ui & 1));
        if constexpr (Epi::COLAUX) E.caux_buf(abuf + 256 * (ui & 1));
        E(acc, cur, wr, wc, fr, fq);
#ifdef GEMM_DUP_EPI
        if constexpr (!Epi::NODUP && ((GEMM_DUP_EPI) & Epi::DUPBIT) != 0) { asm volatile("" ::: "memory"); E(acc, cur, wr, wc, fr, fq); }
#endif
        if (!has_next) break;
        if (!E.keep(cur)) {
#pragma unroll
        for (int a = 0; a < 2; ++a)
#pragma unroll
            for (int b = 0; b < 2; ++b)
#pragma unroll
                for (int m = 0; m < 4; ++m)
#pragma unroll
                    for (int n = 0; n < 2; ++n) acc[a][b][m][n] = (f32x4){0.f, 0.f, 0.f, 0.f}; }
        cur = nxt; cA = nA; cB = nB; nt = nnt; ++ui;
        if constexpr (Epi::ROWAUX) E.aux_issue(cur, gbuf + 256 * (ui & 1), wid, lane);
        if constexpr (Epi::COLAUX) E.caux_issue(cur, abuf + 256 * (ui & 1), wid, lane);
        if constexpr (GATHER) { vgc[0][0] = vgn[0][0]; vgc[0][1] = vgn[0][1]; vgc[1][0] = vgn[1][0]; vgc[1][1] = vgn[1][1]; }
        if (wr == 1) PG8_BAR;
    }
    PG8_WAIT_V(0);
    PG8_BAR;
#undef PG8_SA
#undef PG8_SB
#undef PG8_STG
#undef PG8_STAGE_A
#undef PG8_STAGE_B
#undef PG8_LDA
#undef PG8_LDB
#undef PG8_MMA
#undef PG8_F8CAT
#undef PG8_WAIT_V
#undef PG8_WAIT_L
#undef PG8_BAR
#undef PG8_SCHED
}
}

#define RLX_AGENT __ATOMIC_RELAXED, __HIP_MEMORY_SCOPE_AGENT
#define LDS_WAIT() asm volatile("s_waitcnt lgkmcnt(0)" ::: "memory")
#define VM_WAIT() asm volatile("s_waitcnt vmcnt(0)" ::: "memory")
__device__ __forceinline__ float bf2f(unsigned b) { return __uint_as_float(b << 16); }
__device__ __forceinline__ unsigned f2bf(float f) { unsigned u = __float_as_uint(f); return (u + 0x7fffu + ((u >> 16) & 1u)) >> 16; }
__device__ __forceinline__ unsigned pk2(float lo, float hi) { return pg8::cvt_pk_bf16(lo, hi); }
__device__ __forceinline__ float f8clamp(float x) { return fminf(fmaxf(x, -448.0f), 448.0f); }
__device__ __forceinline__ unsigned pk4_u8(float a, float b, float c, float d) { int r = __builtin_amdgcn_cvt_pk_u8_f32(__builtin_rintf(a), 0, 0); r = __builtin_amdgcn_cvt_pk_u8_f32(__builtin_rintf(b), 1, r); r = __builtin_amdgcn_cvt_pk_u8_f32(__builtin_rintf(c), 2, r); r = __builtin_amdgcn_cvt_pk_u8_f32(__builtin_rintf(d), 3, r); return (unsigned)r; }
__device__ __forceinline__ unsigned char f8_byte(float x) { return (unsigned char)(__builtin_amdgcn_cvt_pk_fp8_f32(f8clamp(x), 0.0f, 0, false) & 0xff); }
__device__ __forceinline__ unsigned pk4_f8_nc(float a, float b, float c, float d) { int r = __builtin_amdgcn_cvt_pk_fp8_f32(a, b, 0, false); r = __builtin_amdgcn_cvt_pk_fp8_f32(c, d, r, true); return (unsigned)r; }
__device__ __forceinline__ unsigned pk4_f8(float a, float b, float c, float d) { int r = __builtin_amdgcn_cvt_pk_fp8_f32(f8clamp(a), f8clamp(b), 0, false); r = __builtin_amdgcn_cvt_pk_fp8_f32(f8clamp(c), f8clamp(d), r, true); return (unsigned)r; }
__device__ __forceinline__ float fexp2(float x) { return __builtin_amdgcn_exp2f(x); }
__device__ __forceinline__ float flog2(float x) { return __builtin_amdgcn_logf(x); }
__device__ __forceinline__ float frcp(float x) { return __builtin_amdgcn_rcpf(x); }
__device__ __forceinline__ float fsigmoid(float x) { return frcp(1.0f + fexp2(-LOG2E * x)); }
__device__ __forceinline__ float shx(int lane, float v, int mask) { return __int_as_float(__builtin_amdgcn_ds_bpermute((lane ^ mask) << 2, __float_as_int(v))); }
__device__ __forceinline__ float shup(int lane, float v, int o) { return __int_as_float(__builtin_amdgcn_ds_bpermute((lane >= o ? lane - o : lane) << 2, __float_as_int(v))); }
__device__ __forceinline__ float shidx(float v, int src) { return __int_as_float(__builtin_amdgcn_ds_bpermute(src << 2, __float_as_int(v))); }
#define WV_DPP(x, ctrl) __int_as_float(__builtin_amdgcn_update_dpp(0, __float_as_int(x), (ctrl), 0xf, 0xf, true))
__device__ __forceinline__ float wave_sum(int lane, float v) {
    (void)lane;
    v += WV_DPP(v, 0xb1); v += WV_DPP(v, 0x4e); v += WV_DPP(v, 0x141); v += WV_DPP(v, 0x140);
    { const auto r = __builtin_amdgcn_permlane16_swap(__float_as_uint(v), __float_as_uint(v), false, false); v = __uint_as_float(r[0]) + __uint_as_float(r[1]); }
    { const auto r = __builtin_amdgcn_permlane32_swap(__float_as_uint(v), __float_as_uint(v), false, false); v = __uint_as_float(r[0]) + __uint_as_float(r[1]); }
    return v;
}
__device__ __forceinline__ float wave_max(int lane, float v) {
    (void)lane;
    v = fmaxf(v, WV_DPP(v, 0xb1)); v = fmaxf(v, WV_DPP(v, 0x4e)); v = fmaxf(v, WV_DPP(v, 0x141)); v = fmaxf(v, WV_DPP(v, 0x140));
    { const auto r = __builtin_amdgcn_permlane16_swap(__float_as_uint(v), __float_as_uint(v), false, false); v = fmaxf(__uint_as_float(r[0]), __uint_as_float(r[1])); }
    { const auto r = __builtin_amdgcn_permlane32_swap(__float_as_uint(v), __float_as_uint(v), false, false); v = fmaxf(__uint_as_float(r[0]), __uint_as_float(r[1])); }
    return v;
}
__device__ __forceinline__ unsigned pk4_i8(float a, float b, float c, float d) {
    const int qa = (int)__builtin_rintf(a), qb = (int)__builtin_rintf(b), qc = (int)__builtin_rintf(c), qd = (int)__builtin_rintf(d);
    return ((unsigned)qa & 255u) | (((unsigned)qb & 255u) << 8) | (((unsigned)qc & 255u) << 16) | ((unsigned)qd << 24); }

#define XB_TMO      128
#define XB_XCNT(j)  (256  + 64 * (j))
#define XB_XSUB(j)  (1280 + 64 * (j))
#define XB_XGEN(j)  (2304 + 64 * (j))
#define XB_TOP      3328
#define XB_TOPGEN   3392
#define XCD_BAR_WORDS 3456
#if CHK
#define XB_SPIN_CAP (1u << 21)
#else
#define XB_SPIN_CAP (1u << 18)
#endif
__device__ __forceinline__ unsigned xb_ld(unsigned* p)              { return __hip_atomic_load(p, __ATOMIC_RELAXED, __HIP_MEMORY_SCOPE_AGENT); }
__device__ __forceinline__ unsigned xb_add(unsigned* p, unsigned v) { return __hip_atomic_fetch_add(p, v, __ATOMIC_RELAXED, __HIP_MEMORY_SCOPE_AGENT); }
__device__ __forceinline__ unsigned xb_xcc_id() { return (unsigned)__builtin_amdgcn_s_getreg((3 << 11) | 20) & 0xFu; }
#define XB_SPIN(cond, bar) do { unsigned _sp = 0; while (cond) { __builtin_amdgcn_s_sleep(1); \
    if ((++_sp & 255u) == 0u) { if (xb_ld(&(bar)[XB_TMO])) break; if (_sp > XB_SPIN_CAP) { atomicAdd(&(bar)[XB_TMO], 1u); break; } } } } while (0)
struct XcdBarrier { unsigned* bar; unsigned x; volatile LAS unsigned* st; };
__device__ __forceinline__ XcdBarrier xcd_barrier_post(unsigned* bar, volatile LAS unsigned* st) {
    XcdBarrier b; b.bar = bar; b.x = xb_xcc_id(); b.st = st;
    if (threadIdx.x == 0) (void)xb_add(&bar[XB_XCNT(b.x)], 1u);
    return b;
}
__device__ __forceinline__ void xcd_barrier_complete(unsigned* bar, unsigned x, unsigned& nloc, unsigned& nx) {
    const unsigned G = gridDim.x * gridDim.y * gridDim.z;
    unsigned sum, cnt, mine, sp = 0u;
    for (;;) {
        sum = 0u; cnt = 0u; mine = 0u;
#pragma unroll
        for (unsigned j = 0; j < 16; ++j) { const unsigned c = xb_ld(&bar[XB_XCNT(j)]); sum += c; cnt += (c > 0u) ? 1u : 0u; mine = (j == x) ? c : mine; }
        if (sum == G) break;
        __builtin_amdgcn_s_sleep(1);
        if ((++sp & 255u) == 0u) { if (xb_ld(&bar[XB_TMO])) break; if (sp > XB_SPIN_CAP) { atomicAdd(&bar[XB_TMO], 1u); break; } }
    }
    nloc = mine > 0u ? mine : 1u; nx = cnt > 0u ? cnt : 1u;
}
__device__ __forceinline__ void xcd_barrier(const XcdBarrier& b) {
    asm volatile("s_waitcnt vmcnt(0)" ::: "memory");
    __syncthreads();
    if (threadIdx.x == 0) {
        unsigned* bar = b.bar;
        __builtin_amdgcn_s_waitcnt(0);
        unsigned nloc = b.st[0], nx = b.st[1];
        if (nloc == 0u) { xcd_barrier_complete(bar, b.x, nloc, nx); b.st[0] = nloc; b.st[1] = nx; }
        const unsigned old = xb_add(&bar[XB_XSUB(b.x)], 1u);
        const unsigned gen = old / nloc;
        if (old + 1u == (gen + 1u) * nloc) {
            __builtin_amdgcn_fence(__ATOMIC_RELEASE, "agent");
            asm volatile("s_waitcnt vmcnt(0)" ::: "memory");
            const unsigned og = xb_add(&bar[XB_TOP], 1u);
            const unsigned tg = og / nx;
            if (og + 1u == (tg + 1u) * nx) xb_add(&bar[XB_TOPGEN], 1u);
            else XB_SPIN(xb_ld(&bar[XB_TOPGEN]) == tg, bar);
            __builtin_amdgcn_fence(__ATOMIC_ACQUIRE, "agent");
            xb_add(&bar[XB_XGEN(b.x)], 1u);
            asm volatile("s_waitcnt vmcnt(0)" ::: "memory");
        } else {
            XB_SPIN(xb_ld(&bar[XB_XGEN(b.x)]) == gen, bar);
            __builtin_amdgcn_fence(__ATOMIC_ACQUIRE, "agent");
            asm volatile("s_waitcnt vmcnt(0)" ::: "memory");
        }
    }
    __syncthreads();
}

struct Args { const float* in[29]; float* out; unsigned char* ws; };
typedef const __attribute__((address_space(4))) Args* ArgsP;
struct AR { ArgsP p;
    __device__ __forceinline__ const float* in(int i) const { return p->in[i]; }
    __device__ __forceinline__ float* out() const { return p->out; }
    __device__ __forceinline__ unsigned char* ws() const { return p->ws; } };
enum { I_X = 0, I_C, I_WADA, I_BADA, I_LN1G, I_LN1B, I_WIN, I_BF, I_CONVW, I_CONVB, I_WA, I_BA, I_WX, I_BX, I_LAM, I_WGATE, I_BGATE, I_WPA, I_WPB, I_WPC, I_WO,
       I_LN2G, I_LN2B, I_WR, I_BR, I_WGU, I_BGU, I_WDN, I_BDN };

struct P0Item { const float* src; bf16_t* dst; int ldw; int ldt; float qs; };
constexpr int IT_IN = 16 * 80, IT_G = 16 * 48, IT_PA = 8 * 16, IT_PB = 8 * 16, IT_PC = 16 * 16, IT_O = 16 * 16, IT_GU = 32 * 16 * 32, IT_DN = 32 * 16 * 16;
constexpr int IT_LAYER = IT_IN + IT_G + IT_PA + IT_PB + IT_PC + IT_O + IT_GU + IT_DN;
__device__ __forceinline__ P0Item p0_decode(const AR a, int it) {
    const int l = it / IT_LAYER; int r = it % IT_LAYER; P0Item d; d.qs = 0.f;
    unsigned char* wl = a.ws() + WS_W + (size_t)l * WL_SIZE;
    if (r < IT_IN) { const int kb = FP8_IN ? (r / 160) * 2 : r / 80, n0 = FP8_IN ? 32 * (r % 160) : 64 * (r % 80); d.ldw = DIN; d.ldt = 1024; d.src = a.in(I_WIN) + (size_t)l * D * DIN + (size_t)(64 * kb) * DIN + (n0 < 1536 ? n0 : n0 + 8);
        if (FP8_IN) { d.qs = (FP8_IN == 2) ? -127.0f / fmaxf(__uint_as_float(__hip_atomic_load((gu32*)(a.ws() + WS_CTL) + CW_WMAX + (2 * l) * 64, RLX_AGENT)), 1e-30f) : Q_WIN; d.dst = (bf16_t*)(wl + WL_IN + (size_t)n0 * 1024 + 64 * kb); } else d.dst = (bf16_t*)(wl + WL_IN) + (size_t)n0 * 1024 + 64 * kb; return d; } r -= IT_IN;
    if (r < IT_G) { const int kb = FP8_IN ? (r / 96) * 2 : r / 48, n0 = FP8_IN ? 32 * (r % 96) : 64 * (r % 48); d.ldw = 3072; d.ldt = 1024; d.src = a.in(I_WGATE) + (size_t)l * D * 3072 + (size_t)(64 * kb) * 3072 + n0;
        if (FP8_IN) { d.qs = (FP8_IN == 2) ? -127.0f / fmaxf(__uint_as_float(__hip_atomic_load((gu32*)(a.ws() + WS_CTL) + CW_WMAX + (2 * l + 1) * 64, RLX_AGENT)), 1e-30f) : Q_WIN; d.dst = (bf16_t*)(wl + WL_IN + (size_t)(5120 + n0) * 1024 + 64 * kb); } else d.dst = (bf16_t*)(wl + WL_IN) + (size_t)(5120 + n0) * 1024 + 64 * kb; return d; } r -= IT_G;
    if (r < IT_PA) { const int kb = FP8_MRG ? (r / 32) * 2 : r / 16, n0 = FP8_MRG ? 32 * (r % 32) : 64 * (r % 16); d.ldw = D; d.ldt = 2048; d.src = a.in(I_WPA) + (size_t)l * 512 * D + (size_t)(64 * kb) * D + n0;
        if (FP8_MRG) { d.qs = Q_WP; d.dst = (bf16_t*)(wl + WL_P + (size_t)n0 * 2048 + 64 * kb); } else d.dst = (bf16_t*)(wl + WL_P) + (size_t)n0 * 2048 + 64 * kb; return d; } r -= IT_PA;
    if (r < IT_PB) { const int kb = FP8_MRG ? (r / 32) * 2 : r / 16, n0 = FP8_MRG ? 32 * (r % 32) : 64 * (r % 16); d.ldw = D; d.ldt = 2048; d.src = a.in(I_WPB) + (size_t)l * 512 * D + (size_t)(64 * kb) * D + n0;
        if (FP8_MRG) { d.qs = Q_WP; d.dst = (bf16_t*)(wl + WL_P + (size_t)n0 * 2048 + 512 + 64 * kb); } else d.dst = (bf16_t*)(wl + WL_P) + (size_t)n0 * 2048 + 512 + 64 * kb; return d; } r -= IT_PB;
    if (r < IT_PC) { const int kb = FP8_MRG ? (r / 32) * 2 : r / 16, n0 = FP8_MRG ? 32 * (r % 32) : 64 * (r % 16); d.ldw = D; d.ldt = 2048; d.src = a.in(I_WPC) + (size_t)l * D * D + (size_t)(64 * kb) * D + n0;
        if (FP8_MRG) { d.qs = Q_WP; d.dst = (bf16_t*)(wl + WL_P + (size_t)n0 * 2048 + 1024 + 64 * kb); } else d.dst = (bf16_t*)(wl + WL_P) + (size_t)n0 * 2048 + 1024 + 64 * kb; return d; } r -= IT_PC;
    if (r < IT_O) { const int kb = r / 16, n0 = 64 * (r % 16); d.ldw = D; d.ldt = 1024; d.src = a.in(I_WO) + (size_t)l * D * D + (size_t)(64 * kb) * D + n0; d.dst = (bf16_t*)(wl + WL_O) + (size_t)n0 * 1024 + 64 * kb; return d; } r -= IT_O;
    if (r < IT_GU) { const int e = r / 512, q = r % 512, kb = FP8_MOE ? (q / 64) * 2 : q / 32, n0 = FP8_MOE ? 32 * (q % 64) : 64 * (q % 32);
        const int sc = 1024 * ((n0 >> 7) & 1) + 128 * (n0 >> 8) + (n0 & 127);
        d.ldw = 2048; d.ldt = 1024; d.src = a.in(I_WGU) + ((size_t)l * NEXP + e) * D * 2048 + (size_t)(64 * kb) * 2048 + sc; if (FP8_MOE) { d.qs = Q_WGU; d.dst = (bf16_t*)(wl + WL_GU + ((size_t)e * 2048 + n0) * 1024 + 64 * kb); } else d.dst = (bf16_t*)(wl + WL_GU) + ((size_t)e * 2048 + n0) * 1024 + 64 * kb; return d; } r -= IT_GU;
    { const int e = r / 256, q = r % 256, kb = FP8_MOE ? (q / 32) * 2 : q / 16, n0 = FP8_MOE ? 32 * (q % 32) : 64 * (q % 16);
      d.ldw = D; d.ldt = 1024; d.src = a.in(I_WDN) + ((size_t)l * NEXP + e) * D * D + (size_t)(64 * kb) * D + n0; if (FP8_MOE) { d.qs = Q_WDN; d.dst = (bf16_t*)(wl + WL_DN + ((size_t)e * 1024 + n0) * 1024 + 64 * kb); } else d.dst = (bf16_t*)(wl + WL_DN) + ((size_t)e * 1024 + n0) * 1024 + 64 * kb; return d; }
}
__device__ __forceinline__ void p0_load(const P0Item& d, f32x4 (&v)[16], int lane) {
    if (d.qs != 0.f) {
        const float* p = d.src + (size_t)(lane >> 3) * d.ldw + 4 * (lane & 7);
#pragma unroll
        for (int i = 0; i < 16; ++i) v[i] = __builtin_nontemporal_load((const f32x4*)(p + (size_t)(8 * i) * d.ldw)); }
    else {
    const float* p = d.src + (size_t)(lane >> 4) * d.ldw + 4 * (lane & 15);
#pragma unroll
    for (int i = 0; i < 16; ++i) v[i] = __builtin_nontemporal_load((const f32x4*)(p + (size_t)(4 * i) * d.ldw)); }
}
__device__ __forceinline__ void p0_store(const P0Item& d, const f32x4 (&v)[16], LAS float* T, int lane) {
    if (d.qs != 0.f) {
        const int r = lane >> 3, c8 = lane & 7;
#pragma unroll
        for (int i = 0; i < 16; ++i) { const int kk = 8 * i + r;
            T[(4 * c8 + 0) * 129 + kk] = v[i][0]; T[(4 * c8 + 1) * 129 + kk] = v[i][1]; T[(4 * c8 + 2) * 129 + kk] = v[i][2]; T[(4 * c8 + 3) * 129 + kk] = v[i][3]; }
        LDS_WAIT(); asm volatile("" ::: "memory");
        const float q = fabsf(d.qs); const bool i8 = d.qs < 0.f;
#pragma unroll
        for (int j = 0; j < 4; ++j) { const int n = r + 8 * j; const LAS float* s = T + n * 129 + 16 * c8; u32x4 o;
            if (FP8_IN == 2 && i8) { o.x = pk4_i8(s[0] * q, s[1] * q, s[2] * q, s[3] * q); o.y = pk4_i8(s[4] * q, s[5] * q, s[6] * q, s[7] * q); o.z = pk4_i8(s[8] * q, s[9] * q, s[10] * q, s[11] * q); o.w = pk4_i8(s[12] * q, s[13] * q, s[14] * q, s[15] * q); }
            else { o.x = pk4_f8(s[0] * q, s[1] * q, s[2] * q, s[3] * q); o.y = pk4_f8(s[4] * q, s[5] * q, s[6] * q, s[7] * q); o.z = pk4_f8(s[8] * q, s[9] * q, s[10] * q, s[11] * q); o.w = pk4_f8(s[12] * q, s[13] * q, s[14] * q, s[15] * q); }
            *(GAS u32x4*)((unsigned char*)d.dst + (size_t)n * d.ldt + 16 * c8) = o; }
        LDS_WAIT(); asm volatile("" ::: "memory");
        return; }
    const int r = lane >> 4, c4 = lane & 15;
#pragma unroll
    for (int i = 0; i < 16; ++i) { const int kk = 4 * i + r;
        T[(4 * c4 + 0) * 65 + kk] = v[i][0]; T[(4 * c4 + 1) * 65 + kk] = v[i][1]; T[(4 * c4 + 2) * 65 + kk] = v[i][2]; T[(4 * c4 + 3) * 65 + kk] = v[i][3]; }
    LDS_WAIT(); asm volatile("" ::: "memory");
    const int c = lane & 7;
#pragma unroll
    for (int j = 0; j < 8; ++j) { const int n = (lane >> 3) + 8 * j; const LAS float* s = T + n * 65 + 8 * c;
        u32x4 o; o.x = pk2(s[0], s[1]); o.y = pk2(s[2], s[3]); o.z = pk2(s[4], s[5]); o.w = pk2(s[6], s[7]);
        *(GAS u32x4*)(d.dst + (size_t)n * d.ldt + 8 * c) = o; }
    LDS_WAIT(); asm volatile("" ::: "memory");
}
constexpr int IT_Q = (FP8_IN == 2) ? (IT_IN + IT_G) : 0;
__device__ __forceinline__ int p0_item(int q, int part) { return part ? (q / IT_Q) * IT_LAYER + (q % IT_Q) : (q / (IT_LAYER - IT_Q)) * IT_LAYER + IT_Q + (q % (IT_LAYER - IT_Q)); }
__device__ __forceinline__ void p0_weights(const AR a, LAS unsigned char* lds, int gw, int NGW, int wave, int lane, int part) {
    LAS float* T = (LAS float*)(lds + wave * 16640);
    const int NQ = DEPTH * (part ? IT_Q : IT_LAYER - IT_Q);
    int q = gw; if (q >= NQ) return;
    P0Item cur = p0_decode(a, p0_item(q, part)); f32x4 v[16]; p0_load(cur, v, lane);
    for (;;) {
        const int nx = q + NGW; const bool more = nx < NQ;
        P0Item nxt = cur; f32x4 w[16];
        if (more) { nxt = p0_decode(a, p0_item(nx, part)); p0_load(nxt, w, lane); }
        p0_store(cur, v, T, lane);
        if (!more) break;
#pragma unroll
        for (int i = 0; i < 16; ++i) v[i] = w[i];
        cur = nxt; q = nx;
    }
}
__device__ __forceinline__ void p0_wabsmax(const AR a, int gt, int NT, int lane) {
#pragma unroll 1
    for (int t = 0; t < 2 * DEPTH; ++t) { const int l = t >> 1, which = t & 1;
        const f32x4* W = (const f32x4*)(which ? a.in(I_WGATE) + (size_t)l * D * 3072 : a.in(I_WIN) + (size_t)l * D * DIN); const int n4 = (which ? D * 3072 : D * DIN) / 4;
        float mx = 0.f;
#pragma unroll 4
        for (int i = gt; i < n4; i += NT) { const f32x4 v = W[i]; mx = fmaxf(fmaxf(mx, fmaxf(fabsf(v[0]), fabsf(v[1]))), fmaxf(fabsf(v[2]), fabsf(v[3]))); }
        mx = wave_max(lane, mx);
        if (lane == 0) __hip_atomic_fetch_max((gu32*)(a.ws() + WS_CTL) + CW_WMAX + t * 64, __float_as_uint(mx), RLX_AGENT); }
}
__device__ __forceinline__ void p0_ada(const AR a, LAS unsigned char* lds, int item, int tid, int wave, int lane) {
    LAS float* cond = (LAS float*)lds;
    LAS float* part = (LAS float*)(lds + 65536);
    const int l = item / 96, cg = item % 96, col = cg * 64 + lane;
    const float* c = a.in(I_C);
    for (int i = tid; i < 16 * 1024; i += 512) { const float v = c[i]; cond[i] = v * fsigmoid(v); }
    __syncthreads();
    float acc[16];
#pragma unroll
    for (int b = 0; b < 16; ++b) acc[b] = 0.f;
    const float* W = a.in(I_WADA) + (size_t)l * D * 6144;
    {
        const float* Wp = W + (size_t)(wave * 128) * 6144 + col; float wc[16], wn[16];
#pragma unroll
        for (int i = 0; i < 16; ++i) wc[i] = Wp[(size_t)i * 6144];
#pragma unroll 1
        for (int k0 = 0; k0 < 128; k0 += 16) {
            if (k0 + 16 < 128) {
#pragma unroll
                for (int i = 0; i < 16; ++i) wn[i] = Wp[(size_t)(k0 + 16 + i) * 6144]; }
#pragma unroll
            for (int i = 0; i < 16; ++i) { const int k = wave * 128 + k0 + i;
#pragma unroll
                for (int b = 0; b < 16; ++b) acc[b] += cond[b * 1024 + k] * wc[i]; }
#pragma unroll
            for (int i = 0; i < 16; ++i) wc[i] = wn[i];
        } }
#pragma unroll
    for (int b = 0; b < 16; ++b) part[(wave * 16 + b) * 64 + lane] = acc[b];
    __syncthreads();
    float* ada = (float*)(a.ws() + WS_ADA);
    for (int o = tid; o < 1024; o += 512) { const int b = o >> 6, ln = o & 63; float s = 0.f;
#pragma unroll
        for (int w = 0; w < 8; ++w) s += part[(w * 16 + b) * 64 + ln];
        ada[((size_t)l * 16 + b) * 6144 + cg * 64 + ln] = s + a.in(I_BADA)[(size_t)l * 6144 + cg * 64 + ln]; }
    __syncthreads();
}

__device__ __forceinline__ void stage_wf(const AR a, int l, LAS unsigned char* lds, int tid) {
    LAS float* Wf = (LAS float*)lds;
    const float* W = a.in(I_WIN) + (size_t)l * D * DIN + 1536;
    for (int i = tid; i < 8192; i += 512) { const int k = i >> 3, g = i & 7, L = (k & 255) >> 2, j = k >> 8, ii = k & 3;
        Wf[((((4 * j + ii) * 2 + (g >> 2)) * 64 + L) << 2) + (g & 3)] = W[(size_t)k * DIN + g]; }
}
__device__ __forceinline__ float log_sigmoidf(float x) { return fminf(x, 0.f) - 0.6931471806f * flog2(1.0f + fexp2(-LOG2E * fabsf(x))); }
__device__ __forceinline__ void stage_vec(const float* src, LAS float* dst, int tid) { if (tid < 256) *(LAS f32x4*)(dst + 4 * tid) = *(const f32x4*)(src + 4 * tid); }
__device__ __forceinline__ void stage_vec5(const float* s0, const float* s1, const float* s2, const float* s3, const float* s4, LAS float* dst, int tid) {
    if (tid < 256) { const f32x4 v0 = *(const f32x4*)(s0 + 4 * tid), v1 = *(const f32x4*)(s1 + 4 * tid), v2 = *(const f32x4*)(s2 + 4 * tid), v3 = *(const f32x4*)(s3 + 4 * tid), v4 = *(const f32x4*)(s4 + 4 * tid);
        *(LAS f32x4*)(dst + 4 * tid) = v0; *(LAS f32x4*)(dst + 1024 + 4 * tid) = v1; *(LAS f32x4*)(dst + 2048 + 4 * tid) = v2; *(LAS f32x4*)(dst + 3072 + 4 * tid) = v3; *(LAS f32x4*)(dst + 4096 + 4 * tid) = v4; } }
__device__ __forceinline__ void prep_row(const AR a, int m, const f32x4 (&x)[4], const LAS float* Wf, const LAS float* shL, const LAS float* scL, const LAS float* bfL, int lane) {
    bf16_t* H = (bf16_t*)(a.ws() + WS_H) + (size_t)m * D;
    float s[8];
#pragma unroll
    for (int j = 0; j < 8; ++j) s[j] = 0.f;
    float mx = 0.f;
#pragma unroll
    for (int j = 0; j < 4; ++j) {
        const int col = 4 * lane + 256 * j;
        const f32x4 sh = *(const LAS f32x4*)(shL + 256 * j), sc = *(const LAS f32x4*)(scL + 256 * j);
        const f32x4 h = x[j] * (sc + 1.0f) + sh;
        if (FP8_IN == 2) { mx = fmaxf(fmaxf(mx, fmaxf(fabsf(h[0]), fabsf(h[1]))), fmaxf(fabsf(h[2]), fabsf(h[3]))); }
        else if (FP8_IN == 1) *(unsigned*)((unsigned char*)(a.ws() + WS_H) + (size_t)m * D + col) = pk4_f8(h[0] * Q_H1, h[1] * Q_H1, h[2] * Q_H1, h[3] * Q_H1);
        else { u32x2 w; w.x = pk2(h[0], h[1]); w.y = pk2(h[2], h[3]); *(u32x2*)(H + col) = w; }
#pragma unroll
        for (int i = 0; i < 4; ++i) { const f32x4 w0 = *(const LAS f32x4*)(Wf + ((((4 * j + i) * 2) * 64 + lane) << 2)), w1 = *(const LAS f32x4*)(Wf + ((((4 * j + i) * 2 + 1) * 64 + lane) << 2));
            s[0] += h[i] * w0[0]; s[1] += h[i] * w0[1]; s[2] += h[i] * w0[2]; s[3] += h[i] * w0[3];
            s[4] += h[i] * w1[0]; s[5] += h[i] * w1[1]; s[6] += h[i] * w1[2]; s[7] += h[i] * w1[3]; }
    }
    if (FP8_IN == 2) {
        mx = fmaxf(wave_max(lane, mx), 1e-30f); const float inv = 127.0f / mx;
#pragma unroll
        for (int j = 0; j < 4; ++j) { const f32x4 sh = *(const LAS f32x4*)(shL + 256 * j), sc = *(const LAS f32x4*)(scL + 256 * j); const f32x4 h = x[j] * (sc + 1.0f) + sh;
            *(unsigned*)((unsigned char*)(a.ws() + WS_H) + (size_t)m * D + 4 * lane + 256 * j) = pk4_i8(h[0] * inv, h[1] * inv, h[2] * inv, h[3] * inv); }
        if (lane == 0) ((float*)(a.ws() + WS_ROWS))[m] = mx * (1.0f / 127.0f); }
#pragma unroll
    for (int j = 0; j < 8; ++j) s[j] = wave_sum(lane, s[j]);
    float mine = s[0];
#pragma unroll
    for (int j = 1; j < 8; ++j) mine = (lane == j) ? s[j] : mine;
    if (lane < 8) { float* logf = (float*)(a.ws() + WS_LOGF); logf[(size_t)m * 8 + lane] = log_sigmoidf(mine + bfL[lane]); }
}
__device__ __forceinline__ void ln_row(f32x4 (&v)[4], const LAS float* g, const LAS float* bb, int lane) {
    float s = 0.f;
#pragma unroll
    for (int j = 0; j < 4; ++j) s += (v[j][0] + v[j][1]) + (v[j][2] + v[j][3]);
    const float mean = wave_sum(lane, s) * (1.f / D); float s2 = 0.f;
#pragma unroll
    for (int j = 0; j < 4; ++j) { v[j] = v[j] - mean; s2 += (v[j][0] * v[j][0] + v[j][1] * v[j][1]) + (v[j][2] * v[j][2] + v[j][3] * v[j][3]); }
    const float rstd = 1.f / sqrtf(wave_sum(lane, s2) * (1.f / D) + LN_EPS);
#pragma unroll
    for (int j = 0; j < 4; ++j) { const f32x4 gg = *(const LAS f32x4*)(g + 256 * j), bv = *(const LAS f32x4*)(bb + 256 * j); v[j] = v[j] * rstd * gg + bv; }
}

struct DenseOrder {
    pg8::TileOrder T; const char* A; const char* B; int lda, ldb, nt;
    __device__ __forceinline__ bool next(int i, pg8::Unit& u) const { u.aux = 0; return T.tile(i, u.pm, u.pn); }
    __device__ __forceinline__ void operands(const pg8::Unit& u, const char*& a, const char*& b, int& n) const {
        a = A + (size_t)u.pm * 256 * lda * 2; b = B + (size_t)u.pn * 256 * ldb * 2; n = nt; }
};
struct MergeOrder {
    pg8::TileOrder T; const char* A; const char* B;
    __device__ __forceinline__ bool next(int i, pg8::Unit& u) const { u.aux = i % 3; return T.tile(i / 3, u.pm, u.pn); }
    __device__ __forceinline__ void operands(const pg8::Unit& u, const char*& a, const char*& b, int& n) const {
        const int k0 = (u.aux == 0) ? 0 : (u.aux == 1 ? 512 : 1024);
        constexpr size_t EB = FP8_MRG ? 1 : 2;
        a = A + ((size_t)u.pm * 256 * OP + k0) * EB; b = B + ((size_t)u.pn * 256 * OP + k0) * EB; n = ((u.aux == 2) ? 16 : 8) / (FP8_MRG ? 2 : 1); }
};
struct MoeTables { const LAS int* cnt; const LAS int* bs; const LAS unsigned char* be; };
__device__ __forceinline__ MoeTables moe_tables(LAS unsigned char* lds) {
    MoeTables t; t.cnt = (const LAS int*)(lds + MISC_OFF + MO_CNT); t.bs = (const LAS int*)(lds + MISC_OFF + MO_BS); t.be = (const LAS unsigned char*)(lds + MISC_OFF + MO_BE); return t; }
__device__ __forceinline__ void moe_build_tables(gu32* ctl, int l, LAS unsigned char* lds, int tid) {
    LAS int* cnt = (LAS int*)(lds + MISC_OFF + MO_CNT); LAS int* bs = (LAS int*)(lds + MISC_OFF + MO_BS); LAS unsigned char* be = (LAS unsigned char*)(lds + MISC_OFF + MO_BE);
    __syncthreads();
    if (tid < 32) cnt[tid] = (int)__hip_atomic_load(ctl + CW_GCNT + (l * 32 + tid) * 64, RLX_AGENT);
    __syncthreads();
    if (tid == 0) { int s = 0; for (int e = 0; e < 32; ++e) { bs[e] = s; int c = cnt[e]; if (c > ECAP) c = ECAP; s += (c + 255) >> 8; } if (s > MAXBLK) s = MAXBLK; bs[32] = s; }
    __syncthreads();
    { const int nb = bs[32]; for (int b = tid; b < nb; b += 512) { int e = 0;
#pragma unroll 1
          for (int q = 1; q < 32; ++q) if (bs[q] <= b) e = q;
          be[b] = (unsigned char)e; } }
    __syncthreads();
}
template <int NPN, bool G1> struct MoeOrder {
    int vcu; MoeTables t; const char* A; const char* B; const int* slot_tok;
    __device__ __forceinline__ bool next(int i, pg8::Unit& u) const {
        const int L = i * 256 + vcu, nb = t.bs[32]; if (L >= nb * NPN) return false;
        u.pm = L / NPN; u.pn = L % NPN; u.aux = t.be[u.pm]; return true; }
    __device__ __forceinline__ void operands(const pg8::Unit& u, const char*& a, const char*& b, int& n) const {
        constexpr size_t RB = FP8_MOE ? 1024 : 2048;
        if (G1) { a = A; b = B + ((size_t)u.aux * 2048 + (size_t)u.pn * 256) * RB; }
        else { a = A + (size_t)u.pm * 256 * RB; b = B + ((size_t)u.aux * 1024 + (size_t)u.pn * 256) * RB; }
        n = FP8_MOE ? 8 : 16; }
    __device__ __forceinline__ void gather_issue(const pg8::Unit& u, LAS unsigned* buf, int wid, int lane) const {
        const int e = u.aux, j = u.pm - t.bs[e];
        __builtin_amdgcn_global_load_lds((const unsigned*)(slot_tok + (size_t)e * ECAP + 256 * j + 64 * (wid & 3) + lane), buf + 64 * (wid & 3), 4, 0, 0);
    }
    __device__ __forceinline__ void gather_read(const pg8::Unit& u, const int (&R)[2], const int (&C)[2], unsigned (&vg)[2][2], const LAS unsigned* buf) const {
        const int e = u.aux, j = u.pm - t.bs[e], c = t.cnt[e];
#pragma unroll
        for (int h = 0; h < 2; ++h)
#pragma unroll
            for (int i = 0; i < 2; ++i) { const int r = 128 * h + R[i]; unsigned tok = buf[r]; if (256 * j + r >= c) tok = 0u;
                vg[h][i] = tok * (FP8_MOE ? 1024u : 2048u) + (unsigned)C[i] * 2u; }
    }
};

__device__ __forceinline__ u32x4 pack8(const f32x4& v0, const f32x4& v1) { u32x4 w; w.x = pk2(v0[0], v0[1]); w.y = pk2(v0[2], v0[3]); w.z = pk2(v1[0], v1[1]); w.w = pk2(v1[2], v1[3]); return w; }
__device__ __forceinline__ void unpack8(const u32x4& w, f32x4& v0, f32x4& v1) {
    v0[0] = __uint_as_float(w.x << 16); v0[1] = __uint_as_float(w.x & 0xffff0000u); v0[2] = __uint_as_float(w.y << 16); v0[3] = __uint_as_float(w.y & 0xffff0000u);
    v1[0] = __uint_as_float(w.z << 16); v1[1] = __uint_as_float(w.z & 0xffff0000u); v1[2] = __uint_as_float(w.w << 16); v1[3] = __uint_as_float(w.w & 0xffff0000u); }

__device__ __forceinline__ void unpack8_f8(const u32x2& w, f32x4& v0, f32x4& v1) {
    v0[0] = (float)(w.x & 255u); v0[1] = (float)((w.x >> 8) & 255u); v0[2] = (float)((w.x >> 16) & 255u); v0[3] = (float)(w.x >> 24);
    v1[0] = (float)(w.y & 255u); v1[1] = (float)((w.y >> 8) & 255u); v1[2] = (float)((w.y >> 16) & 255u); v1[3] = (float)(w.y >> 24); }
__device__ __forceinline__ void wide_store16(bf16_t* rowp  , size_t pitch8  , const u32x4& P0, const u32x4& P1) {
    u32x4 S1, S2;
#pragma unroll
    for (int d = 0; d < 4; ++d) { S1[d] = (unsigned)__builtin_amdgcn_update_dpp((int)P0[d], (int)P1[d], 0x128, 0xf, 0xc, false); S2[d] = (unsigned)__builtin_amdgcn_update_dpp((int)P1[d], (int)P0[d], 0x128, 0xf, 0x3, false); }
#ifdef NT_STORES
    __builtin_nontemporal_store(S1, (u32x4*)rowp); __builtin_nontemporal_store(S2, (u32x4*)(rowp + pitch8)); }
#else
    *(u32x4*)rowp = S1; *(u32x4*)(rowp + pitch8) = S2; }
#endif
struct EpiInProj {
    static constexpr bool PERM = true, NODUP = false, F8 = (FP8_IN == 1), I8 = (FP8_IN == 2), ROWAUX = I8, COLAUX = (COL_AUX != 0), WIDE = (WIDE_ST != 0); static constexpr int DUPBIT = 1;
    bf16_t* Z; const float* bgate; const float* rows; float sw_in, sw_gate; const LAS float* rbuf;
    __device__ __forceinline__ void aux_issue(const pg8::Unit& u, LAS unsigned* buf, int wid, int lane) const {
        __builtin_amdgcn_global_load_lds((const unsigned*)(rows + (size_t)u.pm * 256 + 64 * (wid & 3) + lane), buf + 64 * (wid & 3), 4, 0, 0); }
    __device__ __forceinline__ void aux_buf(const LAS unsigned* buf) { rbuf = (const LAS float*)buf; }
    const LAS float* cbuf = nullptr;
    unsigned char* G8 = nullptr;
    __device__ __forceinline__ void caux_issue(const pg8::Unit& u, LAS unsigned* buf, int wid, int lane) const {
        if (u.pn >= 20) __builtin_amdgcn_global_load_lds((const unsigned*)(bgate + (u.pn - 20) * 256 + 64 * (wid & 3) + lane), buf + 64 * (wid & 3), 4, 0, 0); }
    __device__ __forceinline__ void caux_buf(const LAS unsigned* buf) { cbuf = (const LAS float*)buf; }
#ifdef PROBE_SKIP_EPI
    int skip = 0;
#endif
    __device__ __forceinline__ bool keep(const pg8::Unit&) const { return false; }
    __device__ __forceinline__ void operator()(f32x4 (&acc)[2][2][4][2], const pg8::Unit& u, int wr, int wc, int fr, int fq) const {
#ifdef PROBE_SKIP_EPI
        if (skip == 1) return;
#endif
        const int row0 = u.pm * 256 + wr * 64 + fr, col0 = u.pn * 256 + (WIDE ? wc * 64 : wc * 32) + 8 * fq; constexpr int BJ = WIDE ? 32 : 128;
        const int mode = (u.pn >= 20) ? 2 : ((u.pn < 2 || (u.pn >= 6 && u.pn < 8)) ? 1 : 0);
        f32x4 bv[2][2];
#pragma unroll
        for (int bj = 0; bj < 2; ++bj)
#pragma unroll
            for (int n = 0; n < 2; ++n) bv[bj][n] = (mode == 2) ? (COLAUX ? *(const LAS f32x4*)(cbuf + (col0 - u.pn * 256) + bj * BJ + 4 * n) : *(const f32x4*)(bgate + (col0 - ZC_G) + bj * BJ + 4 * n)) : (f32x4){0.f, 0.f, 0.f, 0.f};
        const float sc = (mode == 1) ? C2 : 1.0f;
        constexpr float dq = F8 ? 1.0f / (Q_H1 * Q_WIN) : 1.0f;
        float rsc[2][4];
        if constexpr (I8) { const float sw = ((mode == 2) ? sw_gate : sw_in) * sc;
#pragma unroll
            for (int ai = 0; ai < 2; ++ai)
#pragma unroll
                for (int m = 0; m < 4; ++m) rsc[ai][m] = rbuf[wr * 64 + fr + ai * 128 + m * 16] * sw; }
#pragma unroll
        for (int ai = 0; ai < 2; ++ai)
#pragma unroll
            for (int m = 0; m < 4; ++m) { bf16_t* rowp = Z + (size_t)(row0 + ai * 128 + m * 16) * ZP + col0; u32x4 P[2]; u32x2 GQ[2] = {{0u, 0u}, {0u, 0u}};
#pragma unroll
                for (int bj = 0; bj < 2; ++bj) { f32x4 v0, v1;
                    if constexpr (I8) { f32x4 c0, c1;
#pragma unroll
                        for (int i = 0; i < 4; ++i) { c0[i] = (float)__float_as_int(acc[ai][bj][m][0][i]); c1[i] = (float)__float_as_int(acc[ai][bj][m][1][i]); }
                        v0 = c0 * rsc[ai][m] + bv[bj][0]; v1 = c1 * rsc[ai][m] + bv[bj][1]; }
                    else { v0 = acc[ai][bj][m][0] * (dq * sc) + bv[bj][0]; v1 = acc[ai][bj][m][1] * (dq * sc) + bv[bj][1]; }
                    if (mode == 2) { const f32x4 t0 = v0 * (-LOG2E), t1 = v1 * (-LOG2E); f32x4 e0, e1;
#pragma unroll
                        for (int i = 0; i < 4; ++i) { e0[i] = fexp2(t0[i]); e1[i] = fexp2(t1[i]); }
                        e0 = e0 + 1.0f; e1 = e1 + 1.0f;
#pragma unroll
                        for (int i = 0; i < 4; ++i) { v0[i] = frcp(e0[i]); v1[i] = frcp(e1[i]); } }
                    if (FP8_G && WIDE && mode == 2) { const f32x4 g0 = v0 * Q_G, g1 = v1 * Q_G; GQ[bj].x = pk4_u8(g0[0], g0[1], g0[2], g0[3]); GQ[bj].y = pk4_u8(g1[0], g1[1], g1[2], g1[3]); }
                    P[bj] = pack8(v0, v1);
                    if constexpr (!WIDE) *(u32x4*)(rowp + bj * 128) = P[bj]; }
#ifdef PROBE_SKIP_EPI
                if (skip == 2) { asm volatile("" :: "v"(P[0]), "v"(P[1])); } else
                if (skip == 3) { wide_store16((bf16_t*)((unsigned char*)Z + 641ull * 1048576ull) + (size_t)((wr * 64 + ai * 128 + m * 16 + (fr & 7)) & 63) * ZP + col0 + 32 * (fr >> 3), (size_t)8 * ZP, P[0], P[1]); } else
#endif
                if (FP8_G && WIDE && mode == 2) {
                    const auto r0 = __builtin_amdgcn_permlane16_swap(GQ[1].x, GQ[0].x, false, false), r1 = __builtin_amdgcn_permlane16_swap(GQ[1].y, GQ[0].y, false, false);
                    u32x4 w; w.x = r0[0]; w.y = r1[0]; w.z = r0[1]; w.w = r1[1];
                    *(u32x4*)(G8 + (size_t)(row0 + ai * 128 + m * 16) * 3072 + (u.pn - 20) * 256 + wc * 64 + ((fq & 1) ? 8 * (fq - 1) : 32 + 8 * fq)) = w; }
                else
                if constexpr (WIDE) wide_store16(Z + (size_t)(u.pm * 256 + wr * 64 + ai * 128 + m * 16 + (fr & 7)) * ZP + col0 + 32 * (fr >> 3), (size_t)8 * ZP, P[0], P[1]); }
    }
};
struct EpiMerge {
    static constexpr bool PERM = true, NODUP = true, F8 = (FP8_MRG != 0), I8 = false, ROWAUX = false, COLAUX = false, WIDE = false; static constexpr int DUPBIT = 0;
    const bf16_t* Z; bf16_t* MG; const bf16_t* ONES;
    __device__ __forceinline__ bool keep(const pg8::Unit& u) const { return u.aux != 2; }
    __device__ __forceinline__ void operator()(f32x4 (&acc)[2][2][4][2], const pg8::Unit& u, int wr, int wc, int fr, int fq) const {
        const int row0 = u.pm * 256 + wr * 64 + fr, col0 = u.pn * 256 + wc * 32 + 8 * fq, seg = u.aux;
        const bool fin = (seg == 2);
        const char* nb = (const char*)Z; const char* db = fin ? (const char*)ONES : (const char*)Z;
        constexpr unsigned GP = FP8_G ? 3072u : (unsigned)ZP * 2u, GB = FP8_G ? 1u : 2u;
        const unsigned on0 = (unsigned)row0 * GP + ((FP8_G ? 0 : ZC_G) + seg * 1024 + col0) * GB;
        const unsigned od0 = fin ? (unsigned)(8 * fq) * GB : (unsigned)row0 * GP + ((FP8_G ? 0 : ZC_G) + (seg + 1) * 1024 + col0) * GB;
        const unsigned dmul = fin ? 0u : 1u;
#pragma unroll
        for (int ai = 0; ai < 2; ++ai)
#pragma unroll
          for (int mh = 0; mh < 2; ++mh) {
            u32x4 gw[2][2], dw[2][2]; u32x2 g8[2][2], d8[2][2];
#pragma unroll
            for (int mm = 0; mm < 2; ++mm)
#pragma unroll
                for (int bj = 0; bj < 2; ++bj) { const unsigned ad = (unsigned)(ai * 128 + (2 * mh + mm) * 16) * GP + (unsigned)(bj * 128) * GB;
                    if (FP8_G) { g8[mm][bj] = *(const u32x2*)(nb + (size_t)(on0 + ad)); d8[mm][bj] = *(const u32x2*)(db + (size_t)(od0 + ad * dmul)); }
                    else { gw[mm][bj] = *(const u32x4*)(nb + (size_t)(on0 + ad)); dw[mm][bj] = *(const u32x4*)(db + (size_t)(od0 + ad * dmul)); } }
#pragma unroll
            for (int mm = 0; mm < 2; ++mm)
#pragma unroll
                for (int bj = 0; bj < 2; ++bj) { const int m = 2 * mh + mm; f32x4 n0, n1, d0, d1;
                    if (FP8_G) { unpack8_f8(g8[mm][bj], n0, n1); unpack8_f8(d8[mm][bj], d0, d1); } else { unpack8(gw[mm][bj], n0, n1); unpack8(dw[mm][bj], d0, d1); }
#pragma unroll
                    for (int i = 0; i < 4; ++i) { n0[i] = fmaxf(n0[i], 1e-18f) * frcp(fmaxf(d0[i], 1e-18f)); n1[i] = fmaxf(n1[i], 1e-18f) * frcp(fmaxf(d1[i], 1e-18f)); }
                    acc[ai][bj][m][0] = acc[ai][bj][m][0] * n0; acc[ai][bj][m][1] = acc[ai][bj][m][1] * n1; }
            asm volatile("" ::: "memory");
          }
        if (fin) {
#pragma unroll
            for (int ai = 0; ai < 2; ++ai)
#pragma unroll
                for (int m = 0; m < 4; ++m) { bf16_t* rowp = MG + (size_t)(row0 + ai * 128 + m * 16) * D + col0;
#pragma unroll
                    for (int bj = 0; bj < 2; ++bj) { constexpr float dq = F8 ? 1.0f / (Q_O * Q_WP) : 1.0f; *(u32x4*)(rowp + bj * 128) = pack8(acc[ai][bj][m][0] * dq, acc[ai][bj][m][1] * dq); } } }
    }
};
struct EpiBf16 {
    static constexpr bool PERM = true, NODUP = false, F8 = false, I8 = false, ROWAUX = false, COLAUX = false, WIDE = (WIDE_ST != 0); static constexpr int DUPBIT = 2;
    bf16_t* C; int ldc;
    __device__ __forceinline__ bool keep(const pg8::Unit&) const { return false; }
    __device__ __forceinline__ void operator()(f32x4 (&acc)[2][2][4][2], const pg8::Unit& u, int wr, int wc, int fr, int fq) const {
        const int row0 = u.pm * 256 + wr * 64 + fr, col0 = u.pn * 256 + (WIDE ? wc * 64 : wc * 32) + 8 * fq;
#pragma unroll
        for (int ai = 0; ai < 2; ++ai)
#pragma unroll
            for (int m = 0; m < 4; ++m) {
                if constexpr (WIDE) wide_store16(C + (size_t)(u.pm * 256 + wr * 64 + ai * 128 + m * 16 + (fr & 7)) * ldc + col0 + 32 * (fr >> 3), (size_t)8 * ldc, pack8(acc[ai][0][m][0], acc[ai][0][m][1]), pack8(acc[ai][1][m][0], acc[ai][1][m][1]));
                else { bf16_t* rowp = C + (size_t)(row0 + ai * 128 + m * 16) * ldc + col0;
#pragma unroll
                for (int bj = 0; bj < 2; ++bj) *(u32x4*)(rowp + bj * 128) = pack8(acc[ai][bj][m][0], acc[ai][bj][m][1]); } }
    }
};
struct EpiGU {
    static constexpr bool PERM = true, NODUP = false, F8 = (FP8_MOE != 0), I8 = false, ROWAUX = false, COLAUX = (COL_AUX != 0), WIDE = false; static constexpr int DUPBIT = 4;
    unsigned char* ACT; const float* bgu;
    const LAS float* cbuf = nullptr;
    __device__ __forceinline__ void caux_issue(const pg8::Unit& u, LAS unsigned* buf, int wid, int lane) const {
        const int w = wid & 3; __builtin_amdgcn_global_load_lds((const unsigned*)(bgu + (size_t)u.aux * 2048 + (w >> 1) * 1024 + u.pn * 128 + (w & 1) * 64 + lane), buf + 64 * w, 4, 0, 0); }
    __device__ __forceinline__ void caux_buf(const LAS unsigned* buf) { cbuf = (const LAS float*)buf; }
    __device__ __forceinline__ bool keep(const pg8::Unit&) const { return false; }
    __device__ __forceinline__ void operator()(f32x4 (&acc)[2][2][4][2], const pg8::Unit& u, int wr, int wc, int fr, int fq) const {
        const int row0 = u.pm * 256 + wr * 64 + fr, cc = u.pn * 128 + wc * 32 + 8 * fq;
        const float* bg = bgu + (size_t)u.aux * 2048 + cc;
        f32x4 bg0, bg1, bu0, bu1;
        if constexpr (COLAUX) { const LAS float* cb = cbuf + wc * 32 + 8 * fq; bg0 = *(const LAS f32x4*)cb; bg1 = *(const LAS f32x4*)(cb + 4); bu0 = *(const LAS f32x4*)(cb + 128); bu1 = *(const LAS f32x4*)(cb + 132); }
        else { bg0 = *(const f32x4*)bg; bg1 = *(const f32x4*)(bg + 4); bu0 = *(const f32x4*)(bg + 1024); bu1 = *(const f32x4*)(bg + 1028); }
        float dq = F8 ? 1.0f / (Q_H2 * Q_WGU) : 1.0f; asm volatile("" : "+s"(dq));
#pragma unroll
        for (int ai = 0; ai < 2; ++ai)
#pragma unroll
            for (int m = 0; m < 4; ++m) {
                f32x4 o0, o1;
                { const f32x4 g = acc[ai][0][m][0] * dq + bg0, uu = acc[ai][1][m][0] * dq + bu0; f32x4 ga, up, e;
#pragma unroll
                  for (int i = 0; i < 4; ++i) { ga[i] = fminf(g[i], 7.0f); up[i] = fminf(fmaxf(uu[i], -7.0f), 7.0f); }
                  const f32x4 t = ga * (-1.702f * LOG2E);
#pragma unroll
                  for (int i = 0; i < 4; ++i) e[i] = fexp2(t[i]);
                  const f32x4 dn = e + 1.0f; f32x4 r;
#pragma unroll
                  for (int i = 0; i < 4; ++i) r[i] = frcp(dn[i]);
                  o0 = (up + 1.0f) * (ga * r); }
                { const f32x4 g = acc[ai][0][m][1] * dq + bg1, uu = acc[ai][1][m][1] * dq + bu1; f32x4 ga, up, e;
#pragma unroll
                  for (int i = 0; i < 4; ++i) { ga[i] = fminf(g[i], 7.0f); up[i] = fminf(fmaxf(uu[i], -7.0f), 7.0f); }
                  const f32x4 t = ga * (-1.702f * LOG2E);
#pragma unroll
                  for (int i = 0; i < 4; ++i) e[i] = fexp2(t[i]);
                  const f32x4 dn = e + 1.0f; f32x4 r;
#pragma unroll
                  for (int i = 0; i < 4; ++i) r[i] = frcp(dn[i]);
                  o1 = (up + 1.0f) * (ga * r); }
                if constexpr (F8) { const f32x4 q0 = o0 * Q_ACT, q1 = o1 * Q_ACT; u32x2 w; w.x = pk4_f8_nc(q0[0], q0[1], q0[2], q0[3]); w.y = pk4_f8_nc(q1[0], q1[1], q1[2], q1[3]);
                    *(u32x2*)(ACT + (size_t)(row0 + ai * 128 + m * 16) * D + cc) = w; }
                else *(u32x4*)((bf16_t*)ACT + (size_t)(row0 + ai * 128 + m * 16) * D + cc) = pack8(o0, o1); }
    }
};
struct EpiDown {
    static constexpr bool PERM = true, NODUP = false, F8 = (FP8_MOE != 0), I8 = false, ROWAUX = false, COLAUX = (COL_AUX != 0), WIDE = (WIDE_ST != 0 && FP8_YB != 0); static constexpr int DUPBIT = 8;
    unsigned char* YB; const float* bdn;
    const LAS float* cbuf = nullptr;
    __device__ __forceinline__ void caux_issue(const pg8::Unit& u, LAS unsigned* buf, int wid, int lane) const {
        __builtin_amdgcn_global_load_lds((const unsigned*)(bdn + (size_t)u.aux * D + u.pn * 256 + 64 * (wid & 3) + lane), buf + 64 * (wid & 3), 4, 0, 0); }
    __device__ __forceinline__ void caux_buf(const LAS unsigned* buf) { cbuf = (const LAS float*)buf; }
    __device__ __forceinline__ bool keep(const pg8::Unit&) const { return false; }
    __device__ __forceinline__ void operator()(f32x4 (&acc)[2][2][4][2], const pg8::Unit& u, int wr, int wc, int fr, int fq) const {
        const int row0 = u.pm * 256 + wr * 64 + fr, col0 = u.pn * 256 + (WIDE ? wc * 64 : wc * 32) + 8 * fq; constexpr int BJ = WIDE ? 32 : 128;
        const float* bp = bdn + (size_t)u.aux * D + col0;
        f32x4 bv[2][2];
        constexpr float dq = (F8 ? 1.0f / (Q_ACT * Q_WDN) : 1.0f) * (FP8_YB ? Q_YB : 1.0f);
#pragma unroll
        for (int bj = 0; bj < 2; ++bj)
#pragma unroll
            for (int n = 0; n < 2; ++n) bv[bj][n] = (COLAUX ? *(const LAS f32x4*)(cbuf + (col0 - u.pn * 256) + bj * BJ + 4 * n) : *(const f32x4*)(bp + bj * BJ + 4 * n)) * (FP8_YB ? Q_YB : 1.0f);
#pragma unroll
        for (int ai = 0; ai < 2; ++ai)
#pragma unroll
            for (int m = 0; m < 4; ++m) {
                if constexpr (FP8_YB != 0) { unsigned char* rowp = YB + (size_t)(row0 + ai * 128 + m * 16) * D + col0; u32x2 Q[2];
#pragma unroll
                    for (int bj = 0; bj < 2; ++bj) { const f32x4 v0 = acc[ai][bj][m][0] * dq + bv[bj][0], v1 = acc[ai][bj][m][1] * dq + bv[bj][1];
                        Q[bj].x = pk4_f8(v0[0], v0[1], v0[2], v0[3]); Q[bj].y = pk4_f8(v1[0], v1[1], v1[2], v1[3]); if constexpr (!WIDE) *(u32x2*)(rowp + bj * 128) = Q[bj]; }
                    if constexpr (WIDE) {
                        const auto r0 = __builtin_amdgcn_permlane16_swap(Q[1].x, Q[0].x, false, false), r1 = __builtin_amdgcn_permlane16_swap(Q[1].y, Q[0].y, false, false);
                        u32x4 w; w.x = r0[0]; w.y = r1[0]; w.z = r0[1]; w.w = r1[1];
                        *(u32x4*)(YB + (size_t)(row0 + ai * 128 + m * 16) * D + u.pn * 256 + wc * 64 + ((fq & 1) ? 8 * (fq - 1) : 32 + 8 * fq)) = w; } }
                else { bf16_t* rowp = (bf16_t*)YB + (size_t)(row0 + ai * 128 + m * 16) * D + col0;
#pragma unroll
                for (int bj = 0; bj < 2; ++bj) *(u32x4*)(rowp + bj * 128) = pack8(acc[ai][bj][m][0] * dq + bv[bj][0], acc[ai][bj][m][1] * dq + bv[bj][1]); } }
    }
};

__device__ __forceinline__ void fcumsum_wave(const AR a, int bh, int lane) {
    const int b = bh >> 3, h = bh & 7;
    const float* logf = (const float*)(a.ws() + WS_LOGF) + ((size_t)b * SEQ + 32 * lane) * 8 + h;
    float v[32]; float run = 0.f;
#pragma unroll
    for (int i = 0; i < 32; ++i) { run += logf[i * 8]; v[i] = run; }
    float inc = run;
#pragma unroll
    for (int o = 1; o < 64; o <<= 1) { const float t = shup(lane, inc, o); if (lane >= o) inc += t; }
    const float base = inc - run;
    float* F2 = (float*)(a.ws() + WS_F2) + (size_t)bh * SEQ + 32 * lane;
#pragma unroll
    for (int i = 0; i < 32; i += 4) { f32x4 o = {(base + v[i]) * LOG2E, (base + v[i + 1]) * LOG2E, (base + v[i + 2]) * LOG2E, (base + v[i + 3]) * LOG2E}; *(f32x4*)(F2 + i) = o; }
}

__device__ __forceinline__ int crow(int r, int hi) { return (r & 3) + 8 * (r >> 2) + 4 * hi; }
#define MFMA32(a, b, c) __builtin_amdgcn_mfma_f32_32x32x16_bf16(a, b, c, 0, 0, 0)

constexpr int LRU_WB = 13312;
constexpr int LRU_CW = 8 * LRU_WB;
constexpr int LRU_BF = LRU_CW + 2048;
__device__ __forceinline__ void lru_unit(const AR a, int l, int b, int n, LAS unsigned char* lds, int tid, int wave, int lane) {
    const int r32 = lane & 31, hi = lane >> 5;
    LAS unsigned char* wb = lds + wave * LRU_WB;
    LAS unsigned short* XS = (LAS unsigned short*)wb; LAS unsigned short* GS = (LAS unsigned short*)(wb + 8704); LAS unsigned short* OS = XS; LAS float* XF = (LAS float*)wb;
    LAS unsigned char* BF = lds + LRU_BF;
    LAS float* CWT = (LAS float*)(lds + LRU_CW); LAS float* CBT = CWT + 256;
    LAS float* CAR = (LAS float*)(lds + MISC_OFF + MO_CAR);
    const bf16_t* Z = (const bf16_t*)(a.ws() + WS_Z); bf16_t* O = (bf16_t*)(a.ws() + WS_O);
    const int chb = n * 64;
    __syncthreads();
    if (tid < 256) CWT[tid] = a.in(I_CONVW)[(size_t)l * 4 * D + (tid >> 6) * D + chb + (tid & 63)];
    else if (tid < 320) CBT[tid - 256] = a.in(I_CONVB)[(size_t)l * D + chb + (tid - 256)];
#pragma unroll
    for (int q = 0; q < 2; ++q) { const int f = 2 * wave + q, mat = f >> 3, ks = (f >> 1) & 3, nt = f & 1, d = 32 * nt + r32, c0 = 16 * ks + 8 * hi;
        const float* w = a.in(mat ? I_WX : I_WA) + ((size_t)l * 16 + n) * 4096; u32x4 p;
        p.x = pk2(w[(c0 + 0) * 64 + d], w[(c0 + 1) * 64 + d]); p.y = pk2(w[(c0 + 2) * 64 + d], w[(c0 + 3) * 64 + d]); p.z = pk2(w[(c0 + 4) * 64 + d], w[(c0 + 5) * 64 + d]); p.w = pk2(w[(c0 + 6) * 64 + d], w[(c0 + 7) * 64 + d]);
        *(LAS u32x4*)(BF + f * 1024 + lane * 16) = p; }
    float ba[2], bx[2], cl[2], csup[2];
    { const float* pba = a.in(I_BA) + (size_t)l * D + chb + r32; const float* pbx = a.in(I_BX) + (size_t)l * D + chb + r32; const float* plm = a.in(I_LAM) + (size_t)l * D + chb + r32;
      const float ba0 = pba[0], ba1 = pba[32], bx0 = pbx[0], bx1 = pbx[32], lm0 = plm[0], lm1 = plm[32];
      ba[0] = ba0; ba[1] = ba1; bx[0] = bx0; bx[1] = bx1; csup[0] = 0.f; csup[1] = 0.f;
      cl[0] = -8.0f * (fmaxf(-lm0, 0.f) + 0.6931471806f * flog2(1.0f + fexp2(-LOG2E * fabsf(lm0))));
      cl[1] = -8.0f * (fmaxf(-lm1, 0.f) + 0.6931471806f * flog2(1.0f + fexp2(-LOG2E * fabsf(lm1)))); }
    __syncthreads();
    int par = 0;
    u32x4 xsr[5], gsr[4];
#define LRU_LOADROWS(S) do { const int t0_ = 256 * (S) + 32 * wave; const size_t m0_ = (size_t)b * SEQ + t0_; \
        _Pragma("unroll") for (int it = 0; it < 5; ++it) { const int c = lane + 64 * it; const int rr = c >> 3, c8 = c & 7; xsr[it] = (u32x4){0u, 0u, 0u, 0u}; \
            if (c < 280 && t0_ - 3 + rr >= 0) xsr[it] = *(const u32x4*)(Z + (m0_ - 3 + rr) * ZP + ZC_XC + chb + 8 * c8); } \
        _Pragma("unroll") for (int it = 0; it < 4; ++it) { const int c = lane + 64 * it; const int rr = c >> 3, c8 = c & 7; gsr[it] = *(const u32x4*)(Z + (m0_ + rr) * ZP + ZC_GC + chb + 8 * c8); } } while (0)
    LRU_LOADROWS(0);
    for (int s = 0; s < 8; ++s) {
        const int t0 = 256 * s + 32 * wave; const size_t m0 = (size_t)b * SEQ + t0;
#pragma unroll
        for (int it = 0; it < 5; ++it) { const int c = lane + 64 * it; if (c < 280) { const int rr = c >> 3, c8 = c & 7; *(LAS u32x4*)((LAS unsigned char*)XS + rr * 144 + c8 * 16) = xsr[it]; } }
#pragma unroll
        for (int it = 0; it < 4; ++it) { const int c = lane + 64 * it; const int rr = c >> 3, c8 = c & 7; *(LAS u32x4*)((LAS unsigned char*)GS + rr * 144 + c8 * 16) = gsr[it]; }
        if (s < 7) LRU_LOADROWS(s + 1);
        LDS_WAIT(); asm volatile("" ::: "memory");
        f32x16 accA[2], accX[2];
#pragma unroll
        for (int nt = 0; nt < 2; ++nt) { accA[nt] = f32x16{}; accX[nt] = f32x16{}; }
        f32x4 xo[4][2];
#pragma unroll
        for (int ks = 0; ks < 4; ++ks) { const int c0 = 16 * ks + 8 * hi;
            f32x4 o0 = *(const LAS f32x4*)(CBT + c0), o1 = *(const LAS f32x4*)(CBT + c0 + 4);
#pragma unroll
            for (int j = 0; j < 4; ++j) { const u32x4 xw = *(const LAS u32x4*)((LAS unsigned char*)XS + (r32 + j) * 144 + c0 * 2); f32x4 x0, x1; unpack8(xw, x0, x1);
                const f32x4 w0 = *(const LAS f32x4*)(CWT + j * 64 + c0), w1 = *(const LAS f32x4*)(CWT + j * 64 + c0 + 4);
                o0 = o0 + x0 * w0; o1 = o1 + x1 * w1; }
            xo[ks][0] = o0; xo[ks][1] = o1;
            const bf16x8 af = __builtin_bit_cast(bf16x8, pack8(o0, o1));
#pragma unroll
            for (int nt = 0; nt < 2; ++nt) { const bf16x8 bwa = *(const LAS bf16x8*)(BF + (ks * 2 + nt) * 1024 + lane * 16), bwx = *(const LAS bf16x8*)(BF + (8 + ks * 2 + nt) * 1024 + lane * 16);
                accA[nt] = MFMA32(af, bwa, accA[nt]); accX[nt] = MFMA32(af, bwx, accX[nt]); } }
        LDS_WAIT(); asm volatile("" ::: "memory");
#pragma unroll
        for (int ks = 0; ks < 4; ++ks) { const int c0 = 16 * ks + 8 * hi; *(LAS f32x4*)(XF + r32 * 68 + c0) = xo[ks][0]; *(LAS f32x4*)(XF + r32 * 68 + c0 + 4) = xo[ks][1]; }
        LDS_WAIT(); asm volatile("" ::: "memory");
        float av[2][16], uv[2][16], TA[2], TH[2];
#pragma unroll
        for (int nt = 0; nt < 2; ++nt) { const int d = 32 * nt + r32;
#pragma unroll
            for (int r = 0; r < 16; ++r) { const int row = crow(r, hi);
                const float xc = XF[row * 68 + d];
                const float rg = fsigmoid(accA[nt][r] + ba[nt]), ig = fsigmoid(accX[nt][r] + bx[nt]);
                const float la = cl[nt] * rg, aa = fexp2(la * LOG2E), x2 = 2.0f * la;
                const float om = (x2 > -0.1f) ? -x2 * (1.0f + x2 * (0.5f + x2 * (0.16666667f + x2 * 0.041666668f))) : 1.0f - aa * aa;
                av[nt][r] = aa; uv[nt][r] = sqrtf(om) * (ig * xc);
                if ((r & 3) == 3) asm volatile("" ::: "memory"); }
            float GA[4], GH[4], oA[4], oH[4], cown[4], pown[4];
#pragma unroll
            for (int gi = 0; gi < 4; ++gi) { float hh = 0.f, pp = 1.f;
#pragma unroll
                for (int q = 0; q < 4; ++q) { const int r = 4 * gi + q; hh = av[nt][r] * hh + uv[nt][r]; pp = pp * av[nt][r]; uv[nt][r] = hh; av[nt][r] = pp; }
                GA[gi] = pp; GH[gi] = hh; oA[gi] = shx(lane, pp, 32); oH[gi] = shx(lane, hh, 32); cown[gi] = 0.f; pown[gi] = 1.f; }
            float cin = 0.f, pin = 1.f;
#pragma unroll
            for (int tg = 0; tg < 8; ++tg) { const int gi = tg >> 1; const bool own = ((tg & 1) == hi);
                const float A = own ? GA[gi] : oA[gi], H = own ? GH[gi] : oH[gi];
                cown[gi] = own ? cin : cown[gi]; pown[gi] = own ? pin : pown[gi];
                cin = A * cin + H; pin = A * pin; }
#pragma unroll
            for (int r = 0; r < 16; ++r) { uv[nt][r] = uv[nt][r] + av[nt][r] * cown[r >> 2]; av[nt][r] = av[nt][r] * pown[r >> 2]; }
            TA[nt] = pin; TH[nt] = cin;
            if (hi == 0) { CAR[((par * 8 + wave) * 64 + d) * 2] = pin; CAR[((par * 8 + wave) * 64 + d) * 2 + 1] = cin; } }
        __syncthreads();
#pragma unroll
        for (int nt = 0; nt < 2; ++nt) { const int d = 32 * nt + r32; float cw = csup[nt], call = csup[nt];
#pragma unroll
            for (int w2 = 0; w2 < 8; ++w2) { const f32x2 ah = *(const LAS f32x2*)(CAR + ((par * 8 + w2) * 64 + d) * 2);
                call = ah[0] * call + ah[1]; if (w2 < wave) cw = call; }
            csup[nt] = call;
#pragma unroll
            for (int r = 0; r < 16; ++r) { const int row = crow(r, hi);
                const float hf = uv[nt][r] + av[nt][r] * cw;
                const float g = bf2f((unsigned)GS[row * 72 + d]);
                const float ge = g * fsigmoid(1.5957691216f * (g + 0.044715f * g * g * g));
                if (FP8_MRG) ((LAS unsigned char*)OS)[row * 80 + d] = f8_byte(hf * ge * Q_O); else OS[row * 72 + d] = (unsigned short)f2bf(hf * ge); } }
        LDS_WAIT(); asm volatile("" ::: "memory");
        if (FP8_MRG) {
#pragma unroll
            for (int it = 0; it < 2; ++it) { const int c = lane + 64 * it; const int rr = c >> 2, c4 = c & 3;
                *(u32x4*)((unsigned char*)O + (m0 + rr) * OP + 1024 + chb + 16 * c4) = *(const LAS u32x4*)((LAS unsigned char*)OS + rr * 80 + c4 * 16); } }
        else {
#pragma unroll
        for (int it = 0; it < 4; ++it) { const int c = lane + 64 * it; const int rr = c >> 3, c8 = c & 7;
            *(u32x4*)(O + (m0 + rr) * OP + 1024 + chb + 8 * c8) = *(const LAS u32x4*)((LAS unsigned char*)OS + rr * 144 + c8 * 16); } }
        par ^= 1;
    }
}

constexpr int AT_KS = 0, AT_VT = 9216, AT_FS = 17920, AT_WSF = 18432, AT_FLAG = 20480;
template <int MODE>
__device__ __forceinline__ void attn_unit(const AR a, int b, int h, int qb, LAS unsigned char* lds, int tid, int wave, int lane) {
    const int r32 = lane & 31, hi = lane >> 5;
    const bf16_t* Z = (const bf16_t*)(a.ws() + WS_Z); bf16_t* O = (bf16_t*)(a.ws() + WS_O);
    const float* F2 = (const float*)(a.ws() + WS_F2) + (size_t)(b * 8 + h) * SEQ;
    const size_t rowbase = (size_t)b * SEQ; const int q0 = qb * 256, qw0 = q0 + 32 * wave, q = qw0 + r32;
    const int qcol = (MODE == 0 ? ZC_QA : ZC_QB) + h * 64, kcol = (MODE == 0 ? ZC_KA : ZC_KB) + h * 64, vcol = (MODE == 0 ? ZC_VA : ZC_VB) + h * 64, ocol = (MODE == 0 ? 0 : 512) + h * 64;
    LAS unsigned char* KS = lds + AT_KS; LAS unsigned short* VT = (LAS unsigned short*)(lds + AT_VT); LAS float* FS = (LAS float*)(lds + AT_FS);
    LAS float* wsf = (LAS float*)(lds + AT_WSF) + wave * 64; LAS int* flags = (LAS int*)(lds + AT_FLAG);
    bf16x8 qr[4];
#pragma unroll
    for (int ks = 0; ks < 4; ++ks) qr[ks] = *(const bf16x8*)(Z + (rowbase + q) * ZP + qcol + 16 * ks + 8 * hi);
    const float fq = (MODE == 0) ? F2[q] : 0.f;
    f32x16 o0 = f32x16{}, o1 = f32x16{};
    float mrun = -INFINITY, lsum = 0.f, R = 0.f;
    const int NT = 4 * qb + 4;
    const int lkey = tid >> 3, lch = tid & 7;
    const bf16_t* kp = Z + (rowbase + lkey) * ZP + kcol + 8 * lch; const bf16_t* vp = Z + (rowbase + lkey) * ZP + vcol + 8 * lch;
    u32x4 kreg = *(const u32x4*)(kp + (size_t)(NT - 1) * 64 * ZP), vreg = *(const u32x4*)(vp + (size_t)(NT - 1) * 64 * ZP);
    float freg = 0.f; if (MODE == 0 && tid < 64) freg = F2[(NT - 1) * 64 + tid];
    bool wdone = false;
    __syncthreads();
    for (int jt = NT - 1; jt >= 0; --jt) {
        *(LAS u32x4*)(KS + lkey * 144 + lch * 16) = kreg;
        { const unsigned vv[4] = {vreg.x, vreg.y, vreg.z, vreg.w};
#pragma unroll
          for (int i = 0; i < 4; ++i) { VT[(8 * lch + 2 * i) * 68 + lkey] = (unsigned short)(vv[i] & 0xffffu); VT[(8 * lch + 2 * i + 1) * 68 + lkey] = (unsigned short)(vv[i] >> 16); } }
        if (MODE == 0 && tid < 64) FS[tid] = freg;
        if (MODE == 1 && lane == 0) flags[wave] = wdone ? 1 : 0;
        __syncthreads();
        if (MODE == 1) { int all = 1;
#pragma unroll
            for (int w2 = 0; w2 < 8; ++w2) all &= flags[w2];
            if (all) break; }
        if (jt > 0) { kreg = *(const u32x4*)(kp + (size_t)(jt - 1) * 64 * ZP); vreg = *(const u32x4*)(vp + (size_t)(jt - 1) * 64 * ZP); if (MODE == 0 && tid < 64) freg = F2[(jt - 1) * 64 + tid]; }
        const int k0 = jt * 64;
        const bool active = (MODE == 0) ? (k0 <= qw0 + 31) : ((k0 < qw0 + 31) && !wdone);
        if (active) {
            f32x16 p0 = f32x16{}, p1 = f32x16{};
#pragma unroll
            for (int ks = 0; ks < 4; ++ks) { const bf16x8 ka = *(const LAS bf16x8*)(KS + r32 * 144 + (16 * ks + 8 * hi) * 2), kb = *(const LAS bf16x8*)(KS + (r32 + 32) * 144 + (16 * ks + 8 * hi) * 2);
                p0 = MFMA32(ka, qr[ks], p0); p1 = MFMA32(kb, qr[ks], p1); }
            if (MODE == 0) {
                float rm = -INFINITY;
#pragma unroll
                for (int g = 0; g < 4; ++g) { const f32x4 f0 = *(const LAS f32x4*)(FS + 8 * g + 4 * hi), f1 = *(const LAS f32x4*)(FS + 32 + 8 * g + 4 * hi);
#pragma unroll
                    for (int i = 0; i < 4; ++i) { const int r = 4 * g + i, kv = k0 + 8 * g + 4 * hi + i;
                        float s0 = p0[r] + (fq - f0[i]), s1 = p1[r] + (fq - f1[i]);
                        if (kv > q) s0 = -INFINITY; if (kv + 32 > q) s1 = -INFINITY;
                        p0[r] = s0; p1[r] = s1; rm = fmaxf(rm, fmaxf(s0, s1)); } }
                rm = fmaxf(rm, shx(lane, rm, 32));
                const float mnew = fmaxf(mrun, rm), alpha = fexp2(mrun - mnew); mrun = mnew;
                float ls = 0.f;
#pragma unroll
                for (int r = 0; r < 16; ++r) { p0[r] = fexp2(p0[r] - mnew); p1[r] = fexp2(p1[r] - mnew); ls += p0[r] + p1[r]; }
                lsum = lsum * alpha + ls;
                if (hi == 0) wsf[r32] = alpha;
                LDS_WAIT(); asm volatile("" ::: "memory");
#pragma unroll
                for (int r = 0; r < 16; ++r) { const float f = wsf[crow(r, hi)]; o0[r] *= f; o1[r] *= f; }
            } else {
                float lg[8], rG[8], P1[8], P2[8], P3[8], oL[8];
#pragma unroll
                for (int r = 0; r < 16; ++r) { const int kv = k0 + crow(r, hi);
                    const float e0 = fexp2(fminf(p0[r], 30.0f)), e1 = fexp2(fminf(p1[r], 30.0f));
                    p0[r] = (kv < q) ? e0 : 0.f; p1[r] = (kv + 32 < q) ? e1 : 0.f; }
#pragma unroll
                for (int g = 0; g < 4; ++g) {
                    { const float d0 = 1.0f + p0[4 * g], d1 = 1.0f + p0[4 * g + 1], d2 = 1.0f + p0[4 * g + 2], d3 = 1.0f + p0[4 * g + 3];
                      P1[g] = d0; P2[g] = d0 * d1; P3[g] = P2[g] * d2; const float G = P3[g] * d3; lg[g] = flog2(G); rG[g] = frcp(G); }
                    { const float d0 = 1.0f + p1[4 * g], d1 = 1.0f + p1[4 * g + 1], d2 = 1.0f + p1[4 * g + 2], d3 = 1.0f + p1[4 * g + 3];
                      P1[4 + g] = d0; P2[4 + g] = d0 * d1; P3[4 + g] = P2[4 + g] * d2; const float G = P3[4 + g] * d3; lg[4 + g] = flog2(G); rG[4 + g] = frcp(G); } }
#pragma unroll
                for (int g = 0; g < 8; ++g) oL[g] = shx(lane, lg[g], 32);
                float off[8], run = 0.f;
#pragma unroll
                for (int kg = 15; kg >= 0; --kg) { const bool own = ((kg & 1) == hi); const float sm = own ? lg[kg >> 1] : oL[kg >> 1];
                    off[kg >> 1] = own ? run : off[kg >> 1]; run += sm; }
#pragma unroll
                for (int g = 0; g < 4; ++g) {
                    { const float F = fexp2(R - off[g]), c = rG[g];
                      p0[4 * g] = (c * p0[4 * g]) * F; p0[4 * g + 1] = ((P1[g] * c) * p0[4 * g + 1]) * F; p0[4 * g + 2] = ((P2[g] * c) * p0[4 * g + 2]) * F; p0[4 * g + 3] = ((P3[g] * c) * p0[4 * g + 3]) * F; }
                    { const float F = fexp2(R - off[4 + g]), c = rG[4 + g];
                      p1[4 * g] = (c * p1[4 * g]) * F; p1[4 * g + 1] = ((P1[4 + g] * c) * p1[4 * g + 1]) * F; p1[4 * g + 2] = ((P2[4 + g] * c) * p1[4 * g + 2]) * F; p1[4 * g + 3] = ((P3[4 + g] * c) * p1[4 * g + 3]) * F; } }
                R -= run;
                wdone = __all(R < -152.0f);
            }
            bf16x8 pa[4];
            { u32x4 w;
              w.x = pk2(p0[0], p0[1]); w.y = pk2(p0[2], p0[3]); w.z = pk2(p0[4], p0[5]); w.w = pk2(p0[6], p0[7]); pa[0] = __builtin_bit_cast(bf16x8, w);
              w.x = pk2(p0[8], p0[9]); w.y = pk2(p0[10], p0[11]); w.z = pk2(p0[12], p0[13]); w.w = pk2(p0[14], p0[15]); pa[1] = __builtin_bit_cast(bf16x8, w);
              w.x = pk2(p1[0], p1[1]); w.y = pk2(p1[2], p1[3]); w.z = pk2(p1[4], p1[5]); w.w = pk2(p1[6], p1[7]); pa[2] = __builtin_bit_cast(bf16x8, w);
              w.x = pk2(p1[8], p1[9]); w.y = pk2(p1[10], p1[11]); w.z = pk2(p1[12], p1[13]); w.w = pk2(p1[14], p1[15]); pa[3] = __builtin_bit_cast(bf16x8, w); }
#pragma unroll
            for (int s = 0; s < 4; ++s) {
#pragma unroll
                for (int d0 = 0; d0 < 2; ++d0) { const LAS unsigned short* vrow = VT + (32 * d0 + r32) * 68 + 16 * s + 4 * hi;
                    const u32x2 lo = *(const LAS u32x2*)vrow, hh = *(const LAS u32x2*)(vrow + 8);
                    const u32x4 vw = {lo.x, lo.y, hh.x, hh.y}; const bf16x8 vf = __builtin_bit_cast(bf16x8, vw);
                    if (d0 == 0) o0 = MFMA32(pa[s], vf, o0); else o1 = MFMA32(pa[s], vf, o1); } }
        }
        __syncthreads();
    }
    if (MODE == 0) { const float lt = lsum + shx(lane, lsum, 32); if (hi == 0) wsf[r32] = 1.0f / lt; LDS_WAIT(); asm volatile("" ::: "memory");
#pragma unroll
        for (int r = 0; r < 16; ++r) { const float f = wsf[crow(r, hi)]; o0[r] *= f; o1[r] *= f; } }
#pragma unroll
    for (int r = 0; r < 16; ++r) {
        if (FP8_MRG) { unsigned char* op = (unsigned char*)O + (rowbase + qw0 + crow(r, hi)) * OP + ocol + r32; op[0] = f8_byte(o0[r] * Q_O); op[32] = f8_byte(o1[r] * Q_O); }
        else { bf16_t* op = O + (rowbase + qw0 + crow(r, hi)) * OP + ocol + r32; op[0] = (bf16_t)f2bf(o0[r]); op[32] = (bf16_t)f2bf(o1[r]); } }
}
#include <hip/hip_bf16.h>
#include <cmath>
namespace fox_body {
using bf16=__hip_bfloat16;
using bf16x8=__attribute__((ext_vector_type(8)))short;
using s16x4=__attribute__((ext_vector_type(4)))short;
using f32x16=__attribute__((ext_vector_type(16)))float;
using u32x4=__attribute__((ext_vector_type(4)))unsigned;
constexpr int SEQ=2048,D=64,DM=5184,DMO=2048;
constexpr int NW=8,QBLK=32,QB=QBLK*NW,KVBLK=64,NQB=SEQ/QB;
constexpr int ATTN_UNIT_ROWS=QB;
__device__ __forceinline__ int crow(int r,int hi){return (r&3)+8*(r>>2)+4*hi;}
#define SBAR() __builtin_amdgcn_sched_barrier(0)
__device__ __forceinline__ void cmask(f32x16&p0,f32x16&p1,int jb,int qrel,int hi){
  const float NEG=-INFINITY; int kb=64*jb+4*hi;
  #pragma unroll
  for(int r=0;r<16;++r){int kv=kb+(r&3)+8*(r>>2); if(kv>qrel)p0[r]=NEG; if(kv+32>qrel)p1[r]=NEG;}
}

constexpr int NSLOT=3, SLOTB=8192;
constexpr int LDS_K=0, LDS_V=NSLOT*SLOTB, LDS_WS=2*NSLOT*SLOTB, LDS_OST=LDS_WS+NW*64*4, LDS_BYTES=LDS_OST+NW*4096;
constexpr float C2=0.125f*1.4426950408889634f;
__device__ __forceinline__ void glds16(const void*gsrc,unsigned lds_dst){unsigned keep;
  asm volatile("s_mov_b32 %0, m0\n\ts_mov_b32 m0, %2\n\ts_nop 0\n\tglobal_load_lds_dwordx4 %1, off\n\ts_mov_b32 m0, %0":"=&s"(keep):"v"(gsrc),"s"(lds_dst):"memory");}
__device__ __forceinline__ float max3f(float a,float b,float c){float r;asm("v_max3_f32 %0, %1, %2, %3":"=v"(r):"v"(a),"v"(b),"v"(c));return r;}
__device__ __forceinline__ float max2f(float a,float b){float r;asm("v_max_f32_e32 %0, %1, %2":"=v"(r):"v"(a),"v"(b));return r;}
__device__ __forceinline__ float fadd_s(float a,float b){float r;asm("v_add_f32_e32 %0, %1, %2":"=v"(r):"v"(a),"v"(b));return r;}
__device__ __forceinline__ float fsub_s(float a,float b){float r;asm("v_sub_f32_e32 %0, %1, %2":"=v"(r):"v"(a),"v"(b));return r;}
typedef float f32x2_t __attribute__((ext_vector_type(2))); typedef float f32x4_t __attribute__((ext_vector_type(4))); typedef __bf16 bf16x2_t __attribute__((ext_vector_type(2)));
__device__ __forceinline__ unsigned cvtpk_s(float lo,float hi){f32x2_t v={lo,hi};bf16x2_t b=__builtin_convertvector(v,bf16x2_t);return __builtin_bit_cast(unsigned,b);}
#define WAIT_BAR(N) asm volatile("s_waitcnt vmcnt(" #N ") lgkmcnt(0)\n\ts_barrier":::"memory")

__device__ __forceinline__ void qkt(f32x16&p0,f32x16&p1,const char*Kslot,const bf16x8*qr,const f32x16&negm,int r32,int hi){
  const char*kb=Kslot+hi*1024+r32*16;
  #pragma unroll
  for(int d0=0;d0<4;++d0){
    const bf16x8 b0=*reinterpret_cast<const bf16x8*>(kb+d0*2048);
    const bf16x8 b1=*reinterpret_cast<const bf16x8*>(kb+d0*2048+512);
    if(d0==0){p0=__builtin_amdgcn_mfma_f32_32x32x16_bf16(b0,qr[0],negm,0,0,0);p1=__builtin_amdgcn_mfma_f32_32x32x16_bf16(b1,qr[0],negm,0,0,0);}
    else{p0=__builtin_amdgcn_mfma_f32_32x32x16_bf16(b0,qr[d0],p0,0,0,0);p1=__builtin_amdgcn_mfma_f32_32x32x16_bf16(b1,qr[d0],p1,0,0,0);}}
}
typedef __attribute__((address_space(3))) const char* lds_cptr;
typedef short v4i16_t __attribute__((ext_vector_type(4)));
__device__ __forceinline__ void kload8(bf16x8*kf,lds_cptr kp){
  kf[0]=*(const __attribute__((address_space(3))) bf16x8*)(kp);      kf[1]=*(const __attribute__((address_space(3))) bf16x8*)(kp+512);
  kf[2]=*(const __attribute__((address_space(3))) bf16x8*)(kp+2048); kf[3]=*(const __attribute__((address_space(3))) bf16x8*)(kp+2560);
  kf[4]=*(const __attribute__((address_space(3))) bf16x8*)(kp+4096); kf[5]=*(const __attribute__((address_space(3))) bf16x8*)(kp+4608);
  kf[6]=*(const __attribute__((address_space(3))) bf16x8*)(kp+6144); kf[7]=*(const __attribute__((address_space(3))) bf16x8*)(kp+6656);
}
__device__ __forceinline__ void kload2(bf16x8*kf,lds_cptr kp,int j){ kf[2*j]=*(const __attribute__((address_space(3))) bf16x8*)(kp+j*2048); kf[2*j+1]=*(const __attribute__((address_space(3))) bf16x8*)(kp+j*2048+512); }
__device__ __forceinline__ s16x4 vtr(lds_cptr p){ return __builtin_bit_cast(s16x4,__builtin_amdgcn_ds_read_tr16_b64_v4i16((__attribute__((address_space(3))) v4i16_t*)p)); }
__device__ __forceinline__ float rowmax(const f32x16&p0,const f32x16&p1){
  float a=max3f(p0[0],p0[1],p1[0]),b=max3f(p0[2],p0[3],p1[1]);a=max3f(a,p1[2],p1[3]);
  #pragma unroll
  for(int r=4;r<16;r+=4){a=max3f(a,p0[r],p0[r+1]);b=max3f(b,p0[r+2],p0[r+3]);a=max3f(a,p1[r],p1[r+1]);b=max3f(b,p1[r+2],p1[r+3]);}
  const float m=max2f(a,b);
  auto rr=__builtin_amdgcn_permlane32_swap(__float_as_uint(m),__float_as_uint(m),false,false);
  return max2f(__uint_as_float(rr[0]),__uint_as_float(rr[1]));
}
__device__ __forceinline__ void pv(f32x16*o,int vb,bf16x8 pa0,bf16x8 pa1,bf16x8 pa2,bf16x8 pa3){
  #pragma unroll
  for(int d0=0;d0<2;++d0){s16x4 lo[4],hi[4];
    #pragma unroll
    for(int ks=0;ks<4;++ks){
      asm volatile("ds_read_b64_tr_b16 %0,%1 offset:%c2":"=&v"(lo[ks]):"v"(vb),"i"(d0*4096+ks*1024):"memory");
      asm volatile("ds_read_b64_tr_b16 %0,%1 offset:%c2":"=&v"(hi[ks]):"v"(vb),"i"(d0*4096+ks*1024+512):"memory");}
    asm volatile("s_waitcnt lgkmcnt(0)":::"memory");SBAR();
    #define PK(k) (bf16x8){lo[k][0],lo[k][1],lo[k][2],lo[k][3],hi[k][0],hi[k][1],hi[k][2],hi[k][3]}
    o[d0]=__builtin_amdgcn_mfma_f32_32x32x16_bf16(pa0,PK(0),o[d0],0,0,0);
    o[d0]=__builtin_amdgcn_mfma_f32_32x32x16_bf16(pa1,PK(1),o[d0],0,0,0);
    o[d0]=__builtin_amdgcn_mfma_f32_32x32x16_bf16(pa2,PK(2),o[d0],0,0,0);
    o[d0]=__builtin_amdgcn_mfma_f32_32x32x16_bf16(pa3,PK(3),o[d0],0,0,0);
    #undef PK
  }
}

#ifndef ATTN_STORE16
#define ATTN_STORE16(p,v) (*(u32x4*)(p)=(v))
#endif
template<int THRL> __device__ __forceinline__ void attn_unit(int b,int h,int qb,const bf16*Q,const bf16*__restrict__ K,const bf16*__restrict__ V,bf16*O,const __attribute__((address_space(3))) float*Fl,char*shm,int tid){
  const int lane=tid&63,r32=lane&31,hi=lane>>5; const int wid=__builtin_amdgcn_readfirstlane(tid>>6);
  const long rowbase=(long)b*SEQ; const int q0=qb*QB;
  const bf16*Qw=Q+(rowbase+q0+wid*QBLK)*DM+h*D;
  const bf16*Kh=K+rowbase*DM+h*D,*Vh=V+rowbase*DM+h*D;
  const unsigned lds0=(unsigned)(uintptr_t)shm;
  float*wsf=(float*)(shm+LDS_WS)+wid*64;
  const unsigned koff=(unsigned)(lane*DM+wid*8);
  const unsigned voff=(unsigned)((16*(wid&3)+(lane>>2))*DM+(wid>>2)*32+(lane&3)*8);
  const unsigned kdst=lds0+LDS_K+wid*1024, vdst=lds0+LDS_V+wid*1024;
  #define DMA_K(t,slot) glds16(Kh+((long)(t)*KVBLK*DM+koff),(unsigned)__builtin_amdgcn_readfirstlane(kdst+(slot)))
  #define DMA_V(t,slot) glds16(Vh+((long)(t)*KVBLK*DM+voff),(unsigned)__builtin_amdgcn_readfirstlane(vdst+(slot)))
  const int vb0=(int)(lds0+LDS_V)+((lane>>4)&1)*32+(lane&3)*8+(4*hi+((lane&15)>>2))*64;
  const char*Kbase=shm+LDS_K; bf16x8 kf[8];
  const lds_cptr shm3=(lds_cptr)shm; const lds_cptr kp0=shm3+LDS_K+hi*1024+r32*16; const lds_cptr vp0=shm3+LDS_V+((lane>>4)&1)*32+(lane&3)*8+(4*hi+((lane&15)>>2))*64;
  const int NT=(q0+QB)/KVBLK;
  DMA_K(0,0);DMA_V(0,0);DMA_K(1,SLOTB);
  bf16x8 qr[4];
  #pragma unroll
  for(int d0=0;d0<4;++d0)qr[d0]=*reinterpret_cast<const bf16x8*>(&Qw[(long)r32*DM+d0*16+hi*8]);
  const float fq=Fl[q0+wid*QBLK+r32];
  float mhat=0.f,l_reg=0.f;f32x16 o[2];o[0]=f32x16{};o[1]=f32x16{};const f32x16 negm=f32x16{};
  float cc=-fq;
  #define FSUB(P0,P1,t) do{ _Pragma("unroll") for(int g_=0;g_<4;++g_){ \
      { const f32x4_t f0_=*(const __attribute__((address_space(3))) f32x4_t*)(Fl+(t)*64+8*g_+4*hi)+cc; \
        _Pragma("unroll") for(int i_=0;i_<4;++i_) P0[4*g_+i_]-=f0_[i_]; asm volatile("":::"memory"); } \
      { const f32x4_t f1_=*(const __attribute__((address_space(3))) f32x4_t*)(Fl+(t)*64+32+8*g_+4*hi)+cc; \
        _Pragma("unroll") for(int i_=0;i_<4;++i_) P1[4*g_+i_]-=f1_[i_]; asm volatile("":::"memory"); } } }while(0)
  const int qrel=wid*QBLK+r32;
  #define CMASK(P0,P1,t) do{int jb_=(t)-(NT-4); if(jb_>=0)cmask(P0,P1,jb_,qrel,hi);}while(0)
  bool resc=false;
  #define START(P0,P1) do{ const float rm=rowmax(P0,P1); resc=false; \
    { const float dl=rm; mhat=fadd_s(mhat,dl); \
      _Pragma("unroll") for(int r=0;r<16;++r){P0[r]=fsub_s(P0[r],dl);P1[r]=fsub_s(P1[r],dl);} \
      cc=mhat-fq; } \
    _Pragma("unroll") for(int r=0;r<16;++r)P0[r]=__builtin_amdgcn_exp2f(P0[r]); }while(0)
  #define RESC() do{ if(resc){ asm volatile("s_waitcnt lgkmcnt(0)":::"memory"); \
      _Pragma("unroll") for(int d_=0;d_<2;++d_) _Pragma("unroll") for(int r=0;r<16;++r)o[d_][r]*=wsf[crow(r,hi)]; } }while(0)
  f32x16 pA0,pA1,pB0,pB1;
  int sl_prev=0,sl_cur=0,sl_next=SLOTB;
  #define ROT() do{sl_prev=sl_cur;sl_cur=sl_next;sl_next=(sl_next==(NSLOT-1)*SLOTB)?0:sl_next+SLOTB;}while(0)
  DMA_K(2,2*SLOTB);
  WAIT_BAR(3);
  qkt(pA0,pA1,Kbase,qr,negm,r32,hi);asm volatile("s_nop 15\n\ts_nop 7":"+v"(pA0),"+v"(pA1));FSUB(pA0,pA1,0);CMASK(pA0,pA1,0);
  START(pA0,pA1);
  _Pragma("unroll") for(int r=0;r<16;++r)pA1[r]=__builtin_amdgcn_exp2f(pA1[r]);
  WAIT_BAR(0);
  DMA_K(3,0);DMA_V(1,SLOTB);
  ROT();
  kload8(kf,kp0+sl_cur);
  WAIT_BAR(2);
  s16x4 vlo[8],vhi[8]; u32x4 pw0,pw1,pw2,pw3;
  #define PKW(P,B) cvtpk_s(P[B],P[B+1])
  #define PAF(k) __builtin_bit_cast(bf16x8,pw##k)
  #define VFR(i) (bf16x8){vlo[i][0],vlo[i][1],vlo[i][2],vlo[i][3],vhi[i][0],vhi[i][1],vhi[i][2],vhi[i][3]}
  #define PIN(x) asm volatile("":"+v"(x))
  #define MX3(a,b,c) __builtin_fmaxf(__builtin_fmaxf((a),(b)),(c))
  #define GAPA(MF,A0,A1,A2,A3,W0,W1,PW) do{ MF; sacc+=A0; sacc+=A1; sacc+=A2; sacc+=A3; PIN(sacc); W0; W1; PIN(PW); SBAR(); }while(0)
  #define EX(v) __builtin_amdgcn_exp2f(v)
  #define GAPB(MF,X,B) do{ MF; X[B]=EX(X[B]); X[B+1]=EX(X[B+1]); X[B+2]=EX(X[B+2]); X[B+3]=EX(X[B+3]); PIN(X); SBAR(); }while(0)
  #define VRD(i) do{ vlo[i]=vtr(vp_+(((i)>>2)*4096+((i)&3)*1024)); vhi[i]=vtr(vp_+(((i)>>2)*4096+((i)&3)*1024+512)); }while(0)
  #define KRD(G,j) do{ if(G){ kload2(kf,kp0+sl_next,j); SBAR(); } }while(0)
  #define STEP(C0,C1,P0,P1,t,GK,GV,GL) do{ SBAR(); \
    const lds_cptr vp_=vp0+sl_prev; \
    VRD(0); SBAR(); float sacc=(P0[0]+P0[1]); \
    GAPA(C0=__builtin_amdgcn_mfma_f32_32x32x16_bf16(kf[0],qr[0],negm,0,0,0), P0[2],P0[3],P0[4],P0[5],     pw0[0]=PKW(P0,0), pw0[1]=PKW(P0,2), pw0); \
    VRD(4); SBAR(); GAPA(C1=__builtin_amdgcn_mfma_f32_32x32x16_bf16(kf[1],qr[0],negm,0,0,0), P0[6],P0[7],P0[8],P0[9],     pw0[2]=PKW(P0,4), pw0[3]=PKW(P0,6), pw0); \
    VRD(1); SBAR(); GAPA(C0=__builtin_amdgcn_mfma_f32_32x32x16_bf16(kf[2],qr[1],C0,0,0,0),   P0[10],P0[11],P0[12],P0[13], pw1[0]=PKW(P0,8), pw1[1]=PKW(P0,10), pw1); \
    VRD(5); SBAR(); GAPA(C1=__builtin_amdgcn_mfma_f32_32x32x16_bf16(kf[3],qr[1],C1,0,0,0),   P0[14],P0[15],P1[0],P1[1],   pw1[2]=PKW(P0,12),pw1[3]=PKW(P0,14), pw1); \
    VRD(2); SBAR(); GAPA(C0=__builtin_amdgcn_mfma_f32_32x32x16_bf16(kf[4],qr[2],C0,0,0,0),   P1[2],P1[3],P1[4],P1[5],     pw2[0]=PKW(P1,0), pw2[1]=PKW(P1,2), pw2); \
    VRD(6); SBAR(); GAPA(C1=__builtin_amdgcn_mfma_f32_32x32x16_bf16(kf[5],qr[2],C1,0,0,0),   P1[6],P1[7],P1[8],P1[9],     pw2[2]=PKW(P1,4), pw2[3]=PKW(P1,6), pw2); \
    VRD(3); SBAR(); GAPA(C0=__builtin_amdgcn_mfma_f32_32x32x16_bf16(kf[6],qr[3],C0,0,0,0),   P1[10],P1[11],P1[12],P1[13], pw3[0]=PKW(P1,8), pw3[1]=PKW(P1,10), pw3); \
    VRD(7); SBAR(); GAPA(C1=__builtin_amdgcn_mfma_f32_32x32x16_bf16(kf[7],qr[3],C1,0,0,0),   P1[14],P1[15],0.f,0.f,       pw3[2]=PKW(P1,12),pw3[3]=PKW(P1,14), pw3); \
    l_reg+=sacc; \
    if(GK){DMA_K((t)+3,sl_cur);} if(GV){DMA_V((t)+1,sl_next);} \
    FSUB(C0,C1,t); CMASK(C0,C1,t); \
    { float a=MX3(C0[0],C0[1],C1[0]),b=MX3(C0[2],C0[3],C1[1]); a=MX3(a,C1[2],C1[3]); \
      _Pragma("unroll") for(int r=4;r<16;r+=4){a=MX3(a,C0[r],C0[r+1]);b=MX3(b,C0[r+2],C0[r+3]);a=MX3(a,C1[r],C1[r+1]);b=MX3(b,C1[r+2],C1[r+3]);} \
      float rm=__builtin_fmaxf(a,b); { auto rr=__builtin_amdgcn_permlane32_swap(__float_as_uint(rm),__float_as_uint(rm),false,false); rm=__builtin_fmaxf(__uint_as_float(rr[0]),__uint_as_float(rr[1])); } \
      resc=false; \
      if(__builtin_expect(__any(rm>(float)THRL),0)){ const float dl=__builtin_fmaxf(rm,0.f); mhat+=dl; \
        _Pragma("unroll") for(int r=0;r<16;++r){C0[r]-=dl;C1[r]-=dl;} \
        cc=mhat-fq; \
        const float f=__builtin_amdgcn_exp2f(-dl); l_reg*=f; if(hi==0)wsf[r32]=f; resc=true; } } \
    SBAR(); \
    GAPB(o[0]=__builtin_amdgcn_mfma_f32_32x32x16_bf16(PAF(0),VFR(0),o[0],0,0,0), C0,0); \
    GAPB(o[1]=__builtin_amdgcn_mfma_f32_32x32x16_bf16(PAF(0),VFR(4),o[1],0,0,0), C0,4); \
    KRD(GL,0); GAPB(o[0]=__builtin_amdgcn_mfma_f32_32x32x16_bf16(PAF(1),VFR(1),o[0],0,0,0), C0,8); \
    KRD(GL,1); GAPB(o[1]=__builtin_amdgcn_mfma_f32_32x32x16_bf16(PAF(1),VFR(5),o[1],0,0,0), C0,12); \
    KRD(GL,2); GAPB(o[0]=__builtin_amdgcn_mfma_f32_32x32x16_bf16(PAF(2),VFR(2),o[0],0,0,0), C1,0); \
    KRD(GL,3); GAPB(o[1]=__builtin_amdgcn_mfma_f32_32x32x16_bf16(PAF(2),VFR(6),o[1],0,0,0), C1,4); \
    GAPB(o[0]=__builtin_amdgcn_mfma_f32_32x32x16_bf16(PAF(3),VFR(3),o[0],0,0,0), C1,8); \
    GAPB(o[1]=__builtin_amdgcn_mfma_f32_32x32x16_bf16(PAF(3),VFR(7),o[1],0,0,0), C1,12); \
    }while(0)
  int t=1;
  #undef CMASK
  #define CMASK(P0,P1,t) do{}while(0)
  for(;t+5<NT;t+=2){
    STEP(pB0,pB1,pA0,pA1,t,true,true,true);     WAIT_BAR(2); RESC(); ROT();
    STEP(pA0,pA1,pB0,pB1,t+1,true,true,true);   WAIT_BAR(2); RESC(); ROT();
  }
  #undef CMASK
  #define CMASK(P0,P1,t) do{int jb_=(t)-(NT-4); if(jb_>=0)cmask(P0,P1,jb_,qrel,hi);}while(0)
  #define ENDW(tt) do{ if((tt)+3<NT){WAIT_BAR(2);} else if((tt)+2<NT){WAIT_BAR(1);} else {WAIT_BAR(0);} }while(0)
  for(;t+1<NT;t+=2){
    STEP(pB0,pB1,pA0,pA1,t,(t+3<NT),(t+1<NT),(t+1<NT));       ENDW(t);   RESC(); ROT();
    STEP(pA0,pA1,pB0,pB1,t+1,(t+4<NT),(t+2<NT),(t+2<NT));     ENDW(t+1); RESC(); ROT();
  }
  STEP(pB0,pB1,pA0,pA1,NT-1,false,false,false); RESC();
  { float sacc=pB0[0]+pB0[1]; _Pragma("unroll") for(int r=2;r<16;++r)sacc+=pB0[r]; _Pragma("unroll") for(int r=0;r<16;++r)sacc+=pB1[r]; l_reg+=sacc;
    pw0=(u32x4){PKW(pB0,0),PKW(pB0,2),PKW(pB0,4),PKW(pB0,6)};pw1=(u32x4){PKW(pB0,8),PKW(pB0,10),PKW(pB0,12),PKW(pB0,14)};pw2=(u32x4){PKW(pB1,0),PKW(pB1,2),PKW(pB1,4),PKW(pB1,6)};pw3=(u32x4){PKW(pB1,8),PKW(pB1,10),PKW(pB1,12),PKW(pB1,14)};
    SBAR(); pv(o,vb0+sl_cur,PAF(0),PAF(1),PAF(2),PAF(3)); }
  #undef PKW
  #undef PAF
  #undef VFR
  #undef PIN
  #undef MX3
  #undef GAPA
  #undef GAPB
  #undef EX
  #undef VRD
  #undef KRD
  #undef STEP
  #undef ENDW
  {auto rr=__builtin_amdgcn_permlane32_swap(__float_as_uint(l_reg),__float_as_uint(l_reg),false,false);l_reg=__uint_as_float(rr[0])+__uint_as_float(rr[1]);}
  if(hi==0)wsf[32+r32]=l_reg;asm volatile("s_waitcnt lgkmcnt(0)":::"memory");
  float rli[16];
  #pragma unroll
  for(int r=0;r<16;++r)rli[r]=__builtin_amdgcn_rcpf(wsf[32+crow(r,hi)]);
#if FP8_MRG
  { unsigned char*Ow8=(unsigned char*)O+(rowbase+q0+wid*QBLK)*DMO+h*D;
    unsigned char*stg=(unsigned char*)(shm+LDS_OST)+wid*4096;
    #pragma unroll
    for(int r=0;r<16;++r){const int orow=crow(r,hi);
      #pragma unroll
      for(int d0=0;d0<2;++d0)stg[orow*64+d0*32+r32]=f8_byte(o[d0][r]*rli[r]*Q_O);}
    asm volatile("s_waitcnt lgkmcnt(0)":::"memory");
    #pragma unroll
    for(int i=0;i<2;++i){const int row=i*16+(lane>>2),ch=lane&3; const u32x4 v=*(const u32x4*)(stg+row*64+ch*16); ATTN_STORE16(Ow8+(long)row*DMO+ch*16,v);} }
#else
  bf16*Ow=O+(rowbase+q0+wid*QBLK)*DMO+h*D;
  { bf16*stg=(bf16*)(shm+LDS_OST)+wid*2048;
    #pragma unroll
    for(int r=0;r<16;++r){const int orow=crow(r,hi);
      #pragma unroll
      for(int d0=0;d0<2;++d0)stg[orow*64+d0*32+r32]=__float2bfloat16(o[d0][r]*rli[r]);}
    asm volatile("s_waitcnt lgkmcnt(0)":::"memory");
    #pragma unroll
    for(int i=0;i<4;++i){const int row=i*8+(lane>>3),ch=lane&7; const u32x4 v=*(const u32x4*)(stg+row*64+ch*8); ATTN_STORE16(Ow+(long)row*DMO+ch*8,v);} }
#endif
  asm volatile("s_waitcnt lgkmcnt(0)\n\ts_barrier":::"memory");
  #undef FSUB
  #undef DMA_K
  #undef DMA_V
  #undef CMASK
  #undef START
  #undef RESC
  #undef ROT
}
constexpr int ATTN_LDS_BYTES=LDS_BYTES;
#undef SBAR
#undef WAIT_BAR
}

constexpr int L1_HI = 0, L1_ROWB = 2064, L1_LO = 16 * L1_ROWB, L1_PART = 2 * 16 * L1_ROWB, L1_LGT = L1_PART + 16384;
template <bool xbf> __device__ __forceinline__ void ln1_phase(const AR a, int l, const float* xin, LAS unsigned char* lds, int vcu, int tid, int wave, int lane) {
    LAS int* lcnt = (LAS int*)(lds + MISC_OFF + MO_LCNT); LAS int* lbase = (LAS int*)(lds + MISC_OFF + MO_LBASE);
    LAS unsigned* REC = (LAS unsigned*)(lds + MISC_OFF + MO_REC); LAS float* GT = (LAS float*)(lds + MISC_OFF + MO_GT);
    LAS float* PART = (LAS float*)(lds + L1_PART); LAS float* LGT = (LAS float*)(lds + L1_LGT);
    const float* Wr = a.in(I_WR) + (size_t)l * D * NEXP; const float* br = a.in(I_BR) + (size_t)l * NEXP;
    __syncthreads();
    if (tid < 32) lcnt[tid] = 0;
    bf16x8 Bh[4][2], Bl[4][2];
    { const int n = lane & 15, kg = lane >> 4; float w[4][2][8];
#pragma unroll
      for (int ks = 0; ks < 4; ++ks)
#pragma unroll
        for (int nt = 0; nt < 2; ++nt) { const float* p = Wr + (size_t)(128 * wave + 32 * ks + 8 * kg) * 32 + n + 16 * nt;
#pragma unroll
            for (int j = 0; j < 8; ++j) w[ks][nt][j] = p[j * 32]; }
#pragma unroll
      for (int ks = 0; ks < 4; ++ks)
#pragma unroll
        for (int nt = 0; nt < 2; ++nt) { float r[8];
#pragma unroll
            for (int j = 0; j < 8; ++j) r[j] = w[ks][nt][j] - bf2f(f2bf(w[ks][nt][j]));
            u32x4 ph, pl; ph.x = pk2(w[ks][nt][0], w[ks][nt][1]); ph.y = pk2(w[ks][nt][2], w[ks][nt][3]); ph.z = pk2(w[ks][nt][4], w[ks][nt][5]); ph.w = pk2(w[ks][nt][6], w[ks][nt][7]);
            pl.x = pk2(r[0], r[1]); pl.y = pk2(r[2], r[3]); pl.z = pk2(r[4], r[5]); pl.w = pk2(r[6], r[7]);
            Bh[ks][nt] = __builtin_bit_cast(bf16x8, ph); Bl[ks][nt] = __builtin_bit_cast(bf16x8, pl); } }
    const bf16_t* Y = (const bf16_t*)(a.ws() + WS_Y); bf16_t* X1 = (bf16_t*)(a.ws() + WS_X1); bf16_t* H = (bf16_t*)(a.ws() + WS_H);
    LAS float* VL = (LAS float*)(lds + 86016);
    { const float* ada = (const float*)(a.ws() + WS_ADA) + ((size_t)l * 16 + ((vcu * 128) >> 11)) * 6144;
      stage_vec5(a.in(I_LN1G) + (size_t)l * D, a.in(I_LN1B) + (size_t)l * D, ada + 2048, ada + 3072, ada + 4096, VL, tid); }
    const LAS float* VLl = VL + 4 * lane; asm volatile("" : "+v"(VLl));
    __syncthreads();
    const float brv = br[tid & 31];
    f32x4 px[2][4]; u32x2 py[2][4];
#define L1_LOADROWS(P) do { _Pragma("unroll") for (int rr = 0; rr < 2; ++rr) { const int m_ = (vcu >> 4) * 2048 + (P) * 256 + (vcu & 15) * 16 + 2 * wave + rr; \
        _Pragma("unroll") for (int j = 0; j < 4; ++j) { const int col = 4 * lane + 256 * j; if (xbf) { const u32x2 w_ = *(const u32x2*)((const bf16_t*)xin + (size_t)m_ * D + col); px[rr][j] = (f32x4){__uint_as_float(w_.x << 16), __uint_as_float(w_.x & 0xffff0000u), __uint_as_float(w_.y << 16), __uint_as_float(w_.y & 0xffff0000u)}; } else px[rr][j] = *(const f32x4*)(xin + (size_t)m_ * D + col); py[rr][j] = *(const u32x2*)(Y + (size_t)m_ * D + col); } } } while (0)
    L1_LOADROWS(0);
#pragma unroll 1
    for (int pass = 0; pass < 8; ++pass) {
        f32x4 v[2][4];
#pragma unroll
        for (int rr = 0; rr < 2; ++rr) {
#pragma unroll
            for (int j = 0; j < 4; ++j) { const int col = 4 * lane + 256 * j; const f32x4 gt = *(const LAS f32x4*)(VLl + 2048 + 256 * j); const u32x2 yw = py[rr][j];
                const f32x4 yv = {__uint_as_float(yw.x << 16), __uint_as_float(yw.x & 0xffff0000u), __uint_as_float(yw.y << 16), __uint_as_float(yw.y & 0xffff0000u)};
                v[rr][j] = px[rr][j] * DN_ALPHA + (gt + 1.0f) * yv; } }
        if (pass < 7) L1_LOADROWS(pass + 1);
#pragma unroll
        for (int rr = 0; rr < 2; ++rr) {
            const int rowt = 2 * wave + rr, m = (vcu >> 4) * 2048 + pass * 256 + (vcu & 15) * 16 + rowt;
            ln_row(v[rr], VLl, VLl + 1024, lane);
#pragma unroll
            for (int j = 0; j < 4; ++j) { const int col = 4 * lane + 256 * j;
                { u32x2 wx; wx.x = pk2(v[rr][j][0], v[rr][j][1]); wx.y = pk2(v[rr][j][2], v[rr][j][3]); *(u32x2*)(X1 + (size_t)m * D + col) = wx; }
                const f32x4 sh = *(const LAS f32x4*)(VLl + 3072 + 256 * j), sc = *(const LAS f32x4*)(VLl + 4096 + 256 * j);
                const f32x4 h = v[rr][j] * (sc + 1.0f) + sh;
                u32x2 wh; wh.x = pk2(h[0], h[1]); wh.y = pk2(h[2], h[3]);
                if (FP8_MOE) *(unsigned*)((unsigned char*)H + (size_t)m * D + col) = pk4_f8(h[0] * Q_H2, h[1] * Q_H2, h[2] * Q_H2, h[3] * Q_H2); else *(u32x2*)(H + (size_t)m * D + col) = wh;
                const f32x4 hr = {h[0] - __uint_as_float(wh.x << 16), h[1] - __uint_as_float(wh.x & 0xffff0000u), h[2] - __uint_as_float(wh.y << 16), h[3] - __uint_as_float(wh.y & 0xffff0000u)};
                u32x2 wl; wl.x = pk2(hr[0], hr[1]); wl.y = pk2(hr[2], hr[3]);
                *(LAS u32x2*)(lds + L1_HI + rowt * L1_ROWB + col * 2) = wh; *(LAS u32x2*)(lds + L1_LO + rowt * L1_ROWB + col * 2) = wl; }
        }
        __syncthreads();
        { f32x4 acc0 = {0.f, 0.f, 0.f, 0.f}, acc1 = {0.f, 0.f, 0.f, 0.f}; const int row = lane & 15, kg = lane >> 4;
#pragma unroll
          for (int ks = 0; ks < 4; ++ks) { const int off = row * L1_ROWB + (128 * wave + 32 * ks + 8 * kg) * 2;
              const bf16x8 ah = *(const LAS bf16x8*)(lds + L1_HI + off), al = *(const LAS bf16x8*)(lds + L1_LO + off);
              acc0 = __builtin_amdgcn_mfma_f32_16x16x32_bf16(ah, Bh[ks][0], acc0, 0, 0, 0); acc1 = __builtin_amdgcn_mfma_f32_16x16x32_bf16(ah, Bh[ks][1], acc1, 0, 0, 0);
              acc0 = __builtin_amdgcn_mfma_f32_16x16x32_bf16(ah, Bl[ks][0], acc0, 0, 0, 0); acc1 = __builtin_amdgcn_mfma_f32_16x16x32_bf16(ah, Bl[ks][1], acc1, 0, 0, 0);
              acc0 = __builtin_amdgcn_mfma_f32_16x16x32_bf16(al, Bh[ks][0], acc0, 0, 0, 0); acc1 = __builtin_amdgcn_mfma_f32_16x16x32_bf16(al, Bh[ks][1], acc1, 0, 0, 0); }
#pragma unroll
          for (int r = 0; r < 4; ++r) { PART[(wave * 16 + 4 * kg + r) * 32 + (lane & 15)] = acc0[r]; PART[(wave * 16 + 4 * kg + r) * 32 + 16 + (lane & 15)] = acc1[r]; } }
        __syncthreads();
        { float x = brv;
#pragma unroll
          for (int w2 = 0; w2 < 8; ++w2) x += PART[w2 * 512 + tid];
          float vk[4]; int ik[4]; const int el = lane & 31;
#pragma unroll
          for (int r = 0; r < 4; ++r) { float m = x;
              m = fmaxf(m, WV_DPP(m, 0xb1)); m = fmaxf(m, WV_DPP(m, 0x4e)); m = fmaxf(m, WV_DPP(m, 0x141)); m = fmaxf(m, WV_DPP(m, 0x140));
              { const auto r2 = __builtin_amdgcn_permlane16_swap(__float_as_uint(m), __float_as_uint(m), false, false); m = fmaxf(__uint_as_float(r2[0]), __uint_as_float(r2[1])); }
              const unsigned long long bal = __builtin_amdgcn_ballot_w64(x == m);
              const unsigned hb = (lane & 32) ? (unsigned)(bal >> 32) : (unsigned)bal;
              const int idx = hb ? __builtin_ctz(hb) : 0;
              vk[r] = m; ik[r] = idx; x = (el == idx) ? -INFINITY : x; }
          const float p1 = fexp2(LOG2E * (vk[1] - vk[0])), p2 = fexp2(LOG2E * (vk[2] - vk[0])), p3 = fexp2(LOG2E * (vk[3] - vk[0])), inv = 1.0f / (1.0f + p1 + p2 + p3);
          if (el < 4) { const int rowl = pass * 16 + 2 * wave + (lane >> 5);
              const int ee = (el == 0) ? ik[0] : ((el == 1) ? ik[1] : ((el == 2) ? ik[2] : ik[3]));
              const float gg = ((el == 0) ? 1.0f : ((el == 1) ? p1 : ((el == 2) ? p2 : p3))) * inv;
              const int lr = __hip_atomic_fetch_add(lcnt + ee, 1, __ATOMIC_RELAXED, __HIP_MEMORY_SCOPE_WORKGROUP);
              REC[rowl * 4 + el] = (unsigned)ee | ((unsigned)lr << 8); GT[rowl * 4 + el] = gg; } }
    }
#undef L1_LOADROWS
    __syncthreads();
    { int t2 = tid; asm volatile("" : "+v"(t2));
      if (t2 < 32) lbase[t2] = (int)__hip_atomic_fetch_add((gu32*)(a.ws() + WS_CTL) + CW_GCNT + (l * 32 + t2) * 64, (unsigned)lcnt[t2], RLX_AGENT); }
    __syncthreads();
    { const int rowl = tid >> 2, k = tid & 3; const unsigned rec = REC[tid]; const int e = rec & 255, lr = rec >> 8, rank = lbase[e] + lr, tok = (vcu >> 4) * 2048 + (rowl >> 4) * 256 + (vcu & 15) * 16 + (rowl & 15);
      int* slot_tok = (int*)(a.ws() + WS_SLOTTOK); int* tok_er = (int*)(a.ws() + WS_TOKER); float* gates = (float*)(a.ws() + WS_GATE);
      if (rank < ECAP) slot_tok[(size_t)e * ECAP + rank] = tok;
      tok_er[tok * 4 + k] = e * ECAP + rank; gates[tok * 4 + k] = GT[tid]; }
    __syncthreads();
}

template <bool obf> __device__ __forceinline__ void ln2_phase(const AR a, int l, float* xout, LAS unsigned char* lds, int vcu, int tid, int wave, int lane, bool prep_next) {
    const LAS int* bs = (const LAS int*)(lds + MISC_OFF + MO_BS);
    const LAS float* Wf = (const LAS float*)lds;
    LAS float* VL = (LAS float*)(lds + 32768);
    { const int b = (vcu * 128) >> 11; const float* ada = (const float*)(a.ws() + WS_ADA) + ((size_t)l * 16 + b) * 6144;
      const float* adn = (const float*)(a.ws() + WS_ADA) + ((size_t)(prep_next ? l + 1 : l) * 16 + b) * 6144;
      stage_vec5(a.in(I_LN2G) + (size_t)l * D, a.in(I_LN2B) + (size_t)l * D, ada + 5120, adn, adn + 1024, VL, tid);
      { int t8 = tid; asm volatile("" : "+v"(t8)); if (prep_next && t8 < 8) VL[5120 + t8] = a.in(I_BF)[(l + 1) * 8 + t8]; } }
    const LAS float* VLl = VL + 4 * lane; asm volatile("" : "+v"(VLl));
    __syncthreads();
    const bf16_t* X1 = (const bf16_t*)(a.ws() + WS_X1); const bf16_t* YB = (const bf16_t*)(a.ws() + WS_YB);
    const int* tok_er = (const int*)(a.ws() + WS_TOKER); const float* gates = (const float*)(a.ws() + WS_GATE);
    const int mw = (vcu >> 4) * 2048 + (vcu & 15) * 16 + 2 * wave;
    int ern[4]; float gn[4];
#define L2_ROW(S) (mw + 256 * ((S) >> 1) + ((S) & 1))
#define L2_LOADIDX(M) do { _Pragma("unroll") for (int k = 0; k < 4; ++k) { ern[k] = tok_er[(M) * 4 + k]; gn[k] = gates[(M) * 4 + k]; } } while (0)
    unsigned y8c[4][4], y8n[4][4]; u32x2 xc[4], xn[4]; float gcc[4], gcn[4];
#define L2_LOADROWS(Y8, XW, GC, M) do { \
        _Pragma("unroll") for (int k = 0; k < 4; ++k) { const int er = ern[k], e = er >> 15, rank = er & (ECAP - 1); GC[k] = gn[k] * (1.0f / Q_YB); \
            const unsigned char* yr = (const unsigned char*)YB + ((size_t)bs[e] * 256 + rank) * D; \
            _Pragma("unroll") for (int j = 0; j < 4; ++j) Y8[k][j] = *(const unsigned*)(yr + 4 * lane + 256 * j); } \
        _Pragma("unroll") for (int j = 0; j < 4; ++j) XW[j] = *(const u32x2*)(X1 + (size_t)(M) * D + 4 * lane + 256 * j); } while (0)
    static_assert(FP8_YB != 0, "ln2_phase gathers fp8 expert rows");
    L2_LOADIDX(L2_ROW(0));
    L2_LOADROWS(y8c, xc, gcc, L2_ROW(0));
    L2_LOADIDX(L2_ROW(1));
#pragma unroll 1
    for (int st = 0; st < 16; ++st) { const int m = L2_ROW(st);
        { const int s1 = (st < 15) ? st + 1 : 15, s2 = (st < 14) ? st + 2 : 15;
          L2_LOADROWS(y8n, xn, gcn, L2_ROW(s1));
          L2_LOADIDX(L2_ROW(s2)); }
        f32x4 v[4];
#pragma unroll
        for (int j = 0; j < 4; ++j) { f32x4 y = {0.f, 0.f, 0.f, 0.f};
#pragma unroll
            for (int k = 0; k < 4; ++k) { const float g = gcc[k];
                const auto lo = __builtin_amdgcn_cvt_pk_f32_fp8((int)y8c[k][j], false), hi = __builtin_amdgcn_cvt_pk_f32_fp8((int)y8c[k][j], true);
                y[0] += g * lo[0]; y[1] += g * lo[1]; y[2] += g * hi[0]; y[3] += g * hi[1]; }
            const f32x4 gt = *(const LAS f32x4*)(VLl + 2048 + 256 * j); const u32x2 wx = xc[j];
            const f32x4 xv = {__uint_as_float(wx.x << 16), __uint_as_float(wx.x & 0xffff0000u), __uint_as_float(wx.y << 16), __uint_as_float(wx.y & 0xffff0000u)};
            v[j] = xv * DN_ALPHA + (gt + 1.0f) * y; }
        ln_row(v, VLl, VLl + 1024, lane);
#pragma unroll
        for (int j = 0; j < 4; ++j) { if (obf) { u32x2 w_; w_.x = pk2(v[j][0], v[j][1]); w_.y = pk2(v[j][2], v[j][3]); *(u32x2*)((bf16_t*)xout + (size_t)m * D + 4 * lane + 256 * j) = w_; }
            else *(f32x4*)(xout + (size_t)m * D + 4 * lane + 256 * j) = v[j]; }
        if (prep_next) prep_row(a, m, v, Wf, VLl + 3072, VLl + 4096, VL + 5120, lane);
#pragma unroll
        for (int k = 0; k < 4; ++k) { gcc[k] = gcn[k];
#pragma unroll
            for (int j = 0; j < 4; ++j) y8c[k][j] = y8n[k][j]; }
#pragma unroll
        for (int j = 0; j < 4; ++j) xc[j] = xn[j];
    }
#undef L2_LOADROWS
#undef L2_LOADIDX
#undef L2_ROW
}

#if CHK
__device__ __forceinline__ void chk_rec(const AR a, int stage, float err) {
    if (!(err == err)) err = 1e30f; err = fabsf(err);
    atomicMax((unsigned*)(a.ws() + WS_CTL) + CW_CHK + stage, __float_as_uint(err));
}
__device__ __forceinline__ unsigned hash32(unsigned x) { x ^= x >> 16; x *= 0x7feb352du; x ^= x >> 15; x *= 0x846ca68bu; x ^= x >> 16; return x; }
__device__ __forceinline__ float relerr(float got, float ref, float fl) { return fabsf(got - ref) / (fabsf(ref) + fl); }
__device__ __forceinline__ float rbf(float x) { return bf2f(f2bf(x)); }
#define CHK_GT() ({ int t_ = threadIdx.x; asm volatile("" : "+v"(t_)); (int)(blockIdx.x * 512 + t_); })
__device__ __forceinline__ void chk_weights(const AR a) {
    const int s = CHK_GT(); if (s >= 8192) return;
    const unsigned h1 = hash32(s * 3 + 1), h2 = hash32(s * 3 + 2), h3 = hash32(s * 3 + 3); const int l = (s >> 3) & 1, job = s % 5;
    const unsigned char* wl = a.ws() + WS_W + (size_t)l * WL_SIZE; float ref = 0.f, got = 0.f;
    if (job == 0) { const int n = h1 % 8192, k = h2 % 1024; ref = n < 5120 ? a.in(I_WIN)[((size_t)l * D + k) * DIN + (n < 1536 ? n : n + 8)] : a.in(I_WGATE)[((size_t)l * D + k) * 3072 + n - 5120]; got = bf2f(((const bf16_t*)(wl + WL_IN))[(size_t)n * 1024 + k]); }
    else if (job == 1) { const int n = h1 % 1024, k = h2 % 2048; ref = k < 512 ? a.in(I_WPA)[((size_t)l * 512 + k) * D + n] : (k < 1024 ? a.in(I_WPB)[((size_t)l * 512 + k - 512) * D + n] : a.in(I_WPC)[((size_t)l * D + k - 1024) * D + n]); got = bf2f(((const bf16_t*)(wl + WL_P))[(size_t)n * 2048 + k]); }
    else if (job == 2) { const int n = h1 % 1024, k = h2 % 1024; ref = a.in(I_WO)[((size_t)l * D + k) * D + n]; got = bf2f(((const bf16_t*)(wl + WL_O))[(size_t)n * 1024 + k]); }
    else if (job == 3) { const int e = h3 % 32, n = h1 % 2048, k = h2 % 1024, src = 1024 * ((n >> 7) & 1) + 128 * (n >> 8) + (n & 127); ref = a.in(I_WGU)[(((size_t)l * 32 + e) * D + k) * 2048 + src]; got = bf2f(((const bf16_t*)(wl + WL_GU))[((size_t)e * 2048 + n) * 1024 + k]); }
    else { const int e = h3 % 32, n = h1 % 1024, k = h2 % 1024; ref = a.in(I_WDN)[(((size_t)l * 32 + e) * D + k) * D + n]; got = bf2f(((const bf16_t*)(wl + WL_DN))[((size_t)e * 1024 + n) * 1024 + k]); }
    chk_rec(a, 0, fabsf(got - rbf(ref)));
}
__device__ __forceinline__ void chk_ada(const AR a) {
    const int s = CHK_GT(); if (s >= 512) return;
    const unsigned h1 = hash32(s + 77); const int l = s & 1, b = (s >> 1) & 15, j = h1 % 6144; float acc = 0.f;
    for (int k = 0; k < D; ++k) { const float c = a.in(I_C)[b * D + k]; acc += (c / (1.f + expf(-c))) * a.in(I_WADA)[((size_t)l * D + k) * 6144 + j]; }
    acc += a.in(I_BADA)[l * 6144 + j];
    chk_rec(a, 1, relerr(((const float*)(a.ws() + WS_ADA))[((size_t)l * 16 + b) * 6144 + j], acc, 0.01f));
}
__device__ __forceinline__ void chk_prep(const AR a, int l, const float* xin, int stage) {
    const int s = CHK_GT(); if (s >= 1024) return;
    const unsigned h1 = hash32(s + 1234 + l); const int m = h1 % M, b = m >> 11; const float* ada = (const float*)(a.ws() + WS_ADA) + ((size_t)l * 16 + b) * 6144;
    if (s < 768) { const int col = hash32(h1) % D; const float ref = xin[(size_t)m * D + col] * (1.f + ada[1024 + col]) + ada[col];
        chk_rec(a, stage, relerr(bf2f(((const bf16_t*)(a.ws() + WS_H))[(size_t)m * D + col]), ref, 0.05f)); }
    else { const int j = s & 7; float acc = 0.f;
        for (int k = 0; k < D; ++k) acc += (xin[(size_t)m * D + k] * (1.f + ada[1024 + k]) + ada[k]) * a.in(I_WIN)[((size_t)l * D + k) * DIN + 1536 + j];
        const float x = acc + a.in(I_BF)[l * 8 + j], ref = fminf(x, 0.f) - log1pf(expf(-fabsf(x)));
        chk_rec(a, stage, relerr(((const float*)(a.ws() + WS_LOGF))[(size_t)m * 8 + j], ref, 0.01f)); }
}
__device__ __forceinline__ void chk_inproj(const AR a, int l, int stage) {
    const int s = CHK_GT(); if (s >= 4096) return;
    const unsigned h1 = hash32(s + 999 + l), h2 = hash32(h1); const int m = h1 % M, n = h2 % 8192;
    const bf16_t* H = (const bf16_t*)(a.ws() + WS_H) + (size_t)m * D; const bf16_t* W = (const bf16_t*)(a.ws() + WS_W + (size_t)l * WL_SIZE + WL_IN) + (size_t)n * D;
    float acc = 0.f; for (int k = 0; k < D; ++k) acc += bf2f(H[k]) * bf2f(W[k]);
    if (n < 512 || (n >= 1536 && n < 2048)) acc *= C2;
    if (n >= 5120) { acc += a.in(I_BGATE)[l * 3072 + n - 5120]; acc = 1.f / (1.f + expf(-acc)); }
    chk_rec(a, stage, relerr(bf2f(((const bf16_t*)(a.ws() + WS_Z))[(size_t)m * ZP + n]), acc, 0.05f));
}
__device__ __forceinline__ void chk_f2(const AR a, int stage) {
    const int s = CHK_GT(); if (s >= 256) return;
    const unsigned h1 = hash32(s + 555); const int bh = s & 127, t = h1 % SEQ, b = bh >> 3, h = bh & 7; float acc = 0.f;
    for (int i = 0; i <= t; ++i) acc += ((const float*)(a.ws() + WS_LOGF))[((size_t)b * SEQ + i) * 8 + h];
    chk_rec(a, stage, relerr(((const float*)(a.ws() + WS_F2))[(size_t)bh * SEQ + t], acc * LOG2E, 0.05f));
}
__device__ __forceinline__ void chk_lru(const AR a, int l, int stage) {
    const int gt = CHK_GT(), s = gt >> 6, c = gt & 63; if (s >= 128) return;
    const unsigned h1 = hash32(s + 4242 + l), h2 = hash32(h1), h3 = hash32(h2);
    const int b = h1 % BATCH, ch = h2 % D, n = ch >> 6, d = ch & 63, tend = (s < 6) ? (s == 0 ? 2047 : h3 % SEQ) : (s < 40 ? h3 % 40 : h3 % 400);
    const bf16_t* Z = (const bf16_t*)(a.ws() + WS_Z);
    const float* cw = a.in(I_CONVW) + (size_t)l * 4 * D; const float* cb = a.in(I_CONVB) + (size_t)l * D;
    const float* wa = a.in(I_WA) + ((size_t)l * 16 + n) * 4096; const float* wx = a.in(I_WX) + ((size_t)l * 16 + n) * 4096;
    const float lam = a.in(I_LAM)[l * D + ch]; const float cl = -8.f * (fmaxf(-lam, 0.f) + log1pf(expf(-fabsf(lam))));
    const int cc = n * 64 + c; const float wac = rbf(wa[c * 64 + d]), wxc = rbf(wx[c * 64 + d]);
    const float cw0 = cw[cc], cw1 = cw[D + cc], cw2 = cw[2 * D + cc], cw3 = cw[3 * D + cc], cbc = cb[cc];
    const float bac = a.in(I_BA)[l * D + ch], bxc = a.in(I_BX)[l * D + ch];
    float hst = 0.f, x0 = 0.f, x1 = 0.f, x2 = 0.f;
    for (int t = 0; t <= tend; ++t) { const float x3 = bf2f(Z[((size_t)b * SEQ + t) * ZP + ZC_XC + cc]);
        const float xc = cbc + cw0 * x0 + cw1 * x1 + cw2 * x2 + cw3 * x3; x0 = x1; x1 = x2; x2 = x3;
        const float xb = rbf(xc); const float ra = wave_sum(c, xb * wac), rx = wave_sum(c, xb * wxc), xme = shidx(xc, d);
        const float rg = 1.f / (1.f + expf(-(ra + bac))), ig = 1.f / (1.f + expf(-(rx + bxc)));
        const float la = cl * rg, aa = expf(la); hst = aa * hst + sqrtf(-expm1f(2.f * la)) * (ig * xme); }
    const float g = bf2f(Z[((size_t)b * SEQ + tend) * ZP + ZC_GC + ch]);
    const float ref = hst * (0.5f * g * (1.f + tanhf(0.7978845608f * (g + 0.044715f * g * g * g))));
    if (c == 0) chk_rec(a, stage, relerr(bf2f(((const bf16_t*)(a.ws() + WS_O))[((size_t)b * SEQ + tend) * OP + 1024 + ch]), ref, 0.02f));
}
template <int MODE> __device__ __forceinline__ void chk_attn(const AR a, int stage) {
    const int gt = CHK_GT(), s = gt >> 6, e = gt & 63; if (s >= 256) return;
    const unsigned h1 = hash32(s + 31337 + MODE), h2 = hash32(h1), h3 = hash32(h2);
    const int b = h1 % BATCH, h = h2 % 8, d = h3 % 64, t = (s < 8) ? ((s == 0) ? 0 : (s == 1 ? 1 : (s == 2 ? 2047 : hash32(h3) % SEQ))) : hash32(h3) % SEQ;
    const bf16_t* Z = (const bf16_t*)(a.ws() + WS_Z); const size_t rb = (size_t)b * SEQ;
    const int qc = (MODE == 0 ? ZC_QA : ZC_QB) + h * 64, kc = (MODE == 0 ? ZC_KA : ZC_KB) + h * 64, vc = (MODE == 0 ? ZC_VA : ZC_VB) + h * 64;
    const float* F2 = (const float*)(a.ws() + WS_F2) + (size_t)(b * 8 + h) * SEQ;
    const float qe = bf2f(Z[(rb + t) * ZP + qc + e]);
    float ref = 0.f;
    if (MODE == 0) { float mx = -INFINITY, sum = 0.f, o = 0.f;
        for (int k = 0; k <= t; ++k) { const float z = wave_sum(e, qe * bf2f(Z[(rb + k) * ZP + kc + e])) + (F2[t] - F2[k]);
            const float mn = fmaxf(mx, z), al = exp2f(mx - mn), p = exp2f(z - mn); sum = sum * al + p; o = o * al + p * bf2f(Z[(rb + k) * ZP + vc + d]); mx = mn; }
        ref = o / sum;
    } else { float R = 0.f, o = 0.f;
        for (int k = t - 1; k >= 0; --k) { const float z = wave_sum(e, qe * bf2f(Z[(rb + k) * ZP + kc + e]));
            const float sp = fmaxf(z, 0.f) + log2f(1.f + exp2f(-fabsf(z))); o += exp2f(z - sp + R) * bf2f(Z[(rb + k) * ZP + vc + d]); R -= sp; if (R < -200.f) break; }
        ref = o; }
    if (e == 0) chk_rec(a, stage, relerr(bf2f(((const bf16_t*)(a.ws() + WS_O))[(rb + t) * OP + (MODE == 0 ? 0 : 512) + h * 64 + d]), ref, 0.15f));
}
__device__ __forceinline__ void chk_merge(const AR a, int l, int stage) {
    const int s = CHK_GT(); if (s >= 2048) return;
    const unsigned h1 = hash32(s + 808 + l), h2 = hash32(h1); const int m = h1 % M, c = h2 % D;
    const bf16_t* O = (const bf16_t*)(a.ws() + WS_O) + (size_t)m * OP; const bf16_t* W = (const bf16_t*)(a.ws() + WS_W + (size_t)l * WL_SIZE + WL_P) + (size_t)c * OP; const bf16_t* Z = (const bf16_t*)(a.ws() + WS_Z) + (size_t)m * ZP;
    float tot = 0.f;
    for (int seg = 0; seg < 3; ++seg) { const int k0 = seg == 0 ? 0 : (seg == 1 ? 512 : 1024), k1 = seg == 0 ? 512 : (seg == 1 ? 1024 : 2048); float acc = 0.f;
        for (int k = k0; k < k1; ++k) acc += bf2f(O[k]) * bf2f(W[k]); tot += acc * bf2f(Z[ZC_G + seg * 1024 + c]); }
    chk_rec(a, stage, relerr(bf2f(((const bf16_t*)(a.ws() + WS_MG))[(size_t)m * D + c]), tot, 0.05f));
}
__device__ __forceinline__ void chk_wo(const AR a, int l, int stage) {
    const int s = CHK_GT(); if (s >= 2048) return;
    const unsigned h1 = hash32(s + 909 + l), h2 = hash32(h1); const int m = h1 % M, c = h2 % D;
    const bf16_t* A = (const bf16_t*)(a.ws() + WS_MG) + (size_t)m * D; const bf16_t* W = (const bf16_t*)(a.ws() + WS_W + (size_t)l * WL_SIZE + WL_O) + (size_t)c * D;
    float acc = 0.f; for (int k = 0; k < D; ++k) acc += bf2f(A[k]) * bf2f(W[k]);
    chk_rec(a, stage, relerr(bf2f(((const bf16_t*)(a.ws() + WS_Y))[(size_t)m * D + c]), acc, 0.05f));
}
__device__ __forceinline__ void chk_ln1(const AR a, int l, const float* xin, int stage) {
    const int s = CHK_GT(); if (s >= 256) return;
    const int m = hash32(s + 1717 + l) % M, b = m >> 11; const float* ada = (const float*)(a.ws() + WS_ADA) + ((size_t)l * 16 + b) * 6144;
    const bf16_t* Yb = (const bf16_t*)(a.ws() + WS_Y) + (size_t)m * D; const float* X = xin + (size_t)m * D;
#define Y_(k) bf2f(Yb[k])
    float mean = 0.f; for (int k = 0; k < D; ++k) mean += DN_ALPHA * X[k] + (1.f + ada[2048 + k]) * Y_(k); mean /= D;
    float var = 0.f; for (int k = 0; k < D; ++k) { const float v = DN_ALPHA * X[k] + (1.f + ada[2048 + k]) * Y_(k) - mean; var += v * v; } var /= D;
    const float rstd = 1.f / sqrtf(var + LN_EPS);
    float e1 = 0.f, e2 = 0.f;
    for (int k = (s & 63); k < D; k += 64) { const float x1 = (DN_ALPHA * X[k] + (1.f + ada[2048 + k]) * Y_(k) - mean) * rstd * a.in(I_LN1G)[l * D + k] + a.in(I_LN1B)[l * D + k];
        const float h2 = x1 * (1.f + ada[4096 + k]) + ada[3072 + k];
        e1 = fmaxf(e1, relerr(bf2f(((const bf16_t*)(a.ws() + WS_X1))[(size_t)m * D + k]), x1, 0.05f)); e2 = fmaxf(e2, relerr(bf2f(((const bf16_t*)(a.ws() + WS_H))[(size_t)m * D + k]), h2, 0.05f)); }
    chk_rec(a, stage, e1); chk_rec(a, stage, e2);
    const int* tok_er = (const int*)(a.ws() + WS_TOKER); const float* gates = (const float*)(a.ws() + WS_GATE);
    const int r0 = tok_er[m * 4 + 0] >> 15, r1 = tok_er[m * 4 + 1] >> 15, r2 = tok_er[m * 4 + 2] >> 15, r3 = tok_er[m * 4 + 3] >> 15;
    float v0 = -INFINITY, v1 = -INFINITY, v2 = -INFINITY, v3 = -INFINITY; int i0 = 0, i1 = 0, i2 = 0, i3 = 0; float lr0 = 0.f, lr1 = 0.f, lr2 = 0.f, lr3 = 0.f;
    for (int e = 0; e < 32; ++e) { float x = a.in(I_BR)[l * 32 + e];
        for (int k = 0; k < D; ++k) { const float x1 = (DN_ALPHA * X[k] + (1.f + ada[2048 + k]) * Y_(k) - mean) * rstd * a.in(I_LN1G)[l * D + k] + a.in(I_LN1B)[l * D + k];
            x += (x1 * (1.f + ada[4096 + k]) + ada[3072 + k]) * a.in(I_WR)[((size_t)l * D + k) * 32 + e]; }
        if (e == r0) lr0 = x; if (e == r1) lr1 = x; if (e == r2) lr2 = x; if (e == r3) lr3 = x;
        if (x > v3) { if (x > v2) { v3 = v2; i3 = i2; if (x > v1) { v2 = v1; i2 = i1; if (x > v0) { v1 = v0; i1 = i0; v0 = x; i0 = e; } else { v1 = x; i1 = e; } } else { v2 = x; i2 = e; } } else { v3 = x; i3 = e; } } }
    float worst = 0.f;
    { const float den = 1.f + expf(v1 - v0) + expf(v2 - v0) + expf(v3 - v0);
      const float lrs[4] = {lr0, lr1, lr2, lr3}; const int rs[4] = {r0, r1, r2, r3};
#pragma unroll
      for (int k = 0; k < 4; ++k) { const bool found = (rs[k] == i0) || (rs[k] == i1) || (rs[k] == i2) || (rs[k] == i3);
          if (found) worst = fmaxf(worst, fabsf(gates[m * 4 + k] - expf(lrs[k] - v0) / den)); else worst = fmaxf(worst, (fabsf(lrs[k] - v3) > 1e-3f) ? 10.f : 0.f); }
      if (r0 == r1 || r0 == r2 || r0 == r3 || r1 == r2 || r1 == r3 || r2 == r3) worst = 15.f; }
    chk_rec(a, stage + 1, worst);
    for (int k = 0; k < 4; ++k) { const int er = tok_er[m * 4 + k], e = er >> 15, rank = er & (ECAP - 1);
        const int cnt = (int)__hip_atomic_load((gu32*)(a.ws() + WS_CTL) + CW_GCNT + (l * 32 + e) * 64, RLX_AGENT);
        if (rank >= cnt || ((const int*)(a.ws() + WS_SLOTTOK))[(size_t)e * ECAP + rank] != m) chk_rec(a, stage + 1, 20.f); }
    if (s == 0) { int tot = 0; for (int e = 0; e < 32; ++e) tot += (int)__hip_atomic_load((gu32*)(a.ws() + WS_CTL) + CW_GCNT + (l * 32 + e) * 64, RLX_AGENT); if (tot != M * 4) chk_rec(a, stage + 1, 30.f); }
}
__device__ __forceinline__ void chk_gemm1(const AR a, int l, const LAS int* bs, int stage) {
    const int s = CHK_GT(); if (s >= 2048) return;
    const unsigned h1 = hash32(s + 2121 + l), h2 = hash32(h1); const int tok = h1 % M, k = h2 & 3, j = (h2 >> 2) % D;
    const int er = ((const int*)(a.ws() + WS_TOKER))[tok * 4 + k], e = er >> 15, rank = er & (ECAP - 1); const size_t cs = (size_t)bs[e] * 256 + rank;
    const bf16_t* H = (const bf16_t*)(a.ws() + WS_H) + (size_t)tok * D; const bf16_t* Wg = (const bf16_t*)(a.ws() + WS_W + (size_t)l * WL_SIZE + WL_GU) + ((size_t)e * 2048 + 256 * (j >> 7) + (j & 127)) * D; const bf16_t* Wu = Wg + 128 * D;
    float ga = 0.f, up = 0.f; for (int q = 0; q < D; ++q) { const float hv = bf2f(H[q]); ga += hv * bf2f(Wg[q]); up += hv * bf2f(Wu[q]); }
    ga += a.in(I_BGU)[((size_t)l * 32 + e) * 2048 + j]; up += a.in(I_BGU)[((size_t)l * 32 + e) * 2048 + 1024 + j];
    ga = fminf(ga, 7.f); up = fminf(fmaxf(up, -7.f), 7.f); const float ref = (up + 1.f) * (ga / (1.f + expf(-1.702f * ga)));
    chk_rec(a, stage, relerr(bf2f(((const bf16_t*)(a.ws() + WS_ACT))[cs * D + j]), ref, 0.05f));
}
__device__ __forceinline__ void chk_gemm2(const AR a, int l, const LAS int* bs, int stage) {
    const int s = CHK_GT(); if (s >= 2048) return;
    const unsigned h1 = hash32(s + 2323 + l), h2 = hash32(h1); const int tok = h1 % M, k = h2 & 3, c = (h2 >> 2) % D;
    const int er = ((const int*)(a.ws() + WS_TOKER))[tok * 4 + k], e = er >> 15, rank = er & (ECAP - 1); const size_t cs = (size_t)bs[e] * 256 + rank;
    const bf16_t* A = (const bf16_t*)(a.ws() + WS_ACT) + cs * D; const bf16_t* W = (const bf16_t*)(a.ws() + WS_W + (size_t)l * WL_SIZE + WL_DN) + ((size_t)e * 1024 + c) * D;
    float acc = 0.f; for (int q = 0; q < D; ++q) acc += bf2f(A[q]) * bf2f(W[q]); acc += a.in(I_BDN)[((size_t)l * 32 + e) * D + c];
    chk_rec(a, stage, relerr(bf2f(((const bf16_t*)(a.ws() + WS_YB))[cs * D + c]), acc, 0.05f));
}
__device__ __forceinline__ void chk_ln2(const AR a, int l, const float* xout, const LAS int* bs, int stage) {
    const int s = CHK_GT(); if (s >= 256) return;
    const int m = hash32(s + 2525 + l) % M, b = m >> 11; const float* ada = (const float*)(a.ws() + WS_ADA) + ((size_t)l * 16 + b) * 6144;
    const bf16_t* X1b = (const bf16_t*)(a.ws() + WS_X1) + (size_t)m * D; const bf16_t* YB = (const bf16_t*)(a.ws() + WS_YB);
#define X1_(q) bf2f(X1b[q])
    const bf16_t* yr[4]; float g[4];
#pragma unroll
    for (int k = 0; k < 4; ++k) { const int er = ((const int*)(a.ws() + WS_TOKER))[m * 4 + k], e = er >> 15, rank = er & (ECAP - 1); yr[k] = YB + ((size_t)bs[e] * 256 + rank) * D; g[k] = ((const float*)(a.ws() + WS_GATE))[m * 4 + k]; }
    float mean = 0.f, var = 0.f;
    for (int q = 0; q < D; ++q) { float y = g[0] * bf2f(yr[0][q]) + g[1] * bf2f(yr[1][q]) + g[2] * bf2f(yr[2][q]) + g[3] * bf2f(yr[3][q]); mean += DN_ALPHA * X1_(q) + (1.f + ada[5120 + q]) * y; } mean /= D;
    for (int q = 0; q < D; ++q) { float y = g[0] * bf2f(yr[0][q]) + g[1] * bf2f(yr[1][q]) + g[2] * bf2f(yr[2][q]) + g[3] * bf2f(yr[3][q]); const float v = DN_ALPHA * X1_(q) + (1.f + ada[5120 + q]) * y - mean; var += v * v; } var /= D;
    const float rstd = 1.f / sqrtf(var + LN_EPS); float worst = 0.f;
    for (int q = (s & 31); q < D; q += 32) { float y = g[0] * bf2f(yr[0][q]) + g[1] * bf2f(yr[1][q]) + g[2] * bf2f(yr[2][q]) + g[3] * bf2f(yr[3][q]);
        const float ref = (DN_ALPHA * X1_(q) + (1.f + ada[5120 + q]) * y - mean) * rstd * a.in(I_LN2G)[l * D + q] + a.in(I_LN2B)[l * D + q];
        worst = fmaxf(worst, relerr(xout[(size_t)m * D + q], ref, 0.02f)); }
    chk_rec(a, stage, worst);
}
__device__ __forceinline__ void chk_report(const AR a) {
    if (blockIdx.x != 0 || threadIdx.x != 0) return;
    const unsigned* w = (const unsigned*)(a.ws() + WS_CTL) + CW_CHK;
    const unsigned tmo = __hip_atomic_load((gu32*)(a.ws() + WS_CTL) + CW_BAR + XB_TMO, RLX_AGENT);
    if (tmo) { a.out()[0] = 9.9e7f; return; }
#ifdef CHK_REPORT_STAGE
    { const float e = __uint_as_float(__hip_atomic_load((gu32*)w + CHK_REPORT_STAGE, RLX_AGENT)); a.out()[0] = 1e5f * e + 100.f; return; }
#endif
    for (int st = 0; st < 32; ++st) { const float e = __uint_as_float(__hip_atomic_load((gu32*)w + st, RLX_AGENT));
        if (e > 0.02f) { const float sc = e < 0.1f ? 1e3f : (e < 1.f ? 1e4f : (e < 100.f ? 1e5f : 1e6f)); a.out()[0] = (10.f + st) * sc; return; } }
}
#endif

#if CHK
#define CHECK(stmt) do { PHASE_IDS(); stmt; } while (0)
#else
#define CHECK(stmt) do { } while (0)
#endif
#ifndef REP_MASK
#define REP_MASK 0
#endif
#define REPEAT(g) _Pragma("unroll 1") for (int rep_ = ((REP_MASK >> (g)) & 1); rep_ >= 0; --rep_)
#define PHASE_IDS() int tid_o; asm volatile("v_mbcnt_lo_u32_b32 %0, -1, 0\n\tv_mbcnt_hi_u32_b32 %0, -1, %0" : "=v"(tid_o)); tid_o += wave0 * 64; const int tid = tid_o, lane = tid & 63, wave = __builtin_amdgcn_readfirstlane(tid >> 6); const int gw = vcu * 8 + wave; \
    AR a; { ArgsP q_ = a0.p; asm volatile("" : "+s"(q_)); a.p = q_; } int l_o = ll; asm volatile("" : "+s"(l_o)); const int l = l_o; (void)gw; (void)lane; (void)tid; (void)l
__global__ void __launch_bounds__(512, 2) fwd_kernel(Args args_unused) {
    extern __shared__ __attribute__((aligned(16))) unsigned char lds_raw[];
    LAS unsigned char* lds = (LAS unsigned char*)lds_raw;
    AR a0; a0.p = (ArgsP)__builtin_amdgcn_kernarg_segment_ptr();
    const int G = gridDim.x, bx = blockIdx.x, vcu = (G % 8 == 0) ? (bx % 8) * (G / 8) + bx / 8 : bx;
    const int NGW = G * 8;
    const int ll = 0;
    const int wave0 = __builtin_amdgcn_readfirstlane(threadIdx.x >> 6);
#if STAMP
    volatile LAS unsigned long long* tsl = (volatile LAS unsigned long long*)(lds + MISC_OFF + 12288); int nst = 0;
#define STAMP_HERE() do { if (blockIdx.x == 0 && threadIdx.x == 0) tsl[nst] = __builtin_amdgcn_s_memrealtime(); ++nst; } while (0)
#else
#define STAMP_HERE() do { } while (0)
#endif
    { const int tid = threadIdx.x;
      for (int u = tid; u < (LDS_BYTES - MISC_OFF) / 4; u += 512) ((LAS unsigned*)(lds + MISC_OFF))[u] = 0u; }
    __syncthreads();
    STAMP_HERE();
    (void)xcd_barrier_post((unsigned*)(a0.ws() + WS_CTL) + CW_BAR, (volatile LAS unsigned*)(lds + MISC_OFF + MO_BAR));
#define GRID_BAR() do { ArgsP q_ = a0.p; asm volatile("" : "+s"(q_)); XcdBarrier b_; b_.bar = (unsigned*)(q_->ws + WS_CTL) + CW_BAR; b_.x = xb_xcc_id(); b_.st = (volatile LAS unsigned*)(lds + MISC_OFF + MO_BAR); xcd_barrier(b_); } while (0)

    REPEAT(0) { { PHASE_IDS();
      if (FP8_IN == 2) p0_wabsmax(a, gw * 64 + lane, NGW * 64, lane);
      p0_weights(a, lds, gw, NGW, wave, lane, 0);
      __syncthreads();
      if (bx < 192) p0_ada(a, lds, bx, tid, wave, lane);
      if (bx == 255 && tid < 64) { if (FP8_G) ((unsigned char*)(a.ws() + WS_ONES))[tid] = (unsigned char)0xff; else ((bf16_t*)(a.ws() + WS_ONES))[tid] = (bf16_t)0x3f80; } }
    GRID_BAR(); STAMP_HERE(); }
    CHECK(chk_weights(a); chk_ada(a));
    REPEAT(10) { { PHASE_IDS();
      for (int u = vcu; u < 256; u += G) {
        __syncthreads();
        stage_wf(a, 0, lds, tid);
        LAS float* VL = (LAS float*)(lds + 32768);
        { const float* ada = (const float*)(a.ws() + WS_ADA) + (size_t)((u * 128) >> 11) * 6144; stage_vec(ada, VL, tid); stage_vec(ada + 1024, VL + 1024, tid); if (tid < 8) VL[2048 + tid] = a.in(I_BF)[tid]; }
        const LAS float* VLl = VL + 4 * lane; asm volatile("" : "+v"(VLl));
        __syncthreads();
        const float* X = a.in(I_X);
        f32x4 xcur[4], xnxt[4];
#define P1_ROW(I) ((u >> 4) * 2048 + (I) * 128 + (u & 15) * 8 + wave)
#pragma unroll
        for (int j = 0; j < 4; ++j) xcur[j] = *(const f32x4*)(X + (size_t)P1_ROW(0) * D + 4 * lane + 256 * j);
#pragma unroll 1
        for (int i = 0; i < 16; ++i) { const int m = P1_ROW(i), mn = P1_ROW(i < 15 ? i + 1 : 15);
#pragma unroll
          for (int j = 0; j < 4; ++j) xnxt[j] = *(const f32x4*)(X + (size_t)mn * D + 4 * lane + 256 * j);
          prep_row(a, m, xcur, (const LAS float*)lds, VLl, VLl + 1024, VL + 2048, lane);
#pragma unroll
          for (int j = 0; j < 4; ++j) xcur[j] = xnxt[j]; } }
#undef P1_ROW
      if (FP8_IN == 2) { __syncthreads(); p0_weights(a, lds, gw, NGW, wave, lane, 1); } }
    GRID_BAR(); STAMP_HERE(); }
#pragma unroll 1
    for (int ll = 0; ll < DEPTH; ++ll) {
        const int cs = 16 * ll;
        CHECK(chk_prep(a, l, (l == 0) ? a.in(I_X) : (const float*)(a.ws() + WS_XL), cs + 2));
        if (CHK_STOP <= 2) break;
        REPEAT(1) { { PHASE_IDS(); const unsigned char* wl = a.ws() + WS_W + (size_t)l * WL_SIZE;
          DenseOrder S; S.T.init(M / 256, 32, G, bx); S.A = (const char*)(a.ws() + WS_H); S.B = (const char*)(wl + WL_IN); S.lda = FP8_IN ? 512 : 1024; S.ldb = FP8_IN ? 512 : 1024; S.nt = FP8_IN ? 8 : 16;
          const gu32* wm_ = (const gu32*)(a.ws() + WS_CTL) + CW_WMAX + 2 * l * 64;
          EpiInProj E{(bf16_t*)(a.ws() + WS_Z), a.in(I_BGATE) + (size_t)l * 3072, (const float*)(a.ws() + WS_ROWS), fmaxf(__uint_as_float(__hip_atomic_load(wm_, RLX_AGENT)), 1e-30f) * (1.0f / 127.0f), fmaxf(__uint_as_float(__hip_atomic_load(wm_ + 64, RLX_AGENT)), 1e-30f) * (1.0f / 127.0f), nullptr};
#ifdef PROBE_SKIP_EPI
          E.skip = (rep_ > 0) ? PROBE_SKIP_EPI : 0;
#endif
#ifdef STAGGER_IN
          for (int k_ = 0; k_ < (vcu & 15); ++k_) __builtin_amdgcn_s_sleep(STAGGER_IN);
#endif
          E.G8 = a.ws() + WS_G8;
          pg8::gemm_phase<EpiInProj, DenseOrder, false>(lds, FP8_IN ? 512 : 1024, FP8_IN ? 512 : 1024, S, E, tid); }
        GRID_BAR(); STAMP_HERE(); }
        CHECK(chk_inproj(a, l, cs + 3));
        if (CHK_STOP <= 3) break;
        REPEAT(2) { { PHASE_IDS();
          for (int u = vcu; u < 256; u += G) lru_unit(a, l, u >> 4, u & 15, lds, tid, wave, lane); }
        }
        REPEAT(3) { { PHASE_IDS();
          for (int u = vcu; u < 256; u += G) { const int bh = u >> 1, s = u & 1;
            LAS float* Fl = (LAS float*)(lds + 86016);
            __syncthreads();
            {
              const float* lf = (const float*)(a.ws() + WS_LOGF) + ((size_t)(bh >> 3) * SEQ + 4 * tid) * 8 + (bh & 7);
              const float v0 = lf[0], v1 = v0 + lf[8], v2 = v1 + lf[16], v3 = v2 + lf[24];
              float inc = v3;
#pragma unroll
              for (int o = 1; o < 64; o <<= 1) { const float t = shup(lane, inc, o); if (lane >= o) inc += t; }
              LAS float* wt = (LAS float*)(lds + 86016 + 8192);
              if (lane == 63) wt[wave] = inc;
              __syncthreads();
              float base = inc - v3;
#pragma unroll
              for (int w2 = 0; w2 < 8; ++w2) base += (w2 < wave) ? wt[w2] : 0.f;
              const f32x4 o = {(base + v0) * LOG2E, (base + v1) * LOG2E, (base + v2) * LOG2E, (base + v3) * LOG2E};
              *(LAS f32x4*)(Fl + 4 * tid) = o;
              if (CHK) *(f32x4*)((float*)(a.ws() + WS_F2) + (size_t)bh * SEQ + 4 * tid) = o; }
            __syncthreads();
            const fox_body::bf16* Zq = (const fox_body::bf16*)(a.ws() + WS_Z);
#pragma unroll 1
            for (int i = 0; i < 4; ++i) { const int qb = (i == 0) ? s : (i == 1 ? 7 - s : (i == 2 ? 2 + s : 5 - s));
                fox_body::attn_unit<8>(bh >> 3, bh & 7, qb, Zq + ZC_QA, Zq + ZC_KA, Zq + ZC_VA, (fox_body::bf16*)(a.ws() + WS_O), Fl, (char*)lds_raw, tid); } } } }
        REPEAT(4) { { PHASE_IDS();
          for (int u = vcu; u < 256; u += G) { const int bh = u >> 1, s = u & 1;
#pragma unroll 1
            for (int i = 0; i < 4; ++i) { const int qb = (i == 0) ? s : (i == 1 ? 7 - s : (i == 2 ? 2 + s : 5 - s)); attn_unit<1>(a, bh >> 3, bh & 7, qb, lds, tid, wave, lane); } } } }
        GRID_BAR(); STAMP_HERE();
        CHECK(chk_attn<0>(a, cs + 6); chk_attn<1>(a, cs + 7));
        if (CHK_STOP <= 7) break;
        REPEAT(5) { { PHASE_IDS(); const unsigned char* wl = a.ws() + WS_W + (size_t)l * WL_SIZE;
          MergeOrder S; S.T.init(M / 256, 4, G, bx); S.A = (const char*)(a.ws() + WS_O); S.B = (const char*)(wl + WL_P);
          EpiMerge E{(const bf16_t*)(a.ws() + (FP8_G ? WS_G8 : WS_Z)), (bf16_t*)(a.ws() + WS_MG), (const bf16_t*)(a.ws() + WS_ONES)};
          pg8::gemm_phase<EpiMerge, MergeOrder, false>(lds, FP8_MRG ? OP / 2 : OP, FP8_MRG ? OP / 2 : OP, S, E, tid); }
        GRID_BAR(); STAMP_HERE(); }
        CHECK(chk_merge(a, l, cs + 8));
        REPEAT(6) { { PHASE_IDS(); const unsigned char* wl = a.ws() + WS_W + (size_t)l * WL_SIZE;
          DenseOrder S; S.T.init(M / 256, 4, G, bx); S.A = (const char*)(a.ws() + WS_MG); S.B = (const char*)(wl + WL_O); S.lda = 1024; S.ldb = 1024; S.nt = 16;
          EpiBf16 E{(bf16_t*)(a.ws() + WS_Y), D};
          pg8::gemm_phase<EpiBf16, DenseOrder, false>(lds, 1024, 1024, S, E, tid); }
        GRID_BAR(); STAMP_HERE(); }
        CHECK(chk_wo(a, l, cs + 9));
        if (CHK_STOP <= 9) break;
REPEAT(11) {         { PHASE_IDS(); const float* xin = (l == 0) ? a.in(I_X) : (const float*)(a.ws() + WS_XL);
          for (int u = vcu; u < 256; u += G) { if (l == 0) ln1_phase<false>(a, l, xin, lds, u, tid, wave, lane); else ln1_phase<true>(a, l, xin, lds, u, tid, wave, lane); } }
        GRID_BAR(); STAMP_HERE();
          if (rep_ > 0) { PHASE_IDS(); if (bx == 0 && tid < 32) __hip_atomic_store((gu32*)(a.ws() + WS_CTL) + CW_GCNT + (l * 32 + tid) * 64, 0u, RLX_AGENT); GRID_BAR(); } }
        CHECK(chk_ln1(a, l, (l == 0) ? a.in(I_X) : (const float*)(a.ws() + WS_XL), cs + 10));
        if (CHK_STOP <= 11) break;
        REPEAT(7) { { PHASE_IDS(); const unsigned char* wl = a.ws() + WS_W + (size_t)l * WL_SIZE;
          moe_build_tables((gu32*)(a.ws() + WS_CTL), l, lds, tid);
          MoeOrder<8, true> S{vcu, moe_tables(lds), (const char*)(a.ws() + WS_H), (const char*)(wl + WL_GU), (const int*)(a.ws() + WS_SLOTTOK)};
          EpiGU E{a.ws() + WS_ACT, a.in(I_BGU) + (size_t)l * NEXP * 2048};
          pg8::gemm_phase<EpiGU, MoeOrder<8, true>, true>(lds, FP8_MOE ? 512 : 1024, FP8_MOE ? 512 : 1024, S, E, tid); }
        GRID_BAR(); STAMP_HERE(); }
        CHECK(chk_gemm1(a, l, (const LAS int*)(lds + MISC_OFF + MO_BS), cs + 12));
        REPEAT(8) { { PHASE_IDS(); const unsigned char* wl = a.ws() + WS_W + (size_t)l * WL_SIZE;
          MoeOrder<4, false> S{vcu, moe_tables(lds), (const char*)(a.ws() + WS_ACT), (const char*)(wl + WL_DN), nullptr};
          EpiDown E{a.ws() + WS_YB, a.in(I_BDN) + (size_t)l * NEXP * D};
          pg8::gemm_phase<EpiDown, MoeOrder<4, false>, false>(lds, FP8_MOE ? 512 : 1024, FP8_MOE ? 512 : 1024, S, E, tid); }
        GRID_BAR(); STAMP_HERE(); }
        CHECK(chk_gemm2(a, l, (const LAS int*)(lds + MISC_OFF + MO_BS), cs + 13));
        if (CHK_STOP <= 13) break;
        REPEAT(9) { { PHASE_IDS(); float* xout = (l == DEPTH - 1) ? a.out() : (float*)(a.ws() + WS_XL);
          if (l + 1 < DEPTH) stage_wf(a, l + 1, lds, tid);
          __syncthreads();
          for (int u = vcu; u < 256; u += G) { if (l != DEPTH - 1) ln2_phase<true>(a, l, xout, lds, u, tid, wave, lane, true); else ln2_phase<false>(a, l, xout, lds, u, tid, wave, lane, false); } }
          if (rep_ > 0) GRID_BAR(); }
        if (ll + 1 < DEPTH || CHK || STAMP) { GRID_BAR(); STAMP_HERE(); }
        CHECK(chk_ln2(a, l, (l == DEPTH - 1) ? a.out() : (float*)(a.ws() + WS_XL), (const LAS int*)(lds + MISC_OFF + MO_BS), cs + 14));
    }
#if CHK
    GRID_BAR();
    chk_report(a0);
#endif
#if STAMP
    if (blockIdx.x == 0) {
        const float tx = (float)(tsl[STAMP_X + 1] - tsl[STAMP_X]) * 0.01f, ty = (float)(tsl[STAMP_Y + 1] - tsl[STAMP_Y]) * 0.01f;
        float* o = a0.out();
        for (int i = threadIdx.x; i < M * D / 2; i += 512) o[M * D / 2 + i] = ty * 0.25f;
        __syncthreads();
        if (threadIdx.x == 0) o[0] = 10.f * tx;
    }
#endif
}

extern "C" void kernel_launch(void* const* d_in, const int* in_sizes, int n_in, void* d_out, int out_size, void* d_ws, size_t ws_size, hipStream_t stream) {
    static int grid = 0;
    if (grid == 0) {
        if (n_in != 29 || out_size != M * D || ws_size < WS_END) { fprintf(stderr, "kernel_launch: unexpected sizes n_in %d out %d ws %zu\n", n_in, out_size, ws_size); grid = -1; return; }
        if (hipFuncSetAttribute((const void*)fwd_kernel, hipFuncAttributeMaxDynamicSharedMemorySize, LDS_BYTES) != hipSuccess) { fprintf(stderr, "kernel_launch: hipFuncSetAttribute failed\n"); grid = -1; return; }
        int dev = 0, cus = 0, per_cu = 0;
        (void)hipGetDevice(&dev); (void)hipDeviceGetAttribute(&cus, hipDeviceAttributeMultiprocessorCount, dev);
        if (hipOccupancyMaxActiveBlocksPerMultiprocessor(&per_cu, (const void*)fwd_kernel, 512, LDS_BYTES) != hipSuccess || per_cu < 1) fprintf(stderr, "kernel_launch: occupancy query says %d\n", per_cu);
        (void)hipGetLastError();
        grid = cus < 256 ? cus : 256;
    }
    if (grid < 0) return;
    (void)hipMemsetAsync((char*)d_ws + WS_CTL, 0, CTL_ZERO_BYTES, stream);
    Args a{};
    for (int i = 0; i < 29; ++i) a.in[i] = (const float*)d_in[i];
    a.out = (float*)d_out; a.ws = (unsigned char*)d_ws;
    hipLaunchKernelGGL(fwd_kernel, dim3(grid), dim3(512), LDS_BYTES, stream, a);
}
```

```cpp
#define CHK 0
#define CHK_STOP 99
#include <hip/hip_runtime.h>
#include <cstdio>
#include <cstdint>

#ifndef CHK
#define CHK 0
#endif
#ifndef STAMP
#define STAMP 0
#endif
#ifndef CHK_STOP
#define CHK_STOP 99
#endif

#ifndef FP8_MOE
#define FP8_MOE 1
#endif
#ifndef COL_AUX
#define COL_AUX 1
#endif
#ifndef WIDE_ST
#define WIDE_ST 1
#endif
#ifndef FP8_MRG
#define FP8_MRG 1
#endif
#ifndef FP8_G
#define FP8_G 1
#endif
#ifndef FP8_YB
#define FP8_YB 1
#endif
#ifndef FP8_IN
#define FP8_IN 2
#endif
#define LAS __attribute__((address_space(3)))
#define GAS __attribute__((address_space(1)))
typedef unsigned short bf16_t;
typedef short bf16x8 __attribute__((ext_vector_type(8)));
typedef int i32x8 __attribute__((ext_vector_type(8)));
typedef int i32x4v __attribute__((ext_vector_type(4)));
typedef short s16x4 __attribute__((ext_vector_type(4)));
typedef float f32x4 __attribute__((ext_vector_type(4)));
typedef float f32x2 __attribute__((ext_vector_type(2)));
typedef float f32x16 __attribute__((ext_vector_type(16)));
typedef unsigned u32x4 __attribute__((ext_vector_type(4)));
typedef unsigned u32x2 __attribute__((ext_vector_type(2)));
typedef GAS unsigned gu32;

constexpr int D = 1024, BATCH = 16, SEQ = 2048, M = BATCH * SEQ, DEPTH = 2;
constexpr int NEXP = 32, TOPK = 4, DIN = 5128;
constexpr int ZP = 5184;
constexpr int ZC_QA = 0, ZC_KA = 512, ZC_VA = 1024, ZC_QB = 1536, ZC_KB = 2048, ZC_VB = 2560, ZC_XC = 3072, ZC_GC = 4096, ZC_G = 5120;
constexpr int OP = 2048;
constexpr float LN_EPS = 1e-5f;
constexpr float DN_ALPHA = 1.41421356237f;
constexpr float LOG2E = 1.4426950408889634f;
constexpr float C2 = 0.125f * 1.4426950408889634f;
constexpr int MAXBLK = M * TOPK / 256 + NEXP;
constexpr int ECAP = 32768;

constexpr size_t MiB = 1u << 20;
constexpr size_t WS_CTL = 0, CTL_ZERO_BYTES = 1 * MiB;
constexpr size_t WS_ADA = 1 * MiB;
constexpr size_t WS_ONES = 1 * MiB + 800 * 1024;
constexpr size_t WS_LOGF = 2 * MiB;
constexpr size_t WS_F2 = 3 * MiB;
constexpr size_t WS_TOKER = 4 * MiB;
constexpr size_t WS_GATE = 4 * MiB + 512 * 1024;
constexpr size_t WS_SLOTTOK = 5 * MiB;
constexpr size_t WS_W = 16 * MiB;
constexpr size_t WL_IN = 0, WL_P = 16 * MiB, WL_O = 20 * MiB, WL_GU = 22 * MiB, WL_DN = 150 * MiB, WL_SIZE = 214 * MiB;
constexpr float Q_H1 = 8.0f, Q_WIN = 256.0f;
constexpr float Q_YB = 16.0f;
constexpr float Q_O = 8.0f, Q_WP = 256.0f;
constexpr float Q_H2 = 8.0f, Q_WGU = 256.0f, Q_ACT = 8.0f, Q_WDN = 512.0f;
constexpr size_t WS_G8 = 1153 * MiB;
constexpr float Q_G = 255.0f;
constexpr int G8P = 3200;
constexpr size_t WS_ROWS = 1152 * MiB;
constexpr size_t WS_H = 448 * MiB;
constexpr size_t WS_Z = 512 * MiB;
constexpr size_t WS_ACT = 512 * MiB;
constexpr size_t WS_O = 1024 * MiB;
constexpr size_t WS_MB = 1152 * MiB;
constexpr size_t WS_MG = 1280 * MiB;
constexpr size_t WS_Y = 1344 * MiB;
constexpr size_t WS_X1 = 1472 * MiB;
constexpr size_t WS_XL = 1600 * MiB;
constexpr size_t WS_YB = 1728 * MiB;
constexpr size_t WS_END = 2000 * MiB;
static_assert((size_t)MAXBLK * 256 * 1024 * 2 <= 272 * MiB, "act / y_buf size");

constexpr int CW_TMO = 0, CW_CODE = 1;
constexpr int CW_BAR = 4096;
constexpr int CW_GCNT = 8192;
constexpr int CW_WMAX = 32768;
constexpr int CW_CHK = 16384;

constexpr int RING_BYTES = 131072;
constexpr int MISC_OFF = RING_BYTES;
constexpr int LDS_BYTES = 147456;
constexpr int MO_BAR = 14336;
constexpr int MO_CNT = 64;
constexpr int MO_BS = 64 + 128;
constexpr int MO_BE = 64 + 128 + 136;
constexpr int MO_LCNT = 1024;
constexpr int MO_LBASE = 1024 + 128;
constexpr int MO_REC = 2048;
constexpr int MO_GT = 4096;
constexpr int MO_LG = 6144;
constexpr int MO_CAR = 2048;

namespace pg8 {
constexpr int BM = 256, BK = 64, HALF = 128, HTB = HALF * BK * 2, STAGE_BYTES = 8 * HTB, NXCD = 8, WGM = 8;
__host__ __device__ __forceinline__ int lds_byte(int r, int c) { const int st = (r >> 4) * 2 + (c >> 5), rr = r & 15, cc = c & 31, ob = rr * 64 + cc * 2; return st * 1024 + (ob ^ (((ob >> 9) & 1) << 5)); }
__host__ __device__ __forceinline__ void stage_rc(int b, int& R, int& C) { const int st = b / 1024, sb = b % 1024, swz = sb ^ (((sb >> 9) & 1) << 5); R = (st >> 1) * 16 + swz / 64; C = (st & 1) * 32 + (swz % 64) / 2; }
__host__ __device__ __forceinline__ int perm32(int rho) { const int n = rho >> 4, i = rho & 15; return 8 * (i >> 2) + 4 * n + (i & 3); }

struct Unit { int pm, pn, aux; };

struct TileOrder {
    int nM, nN, nwg, G, c;
    __device__ __forceinline__ void init(int nM_, int nN_, int G_, int c_) { nM = nM_; nN = nN_; nwg = nM * nN; G = G_; c = c_; }
    __device__ __forceinline__ bool tile(int i, int& pm, int& pn) const {
        const long L = (long)i * G + c; if (L >= nwg) return false;
        int wgid = (int)L; { const int q = nwg / NXCD, r = nwg % NXCD, xcd = wgid % NXCD, off = wgid / NXCD; wgid = (xcd < r ? xcd * (q + 1) : r * (q + 1) + (xcd - r) * q) + off; }
        const int nig = WGM * nN, gid = wgid / nig, fm = gid * WGM, gsz = (nM - fm) < WGM ? (nM - fm) : WGM;
        pm = fm + ((wgid % nig) % gsz); pn = (wgid % nig) / gsz; return true;
    }
};

__device__ __forceinline__ unsigned cvt_pk_bf16(float lo, float hi) { unsigned r; asm volatile("v_cvt_pk_bf16_f32 %0, %1, %2" : "=v"(r) : "v"(lo), "v"(hi)); return r; }

template <class Epi, class Sched, bool GATHER>
__device__ __forceinline__ void gemm_phase(LAS unsigned char* lds, const int lda, const int ldb, const Sched& S, Epi& E, const int tid_in) {
    int tid_ = tid_in; asm volatile("" : "+v"(tid_));
    const int tid = tid_, wid = __builtin_amdgcn_readfirstlane(tid >> 6), lane = tid & 63, wr = wid >> 2, wc = wid & 3, fr = lane & 15, fq = lane >> 4;
    unsigned voffA[2], voffB[2]; int RR[2], CC[2];
#pragma unroll
    for (int i = 0; i < 2; ++i) { int R, C; stage_rc(tid * 16 + i * 8192, R, C); const int Rb = Epi::WIDE ? (64 * (R >> 5) + perm32(R & 31)) : (Epi::PERM ? ((R & ~31) + perm32(R & 31)) : R);
        RR[i] = R; CC[i] = C; voffA[i] = (unsigned)(R * lda + C) * 2u; voffB[i] = (unsigned)(Rb * ldb + C) * 2u; }
    const size_t kstep = (size_t)(BK * 2);
    const size_t hstepA = (size_t)HALF * lda * 2, hstepB = (size_t)(Epi::WIDE ? 32 : HALF) * ldb * 2;
    const unsigned ldsw = (unsigned)wid * 1024u;
    const int aoff = lds_byte(wr * 64 + fr, fq * 8), boff = lds_byte(wc * 32 + fr, fq * 8);
#define PG8_SA(b, h) (((b) * 2 + (h)) * HTB)
#define PG8_SB(b, h) ((4 + (b) * 2 + (h)) * HTB)
#define PG8_STG(bufoff, ptr, vo, _i) __builtin_amdgcn_global_load_lds((const unsigned*)((const char*)(ptr) + (vo)), (LAS unsigned*)(lds + (bufoff) + ldsw + (_i) * 8192), 16, 0, 0)
#define PG8_STAGE_B(bufoff, gbase) do { PG8_STG(bufoff, gbase, voffB[0], 0); PG8_STG(bufoff, gbase, voffB[1], 1); } while (0)
#define PG8_STAGE_A(bufoff, gbase, h, VG) do { if constexpr (GATHER) { PG8_STG(bufoff, gbase, VG[h][0], 0); PG8_STG(bufoff, gbase, VG[h][1], 1); } \
        else { PG8_STG(bufoff, (gbase) + (h) * hstepA, voffA[0], 0); PG8_STG(bufoff, (gbase) + (h) * hstepA, voffA[1], 1); } } while (0)
#define PG8_LDA(dst, b, h) do { _Pragma("unroll") for (int m = 0; m < 4; ++m) _Pragma("unroll") for (int k = 0; k < 2; ++k) dst[m][k] = *(const LAS bf16x8*)(lds + PG8_SA(b, h) + aoff + m * 2048 + k * 1024); } while (0)
#define PG8_LDB(dst, b, h) do { _Pragma("unroll") for (int n = 0; n < 2; ++n) _Pragma("unroll") for (int k = 0; k < 2; ++k) dst[n][k] = *(const LAS bf16x8*)(lds + PG8_SB(b, h) + boff + n * 2048 + k * 1024); } while (0)
#define PG8_F8CAT(x) __builtin_shufflevector(__builtin_bit_cast(i32x4v, x[0]), __builtin_bit_cast(i32x4v, x[1]), 0, 1, 2, 3, 4, 5, 6, 7)
#define PG8_MMA(ai, bj, At, Bt) do { __builtin_amdgcn_s_setprio(1); _Pragma("unroll") for (int m = 0; m < 4; ++m) _Pragma("unroll") for (int n = 0; n < 2; ++n) { \
        if constexpr (Epi::F8) asm volatile("v_mfma_f32_16x16x128_f8f6f4 %0, %1, %2, %0" : "+v"(acc[ai][bj][m][n]) : "v"(PG8_F8CAT(Bt[n])), "v"(PG8_F8CAT(At[m])));   \
        else if constexpr (Epi::I8) { _Pragma("unroll") for (int k = 0; k < 2; ++k) acc[ai][bj][m][n] = __builtin_bit_cast(f32x4, __builtin_amdgcn_mfma_i32_16x16x64_i8(__builtin_bit_cast(i32x4v, Bt[n][k]), __builtin_bit_cast(i32x4v, At[m][k]), __builtin_bit_cast(i32x4v, acc[ai][bj][m][n]), 0, 0, 0)); }   \
        else { _Pragma("unroll") for (int k = 0; k < 2; ++k) acc[ai][bj][m][n] = __builtin_amdgcn_mfma_f32_16x16x32_bf16(Bt[n][k], At[m][k], acc[ai][bj][m][n], 0, 0, 0); } } __builtin_amdgcn_s_setprio(0); } while (0)
#define PG8_WAIT_V(n) asm volatile("s_waitcnt vmcnt(" #n ")" ::: "memory")
#define PG8_WAIT_L(n) asm volatile("s_waitcnt lgkmcnt(" #n ")" ::: "memory")
#define PG8_BAR __builtin_amdgcn_s_barrier()
#define PG8_SCHED __builtin_amdgcn_sched_barrier(0)
    Unit cur, nxt; int ui = 0;
    if (!S.next(0, cur)) return;
    f32x4 acc[2][2][4][2];
#pragma unroll
    for (int a = 0; a < 2; ++a)
#pragma unroll
        for (int b = 0; b < 2; ++b)
#pragma unroll
            for (int m = 0; m < 4; ++m)
#pragma unroll
                for (int n = 0; n < 2; ++n) acc[a][b][m][n] = (f32x4){0.f, 0.f, 0.f, 0.f};
    bf16x8 At[4][2], B0[2][2], B1[2][2];
    const char* cA; const char* cB; int nt;
    S.operands(cur, cA, cB, nt);
    unsigned vgc[2][2] = {{0u, 0u}, {0u, 0u}}, vgn[2][2] = {{0u, 0u}, {0u, 0u}};
    LAS unsigned* gbuf = (LAS unsigned*)(lds + 131072 + 10240);
    if constexpr (GATHER) { S.gather_issue(cur, gbuf, wid, lane); asm volatile("s_waitcnt vmcnt(0)" ::: "memory"); __builtin_amdgcn_s_barrier(); asm volatile("" ::: "memory"); S.gather_read(cur, RR, CC, vgc, gbuf); }
    LAS unsigned* abuf = (LAS unsigned*)(lds + 131072 + 12288);
    if constexpr (Epi::COLAUX) E.caux_issue(cur, abuf, wid, lane);
    if constexpr (Epi::ROWAUX) E.aux_issue(cur, gbuf, wid, lane);
    PG8_STAGE_B(PG8_SB(0, 0), cB); PG8_STAGE_B(PG8_SB(0, 1), cB + hstepB); PG8_STAGE_A(PG8_SA(0, 0), cA, 0, vgc); PG8_STAGE_A(PG8_SA(0, 1), cA, 1, vgc);
    if (wr == 1) PG8_BAR;
    PG8_WAIT_V(2); PG8_BAR;
    PG8_STAGE_B(PG8_SB(1, 0), cB + kstep); PG8_STAGE_A(PG8_SA(1, 0), cA + kstep, 0, vgc); PG8_STAGE_B(PG8_SB(1, 1), cB + hstepB + kstep);
    PG8_WAIT_V(6); PG8_BAR;
    for (;;) {
        const bool has_next = S.next(ui + 1, nxt);
        const char* nA = cA; const char* nB = cB; int nnt = nt;
        if (has_next) { S.operands(nxt, nA, nB, nnt); if constexpr (GATHER) S.gather_issue(nxt, gbuf + 256 * ((ui + 1) & 1), wid, lane); }
        else { if constexpr (GATHER) { vgn[0][0] = vgc[0][0]; vgn[0][1] = vgc[0][1]; vgn[1][0] = vgc[1][0]; vgn[1][1] = vgc[1][1]; } }
        for (int t = 0; t < nt; t += 2) {
            const bool last = (t == nt - 2);
            const char* a1 = cA + (size_t)(t + 1) * kstep;
            const char* a2 = last ? nA : cA + (size_t)(t + 2) * kstep; const char* b2 = last ? nB : cB + (size_t)(t + 2) * kstep;
            const char* a3 = a2 + kstep; const char* b3 = b2 + kstep;
            unsigned v2[2][2];
            if constexpr (GATHER) { if (last && has_next) S.gather_read(nxt, RR, CC, vgn, gbuf + 256 * ((ui + 1) & 1)); }
            if constexpr (GATHER) { v2[0][0] = last ? vgn[0][0] : vgc[0][0]; v2[0][1] = last ? vgn[0][1] : vgc[0][1]; v2[1][0] = last ? vgn[1][0] : vgc[1][0]; v2[1][1] = last ? vgn[1][1] : vgc[1][1]; }
            else { v2[0][0] = v2[0][1] = v2[1][0] = v2[1][1] = 0u; }
            PG8_LDB(B0, 0, 0); PG8_LDB(B1, 0, 1); PG8_SCHED; PG8_LDA(At, 0, 0); PG8_STAGE_A(PG8_SA(1, 1), a1, 1, vgc);
            PG8_WAIT_V(8); PG8_WAIT_L(0); PG8_BAR; PG8_MMA(0, 0, At, B0); PG8_MMA(0, 1, At, B1); PG8_BAR; PG8_SCHED;
            PG8_LDA(At, 0, 1); PG8_STAGE_B(PG8_SB(0, 0), b2); PG8_STAGE_B(PG8_SB(0, 1), b2 + hstepB); PG8_STAGE_A(PG8_SA(0, 0), a2, 0, v2);
            PG8_WAIT_V(8); PG8_WAIT_L(0); PG8_BAR; PG8_MMA(1, 0, At, B0); PG8_MMA(1, 1, At, B1); PG8_BAR; PG8_SCHED;
            PG8_LDB(B0, 1, 0); PG8_LDB(B1, 1, 1); PG8_SCHED; PG8_LDA(At, 1, 0); PG8_STAGE_A(PG8_SA(0, 1), a2, 1, v2);
            PG8_WAIT_V(8); PG8_WAIT_L(0); PG8_BAR; PG8_MMA(0, 0, At, B0); PG8_MMA(0, 1, At, B1); PG8_BAR; PG8_SCHED;
            PG8_LDA(At, 1, 1); PG8_STAGE_B(PG8_SB(1, 0), b3); PG8_STAGE_B(PG8_SB(1, 1), b3 + hstepB); PG8_STAGE_A(PG8_SA(1, 0), a3, 0, v2);
            PG8_WAIT_V(8); PG8_WAIT_L(0); PG8_BAR; PG8_MMA(1, 0, At, B0); PG8_MMA(1, 1, At, B1); PG8_BAR; PG8_SCHED;
        }
        if (wr == 0) PG8_BAR;
        if constexpr (Epi::F8) asm volatile("s_nop 15\n\ts_nop 7" ::: "memory");
        if constexpr (Epi::ROWAUX) E.aux_buf(gbuf + 256 * (ui & 1));
        if constexpr (Epi::COLAUX) E.caux_buf(abuf + 256 * (ui & 1));
        E(acc, cur, wr, wc, fr, fq);
#ifdef GEMM_DUP_EPI
        if constexpr (!Epi::NODUP && ((GEMM_DUP_EPI) & Epi::DUPBIT) != 0) { asm volatile("" ::: "memory"); E(acc, cur, wr, wc, fr, fq); }
#endif
        if (!has_next) break;
        if (!E.keep(cur)) {
#pragma unroll
        for (int a = 0; a < 2; ++a)
#pragma unroll
            for (int b = 0; b < 2; ++b)
#pragma unroll
                for (int m = 0; m < 4; ++m)
#pragma unroll
                    for (int n = 0; n < 2; ++n) acc[a][b][m][n] = (f32x4){0.f, 0.f, 0.f, 0.f}; }
        cur = nxt; cA = nA; cB = nB; nt = nnt; ++ui;
        if constexpr (Epi::ROWAUX) E.aux_issue(cur, gbuf + 256 * (ui & 1), wid, lane);
        if constexpr (Epi::COLAUX) E.caux_issue(cur, abuf + 256 * (ui & 1), wid, lane);
        if constexpr (GATHER) { vgc[0][0] = vgn[0][0]; vgc[0][1] = vgn[0][1]; vgc[1][0] = vgn[1][0]; vgc[1][1] = vgn[1][1]; }
        if (wr == 1) PG8_BAR;
    }
    PG8_WAIT_V(0);
    PG8_BAR;
#undef PG8_SA
#undef PG8_SB
#undef PG8_STG
#undef PG8_STAGE_A
#undef PG8_STAGE_B
#undef PG8_LDA
#undef PG8_LDB
#undef PG8_MMA
#undef PG8_F8CAT
#undef PG8_WAIT_V
#undef PG8_WAIT_L
#undef PG8_BAR
#undef PG8_SCHED
}
}

#define RLX_AGENT __ATOMIC_RELAXED, __HIP_MEMORY_SCOPE_AGENT
#define LDS_WAIT() asm volatile("s_waitcnt lgkmcnt(0)" ::: "memory")
#define VM_WAIT() asm volatile("s_waitcnt vmcnt(0)" ::: "memory")
__device__ __forceinline__ float bf2f(unsigned b) { return __uint_as_float(b << 16); }
__device__ __forceinline__ unsigned f2bf(float f) { unsigned u = __float_as_uint(f); return (u + 0x7fffu + ((u >> 16) & 1u)) >> 16; }
__device__ __forceinline__ unsigned pk2(float lo, float hi) { return pg8::cvt_pk_bf16(lo, hi); }
__device__ __forceinline__ float f8clamp(float x) { return fminf(fmaxf(x, -448.0f), 448.0f); }
__device__ __forceinline__ unsigned pk4_u8(float a, float b, float c, float d) { int r = __builtin_amdgcn_cvt_pk_u8_f32(__builtin_rintf(a), 0, 0); r = __builtin_amdgcn_cvt_pk_u8_f32(__builtin_rintf(b), 1, r); r = __builtin_amdgcn_cvt_pk_u8_f32(__builtin_rintf(c), 2, r); r = __builtin_amdgcn_cvt_pk_u8_f32(__builtin_rintf(d), 3, r); return (unsigned)r; }
__device__ __forceinline__ unsigned char f8_byte(float x) { return (unsigned char)(__builtin_amdgcn_cvt_pk_fp8_f32(f8clamp(x), 0.0f, 0, false) & 0xff); }
__device__ __forceinline__ unsigned pk4_f8_nc(float a, float b, float c, float d) { int r = __builtin_amdgcn_cvt_pk_fp8_f32(a, b, 0, false); r = __builtin_amdgcn_cvt_pk_fp8_f32(c, d, r, true); return (unsigned)r; }
__device__ __forceinline__ unsigned pk4_f8(float a, float b, float c, float d) { int r = __builtin_amdgcn_cvt_pk_fp8_f32(f8clamp(a), f8clamp(b), 0, false); r = __builtin_amdgcn_cvt_pk_fp8_f32(f8clamp(c), f8clamp(d), r, true); return (unsigned)r; }
__device__ __forceinline__ float fexp2(float x) { return __builtin_amdgcn_exp2f(x); }
__device__ __forceinline__ float flog2(float x) { return __builtin_amdgcn_logf(x); }
__device__ __forceinline__ float frcp(float x) { return __builtin_amdgcn_rcpf(x); }
__device__ __forceinline__ float fsigmoid(float x) { return frcp(1.0f + fexp2(-LOG2E * x)); }
__device__ __forceinline__ float shx(int lane, float v, int mask) { return __int_as_float(__builtin_amdgcn_ds_bpermute((lane ^ mask) << 2, __float_as_int(v))); }
__device__ __forceinline__ float shup(int lane, float v, int o) { return __int_as_float(__builtin_amdgcn_ds_bpermute((lane >= o ? lane - o : lane) << 2, __float_as_int(v))); }
__device__ __forceinline__ float shidx(float v, int src) { return __int_as_float(__builtin_amdgcn_ds_bpermute(src << 2, __float_as_int(v))); }
#define WV_DPP(x, ctrl) __int_as_float(__builtin_amdgcn_update_dpp(0, __float_as_int(x), (ctrl), 0xf, 0xf, true))
__device__ __forceinline__ float wave_sum(int lane, float v) {
    (void)lane;
    v += WV_DPP(v, 0xb1); v += WV_DPP(v, 0x4e); v += WV_DPP(v, 0x141); v += WV_DPP(v, 0x140);
    { const auto r = __builtin_amdgcn_permlane16_swap(__float_as_uint(v), __float_as_uint(v), false, false); v = __uint_as_float(r[0]) + __uint_as_float(r[1]); }
    { const auto r = __builtin_amdgcn_permlane32_swap(__float_as_uint(v), __float_as_uint(v), false, false); v = __uint_as_float(r[0]) + __uint_as_float(r[1]); }
    return v;
}
__device__ __forceinline__ float wave_max(int lane, float v) {
    (void)lane;
    v = fmaxf(v, WV_DPP(v, 0xb1)); v = fmaxf(v, WV_DPP(v, 0x4e)); v = fmaxf(v, WV_DPP(v, 0x141)); v = fmaxf(v, WV_DPP(v, 0x140));
    { const auto r = __builtin_amdgcn_permlane16_swap(__float_as_uint(v), __float_as_uint(v), false, false); v = fmaxf(__uint_as_float(r[0]), __uint_as_float(r[1])); }
    { const auto r = __builtin_amdgcn_permlane32_swap(__float_as_uint(v), __float_as_uint(v), false, false); v = fmaxf(__uint_as_float(r[0]), __uint_as_float(r[1])); }
    return v;
}
__device__ __forceinline__ unsigned pk4_i8(float a, float b, float c, float d) {
    const int qa = (int)__builtin_rintf(a), qb = (int)__builtin_rintf(b), qc = (int)__builtin_rintf(c), qd = (int)__builtin_rintf(d);
    return ((unsigned)qa & 255u) | (((unsigned)qb & 255u) << 8) | (((unsigned)qc & 255u) << 16) | ((unsigned)qd << 24); }

#define XB_TMO      128
#define XB_XCNT(j)  (256  + 64 * (j))
#define XB_XSUB(j)  (1280 + 64 * (j))
#define XB_XGEN(j)  (2304 + 64 * (j))
#define XB_TOP      3328
#define XB_TOPGEN   3392
#define XCD_BAR_WORDS 3456
#if CHK
#define XB_SPIN_CAP (1u << 21)
#else
#define XB_SPIN_CAP (1u << 18)
#endif
__device__ __forceinline__ unsigned xb_ld(unsigned* p)              { return __hip_atomic_load(p, __ATOMIC_RELAXED, __HIP_MEMORY_SCOPE_AGENT); }
__device__ __forceinline__ unsigned xb_add(unsigned* p, unsigned v) { return __hip_atomic_fetch_add(p, v, __ATOMIC_RELAXED, __HIP_MEMORY_SCOPE_AGENT); }
__device__ __forceinline__ unsigned xb_xcc_id() { return (unsigned)__builtin_amdgcn_s_getreg((3 << 11) | 20) & 0xFu; }
#define XB_SPIN(cond, bar) do { unsigned _sp = 0; while (cond) { __builtin_amdgcn_s_sleep(1); \
    if ((++_sp & 255u) == 0u) { if (xb_ld(&(bar)[XB_TMO])) break; if (_sp > XB_SPIN_CAP) { atomicAdd(&(bar)[XB_TMO], 1u); break; } } } } while (0)
struct XcdBarrier { unsigned* bar; unsigned x; volatile LAS unsigned* st; };
__device__ __forceinline__ XcdBarrier xcd_barrier_post(unsigned* bar, volatile LAS unsigned* st) {
    XcdBarrier b; b.bar = bar; b.x = xb_xcc_id(); b.st = st;
    if (threadIdx.x == 0) (void)xb_add(&bar[XB_XCNT(b.x)], 1u);
    return b;
}
__device__ __forceinline__ void xcd_barrier_complete(unsigned* bar, unsigned x, unsigned& nloc, unsigned& nx) {
    const unsigned G = gridDim.x * gridDim.y * gridDim.z;
    unsigned sum, cnt, mine, sp = 0u;
    for (;;) {
        sum = 0u; cnt = 0u; mine = 0u;
#pragma unroll
        for (unsigned j = 0; j < 16; ++j) { const unsigned c = xb_ld(&bar[XB_XCNT(j)]); sum += c; cnt += (c > 0u) ? 1u : 0u; mine = (j == x) ? c : mine; }
        if (sum == G) break;
        __builtin_amdgcn_s_sleep(1);
        if ((++sp & 255u) == 0u) { if (xb_ld(&bar[XB_TMO])) break; if (sp > XB_SPIN_CAP) { atomicAdd(&bar[XB_TMO], 1u); break; } }
    }
    nloc = mine > 0u ? mine : 1u; nx = cnt > 0u ? cnt : 1u;
}
__device__ __forceinline__ void xcd_barrier(const XcdBarrier& b) {
    asm volatile("s_waitcnt vmcnt(0)" ::: "memory");
    __syncthreads();
    if (threadIdx.x == 0) {
        unsigned* bar = b.bar;
        __builtin_amdgcn_s_waitcnt(0);
        unsigned nloc = b.st[0], nx = b.st[1];
        if (nloc == 0u) { xcd_barrier_complete(bar, b.x, nloc, nx); b.st[0] = nloc; b.st[1] = nx; }
        const unsigned old = xb_add(&bar[XB_XSUB(b.x)], 1u);
        const unsigned gen = old / nloc;
        if (old + 1u == (gen + 1u) * nloc) {
            __builtin_amdgcn_fence(__ATOMIC_RELEASE, "agent");
            asm volatile("s_waitcnt vmcnt(0)" ::: "memory");
            const unsigned og = xb_add(&bar[XB_TOP], 1u);
            const unsigned tg = og / nx;
            if (og + 1u == (tg + 1u) * nx) xb_add(&bar[XB_TOPGEN], 1u);
            else XB_SPIN(xb_ld(&bar[XB_TOPGEN]) == tg, bar);
            __builtin_amdgcn_fence(__ATOMIC_ACQUIRE, "agent");
            xb_add(&bar[XB_XGEN(b.x)], 1u);
            asm volatile("s_waitcnt vmcnt(0)" ::: "memory");
        } else {
            XB_SPIN(xb_ld(&bar[XB_XGEN(b.x)]) == gen, bar);
            __builtin_amdgcn_fence(__ATOMIC_ACQUIRE, "agent");
            asm volatile("s_waitcnt vmcnt(0)" ::: "memory");
        }
    }
    __syncthreads();
}

struct Args { const float* in[29]; float* out; unsigned char* ws; };
typedef const __attribute__((address_space(4))) Args* ArgsP;
struct AR { ArgsP p;
    __device__ __forceinline__ const float* in(int i) const { return p->in[i]; }
    __device__ __forceinline__ float* out() const { return p->out; }
    __device__ __forceinline__ unsigned char* ws() const { return p->ws; } };
enum { I_X = 0, I_C, I_WADA, I_BADA, I_LN1G, I_LN1B, I_WIN, I_BF, I_CONVW, I_CONVB, I_WA, I_BA, I_WX, I_BX, I_LAM, I_WGATE, I_BGATE, I_WPA, I_WPB, I_WPC, I_WO,
       I_LN2G, I_LN2B, I_WR, I_BR, I_WGU, I_BGU, I_WDN, I_BDN };

struct P0Item { const float* src; bf16_t* dst; int ldw; int ldt; float qs; };
constexpr int IT_IN = 16 * 80, IT_G = 16 * 48, IT_PA = 8 * 16, IT_PB = 8 * 16, IT_PC = 16 * 16, IT_O = 16 * 16, IT_GU = 32 * 16 * 32, IT_DN = 32 * 16 * 16;
constexpr int IT_LAYER = IT_IN + IT_G + IT_PA + IT_PB + IT_PC + IT_O + IT_GU + IT_DN;
__device__ __forceinline__ P0Item p0_decode(const AR a, int it) {
    const int l = it / IT_LAYER; int r = it % IT_LAYER; P0Item d; d.qs = 0.f;
    unsigned char* wl = a.ws() + WS_W + (size_t)l * WL_SIZE;
    if (r < IT_IN) { const int kb = FP8_IN ? (r / 160) * 2 : r / 80, n0 = FP8_IN ? 32 * (r % 160) : 64 * (r % 80); d.ldw = DIN; d.ldt = 1024; d.src = a.in(I_WIN) + (size_t)l * D * DIN + (size_t)(64 * kb) * DIN + (n0 < 1536 ? n0 : n0 + 8);
        if (FP8_IN) { d.qs = (FP8_IN == 2) ? -127.0f / fmaxf(__uint_as_float(__hip_atomic_load((gu32*)(a.ws() + WS_CTL) + CW_WMAX + (2 * l) * 64, RLX_AGENT)), 1e-30f) : Q_WIN; d.dst = (bf16_t*)(wl + WL_IN + (size_t)n0 * 1024 + 64 * kb); } else d.dst = (bf16_t*)(wl + WL_IN) + (size_t)n0 * 1024 + 64 * kb; return d; } r -= IT_IN;
    if (r < IT_G) { const int kb = FP8_IN ? (r / 96) * 2 : r / 48, n0 = FP8_IN ? 32 * (r % 96) : 64 * (r % 48); d.ldw = 3072; d.ldt = 1024; d.src = a.in(I_WGATE) + (size_t)l * D * 3072 + (size_t)(64 * kb) * 3072 + n0;
        if (FP8_IN) { d.qs = (FP8_IN == 2) ? -127.0f / fmaxf(__uint_as_float(__hip_atomic_load((gu32*)(a.ws() + WS_CTL) + CW_WMAX + (2 * l + 1) * 64, RLX_AGENT)), 1e-30f) : Q_WIN; d.dst = (bf16_t*)(wl + WL_IN + (size_t)(5120 + n0) * 1024 + 64 * kb); } else d.dst = (bf16_t*)(wl + WL_IN) + (size_t)(5120 + n0) * 1024 + 64 * kb; return d; } r -= IT_G;
    if (r < IT_PA) { const int kb = FP8_MRG ? (r / 32) * 2 : r / 16, n0 = FP8_MRG ? 32 * (r % 32) : 64 * (r % 16); d.ldw = D; d.ldt = 2048; d.src = a.in(I_WPA) + (size_t)l * 512 * D + (size_t)(64 * kb) * D + n0;
        if (FP8_MRG) { d.qs = Q_WP; d.dst = (bf16_t*)(wl + WL_P + (size_t)n0 * 2048 + 64 * kb); } else d.dst = (bf16_t*)(wl + WL_P) + (size_t)n0 * 2048 + 64 * kb; return d; } r -= IT_PA;
    if (r < IT_PB) { const int kb = FP8_MRG ? (r / 32) * 2 : r / 16, n0 = FP8_MRG ? 32 * (r % 32) : 64 * (r % 16); d.ldw = D; d.ldt = 2048; d.src = a.in(I_WPB) + (size_t)l * 512 * D + (size_t)(64 * kb) * D + n0;
        if (FP8_MRG) { d.qs = Q_WP; d.dst = (bf16_t*)(wl + WL_P + (size_t)n0 * 2048 + 512 + 64 * kb); } else d.dst = (bf16_t*)(wl + WL_P) + (size_t)n0 * 2048 + 512 + 64 * kb; return d; } r -= IT_PB;
    if (r < IT_PC) { const int kb = FP8_MRG ? (r / 32) * 2 : r / 16, n0 = FP8_MRG ? 32 * (r % 32) : 64 * (r % 16); d.ldw = D; d.ldt = 2048; d.src = a.in(I_WPC) + (size_t)l * D * D + (size_t)(64 * kb) * D + n0;
        if (FP8_MRG) { d.qs = Q_WP; d.dst = (bf16_t*)(wl + WL_P + (size_t)n0 * 2048 + 1024 + 64 * kb); } else d.dst = (bf16_t*)(wl + WL_P) + (size_t)n0 * 2048 + 1024 + 64 * kb; return d; } r -= IT_PC;
    if (r < IT_O) { const int kb = r / 16, n0 = 64 * (r % 16); d.ldw = D; d.ldt = 1024; d.src = a.in(I_WO) + (size_t)l * D * D + (size_t)(64 * kb) * D + n0; d.dst = (bf16_t*)(wl + WL_O) + (size_t)n0 * 1024 + 64 * kb; return d; } r -= IT_O;
    if (r < IT_GU) { const int e = r / 512, q = r % 512, kb = FP8_MOE ? (q / 64) * 2 : q / 32, n0 = FP8_MOE ? 32 * (q % 64) : 64 * (q % 32);
        const int sc = 1024 * ((n0 >> 7) & 1) + 128 * (n0 >> 8) + (n0 & 127);
        d.ldw = 2048; d.ldt = 1024; d.src = a.in(I_WGU) + ((size_t)l * NEXP + e) * D * 2048 + (size_t)(64 * kb) * 2048 + sc; if (FP8_MOE) { d.qs = Q_WGU; d.dst = (bf16_t*)(wl + WL_GU + ((size_t)e * 2048 + n0) * 1024 + 64 * kb); } else d.dst = (bf16_t*)(wl + WL_GU) + ((size_t)e * 2048 + n0) * 1024 + 64 * kb; return d; } r -= IT_GU;
    { const int e = r / 256, q = r % 256, kb = FP8_MOE ? (q / 32) * 2 : q / 16, n0 = FP8_MOE ? 32 * (q % 32) : 64 * (q % 16);
      d.ldw = D; d.ldt = 1024; d.src = a.in(I_WDN) + ((size_t)l * NEXP + e) * D * D + (size_t)(64 * kb) * D + n0; if (FP8_MOE) { d.qs = Q_WDN; d.dst = (bf16_t*)(wl + WL_DN + ((size_t)e * 1024 + n0) * 1024 + 64 * kb); } else d.dst = (bf16_t*)(wl + WL_DN) + ((size_t)e * 1024 + n0) * 1024 + 64 * kb; return d; }
}
__device__ __forceinline__ void p0_load(const P0Item& d, f32x4 (&v)[16], int lane) {
    if (d.qs != 0.f) {
        const float* p = d.src + (size_t)(lane >> 3) * d.ldw + 4 * (lane & 7);
#pragma unroll
        for (int i = 0; i < 16; ++i) v[i] = __builtin_nontemporal_load((const f32x4*)(p + (size_t)(8 * i) * d.ldw)); }
    else {
    const float* p = d.src + (size_t)(lane >> 4) * d.ldw + 4 * (lane & 15);
#pragma unroll
    for (int i = 0; i < 16; ++i) v[i] = __builtin_nontemporal_load((const f32x4*)(p + (size_t)(4 * i) * d.ldw)); }
}
__device__ __forceinline__ void p0_store(const P0Item& d, const f32x4 (&v)[16], LAS float* T, int lane) {
    if (d.qs != 0.f) {
        const int r = lane >> 3, c8 = lane & 7;
#pragma unroll
        for (int i = 0; i < 16; ++i) { const int kk = 8 * i + r;
            T[(4 * c8 + 0) * 129 + kk] = v[i][0]; T[(4 * c8 + 1) * 129 + kk] = v[i][1]; T[(4 * c8 + 2) * 129 + kk] = v[i][2]; T[(4 * c8 + 3) * 129 + kk] = v[i][3]; }
        LDS_WAIT(); asm volatile("" ::: "memory");
        const float q = fabsf(d.qs); const bool i8 = d.qs < 0.f;
#pragma unroll
        for (int j = 0; j < 4; ++j) { const int n = r + 8 * j; const LAS float* s = T + n * 129 + 16 * c8; u32x4 o;
            if (FP8_IN == 2 && i8) { o.x = pk4_i8(s[0] * q, s[1] * q, s[2] * q, s[3] * q); o.y = pk4_i8(s[4] * q, s[5] * q, s[6] * q, s[7] * q); o.z = pk4_i8(s[8] * q, s[9] * q, s[10] * q, s[11] * q); o.w = pk4_i8(s[12] * q, s[13] * q, s[14] * q, s[15] * q); }
            else { o.x = pk4_f8(s[0] * q, s[1] * q, s[2] * q, s[3] * q); o.y = pk4_f8(s[4] * q, s[5] * q, s[6] * q, s[7] * q); o.z = pk4_f8(s[8] * q, s[9] * q, s[10] * q, s[11] * q); o.w = pk4_f8(s[12] * q, s[13] * q, s[14] * q, s[15] * q); }
            *(GAS u32x4*)((unsigned char*)d.dst + (size_t)n * d.ldt + 16 * c8) = o; }
        LDS_WAIT(); asm volatile("" ::: "memory");
        return; }
    const int r = lane >> 4, c4 = lane & 15;
#pragma unroll
    for (int i = 0; i < 16; ++i) { const int kk = 4 * i + r;
        T[(4 * c4 + 0) * 65 + kk] = v[i][0]; T[(4 * c4 + 1) * 65 + kk] = v[i][1]; T[(4 * c4 + 2) * 65 + kk] = v[i][2]; T[(4 * c4 + 3) * 65 + kk] = v[i][3]; }
    LDS_WAIT(); asm volatile("" ::: "memory");
    const int c = lane & 7;
#pragma unroll
    for (int j = 0; j < 8; ++j) { const int n = (lane >> 3) + 8 * j; const LAS float* s = T + n * 65 + 8 * c;
        u32x4 o; o.x = pk2(s[0], s[1]); o.y = pk2(s[2], s[3]); o.z = pk2(s[4], s[5]); o.w = pk2(s[6], s[7]);
        *(GAS u32x4*)(d.dst + (size_t)n * d.ldt + 8 * c) = o; }
    LDS_WAIT(); asm volatile("" ::: "memory");
}
constexpr int IT_Q = (FP8_IN == 2) ? (IT_IN + IT_G) : 0;
__device__ __forceinline__ int p0_item(int q, int part) { return part ? (q / IT_Q) * IT_LAYER + (q % IT_Q) : (q / (IT_LAYER - IT_Q)) * IT_LAYER + IT_Q + (q % (IT_LAYER - IT_Q)); }
__device__ __forceinline__ void p0_weights(const AR a, LAS unsigned char* lds, int gw, int NGW, int wave, int lane, int part) {
    LAS float* T = (LAS float*)(lds + wave * 16640);
    const int NQ = DEPTH * (part ? IT_Q : IT_LAYER - IT_Q);
    int q = gw; if (q >= NQ) return;
    P0Item cur = p0_decode(a, p0_item(q, part)); f32x4 v[16]; p0_load(cur, v, lane);
    for (;;) {
        const int nx = q + NGW; const bool more = nx < NQ;
        P0Item nxt = cur; f32x4 w[16];
        if (more) { nxt = p0_decode(a, p0_item(nx, part)); p0_load(nxt, w, lane); }
        p0_store(cur, v, T, lane);
        if (!more) break;
#pragma unroll
        for (int i = 0; i < 16; ++i) v[i] = w[i];
        cur = nxt; q = nx;
    }
}
__device__ __forceinline__ void p0_wabsmax(const AR a, int gt, int NT, int lane) {
#pragma unroll 1
    for (int t = 0; t < 2 * DEPTH; ++t) { const int l = t >> 1, which = t & 1;
        const f32x4* W = (const f32x4*)(which ? a.in(I_WGATE) + (size_t)l * D * 3072 : a.in(I_WIN) + (size_t)l * D * DIN); const int n4 = (which ? D * 3072 : D * DIN) / 4;
        float mx = 0.f;
#pragma unroll 4
        for (int i = gt; i < n4; i += NT) { const f32x4 v = W[i]; mx = fmaxf(fmaxf(mx, fmaxf(fabsf(v[0]), fabsf(v[1]))), fmaxf(fabsf(v[2]), fabsf(v[3]))); }
        mx = wave_max(lane, mx);
        if (lane == 0) __hip_atomic_fetch_max((gu32*)(a.ws() + WS_CTL) + CW_WMAX + t * 64, __float_as_uint(mx), RLX_AGENT); }
}
__device__ __forceinline__ void p0_ada(const AR a, LAS unsigned char* lds, int item, int tid, int wave, int lane) {
    LAS float* cond = (LAS float*)lds;
    LAS float* part = (LAS float*)(lds + 65536);
    const int l = item / 96, cg = item % 96, col = cg * 64 + lane;
    const float* c = a.in(I_C);
    for (int i = tid; i < 16 * 1024; i += 512) { const float v = c[i]; cond[i] = v * fsigmoid(v); }
    __syncthreads();
    float acc[16];
#pragma unroll
    for (int b = 0; b < 16; ++b) acc[b] = 0.f;
    const float* W = a.in(I_WADA) + (size_t)l * D * 6144;
    {
        const float* Wp = W + (size_t)(wave * 128) * 6144 + col; float wc[16], wn[16];
#pragma unroll
        for (int i = 0; i < 16; ++i) wc[i] = Wp[(size_t)i * 6144];
#pragma unroll 1
        for (int k0 = 0; k0 < 128; k0 += 16) {
            if (k0 + 16 < 128) {
#pragma unroll
                for (int i = 0; i < 16; ++i) wn[i] = Wp[(size_t)(k0 + 16 + i) * 6144]; }
#pragma unroll
            for (int i = 0; i < 16; ++i) { const int k = wave * 128 + k0 + i;
#pragma unroll
                for (int b = 0; b < 16; ++b) acc[b] += cond[b * 1024 + k] * wc[i]; }
#pragma unroll
            for (int i = 0; i < 16; ++i) wc[i] = wn[i];
        } }
#pragma unroll
    for (int b = 0; b < 16; ++b) part[(wave * 16 + b) * 64 + lane] = acc[b];
    __syncthreads();
    float* ada = (float*)(a.ws() + WS_ADA);
    for (int o = tid; o < 1024; o += 512) { const int b = o >> 6, ln = o & 63; float s = 0.f;
#pragma unroll
        for (int w = 0; w < 8; ++w) s += part[(w * 16 + b) * 64 + ln];
        ada[((size_t)l * 16 + b) * 6144 + cg * 64 + ln] = s + a.in(I_BADA)[(size_t)l * 6144 + cg * 64 + ln]; }
    __syncthreads();
}

__device__ __forceinline__ void stage_wf(const AR a, int l, LAS unsigned char* lds, int tid) {
    LAS float* Wf = (LAS float*)lds;
    const float* W = a.in(I_WIN) + (size_t)l * D * DIN + 1536;
    for (int i = tid; i < 8192; i += 512) { const int k = i >> 3, g = i & 7, L = (k & 255) >> 2, j = k >> 8, ii = k & 3;
        Wf[((((4 * j + ii) * 2 + (g >> 2)) * 64 + L) << 2) + (g & 3)] = W[(size_t)k * DIN + g]; }
}
__device__ __forceinline__ float log_sigmoidf(float x) { return fminf(x, 0.f) - 0.6931471806f * flog2(1.0f + fexp2(-LOG2E * fabsf(x))); }
__device__ __forceinline__ void stage_vec(const float* src, LAS float* dst, int tid) { if (tid < 256) *(LAS f32x4*)(dst + 4 * tid) = *(const f32x4*)(src + 4 * tid); }
__device__ __forceinline__ void stage_vec5(const float* s0, const float* s1, const float* s2, const float* s3, const float* s4, LAS float* dst, int tid) {
    if (tid < 256) { const f32x4 v0 = *(const f32x4*)(s0 + 4 * tid), v1 = *(const f32x4*)(s1 + 4 * tid), v2 = *(const f32x4*)(s2 + 4 * tid), v3 = *(const f32x4*)(s3 + 4 * tid), v4 = *(const f32x4*)(s4 + 4 * tid);
        *(LAS f32x4*)(dst + 4 * tid) = v0; *(LAS f32x4*)(dst + 1024 + 4 * tid) = v1; *(LAS f32x4*)(dst + 2048 + 4 * tid) = v2; *(LAS f32x4*)(dst + 3072 + 4 * tid) = v3; *(LAS f32x4*)(dst + 4096 + 4 * tid) = v4; } }
__device__ __forceinline__ void prep_row(const AR a, int m, const f32x4 (&x)[4], const LAS float* Wf, const LAS float* shL, const LAS float* scL, const LAS float* bfL, int lane) {
    bf16_t* H = (bf16_t*)(a.ws() + WS_H) + (size_t)m * D;
    float s[8];
#pragma unroll
    for (int j = 0; j < 8; ++j) s[j] = 0.f;
    float mx = 0.f;
#pragma unroll
    for (int j = 0; j < 4; ++j) {
        const int col = 4 * lane + 256 * j;
        const f32x4 sh = *(const LAS f32x4*)(shL + 256 * j), sc = *(const LAS f32x4*)(scL + 256 * j);
        const f32x4 h = x[j] * (sc + 1.0f) + sh;
        if (FP8_IN == 2) { mx = fmaxf(fmaxf(mx, fmaxf(fabsf(h[0]), fabsf(h[1]))), fmaxf(fabsf(h[2]), fabsf(h[3]))); }
        else if (FP8_IN == 1) *(unsigned*)((unsigned char*)(a.ws() + WS_H) + (size_t)m * D + col) = pk4_f8(h[0] * Q_H1, h[1] * Q_H1, h[2] * Q_H1, h[3] * Q_H1);
        else { u32x2 w; w.x = pk2(h[0], h[1]); w.y = pk2(h[2], h[3]); *(u32x2*)(H + col) = w; }
#pragma unroll
        for (int i = 0; i < 4; ++i) { const f32x4 w0 = *(const LAS f32x4*)(Wf + ((((4 * j + i) * 2) * 64 + lane) << 2)), w1 = *(const LAS f32x4*)(Wf + ((((4 * j + i) * 2 + 1) * 64 + lane) << 2));
            s[0] += h[i] * w0[0]; s[1] += h[i] * w0[1]; s[2] += h[i] * w0[2]; s[3] += h[i] * w0[3];
            s[4] += h[i] * w1[0]; s[5] += h[i] * w1[1]; s[6] += h[i] * w1[2]; s[7] += h[i] * w1[3]; }
    }
    if (FP8_IN == 2) {
        mx = fmaxf(wave_max(lane, mx), 1e-30f); const float inv = 127.0f / mx;
#pragma unroll
        for (int j = 0; j < 4; ++j) { const f32x4 sh = *(const LAS f32x4*)(shL + 256 * j), sc = *(const LAS f32x4*)(scL + 256 * j); const f32x4 h = x[j] * (sc + 1.0f) + sh;
            *(unsigned*)((unsigned char*)(a.ws() + WS_H) + (size_t)m * D + 4 * lane + 256 * j) = pk4_i8(h[0] * inv, h[1] * inv, h[2] * inv, h[3] * inv); }
        if (lane == 0) ((float*)(a.ws() + WS_ROWS))[m] = mx * (1.0f / 127.0f); }
#pragma unroll
    for (int j = 0; j < 8; ++j) s[j] = wave_sum(lane, s[j]);
    float mine = s[0];
#pragma unroll
    for (int j = 1; j < 8; ++j) mine = (lane == j) ? s[j] : mine;
    if (lane < 8) { float* logf = (float*)(a.ws() + WS_LOGF); logf[(size_t)m * 8 + lane] = log_sigmoidf(mine + bfL[lane]); }
}
__device__ __forceinline__ void ln_row(f32x4 (&v)[4], const LAS float* g, const LAS float* bb, int lane) {
    float s = 0.f;
#pragma unroll
    for (int j = 0; j < 4; ++j) s += (v[j][0] + v[j][1]) + (v[j][2] + v[j][3]);
    const float mean = wave_sum(lane, s) * (1.f / D); float s2 = 0.f;
#pragma unroll
    for (int j = 0; j < 4; ++j) { v[j] = v[j] - mean; s2 += (v[j][0] * v[j][0] + v[j][1] * v[j][1]) + (v[j][2] * v[j][2] + v[j][3] * v[j][3]); }
    const float rstd = 1.f / sqrtf(wave_sum(lane, s2) * (1.f / D) + LN_EPS);
#pragma unroll
    for (int j = 0; j < 4; ++j) { const f32x4 gg = *(const LAS f32x4*)(g + 256 * j), bv = *(const LAS f32x4*)(bb + 256 * j); v[j] = v[j] * rstd * gg + bv; }
}

struct DenseOrder {
    pg8::TileOrder T; const char* A; const char* B; int lda, ldb, nt;
    __device__ __forceinline__ bool next(int i, pg8::Unit& u) const { u.aux = 0; return T.tile(i, u.pm, u.pn); }
    __device__ __forceinline__ void operands(const pg8::Unit& u, const char*& a, const char*& b, int& n) const {
        a = A + (size_t)u.pm * 256 * lda * 2; b = B + (size_t)u.pn * 256 * ldb * 2; n = nt; }
};
struct MergeOrder {
    pg8::TileOrder T; const char* A; const char* B;
    __device__ __forceinline__ bool next(int i, pg8::Unit& u) const { u.aux = i % 3; return T.tile(i / 3, u.pm, u.pn); }
    __device__ __forceinline__ void operands(const pg8::Unit& u, const char*& a, const char*& b, int& n) const {
        const int k0 = (u.aux == 0) ? 0 : (u.aux == 1 ? 512 : 1024);
        constexpr size_t EB = FP8_MRG ? 1 : 2;
        a = A + ((size_t)u.pm * 256 * OP + k0) * EB; b = B + ((size_t)u.pn * 256 * OP + k0) * EB; n = ((u.aux == 2) ? 16 : 8) / (FP8_MRG ? 2 : 1); }
};
struct MoeTables { const LAS int* cnt; const LAS int* bs; const LAS unsigned char* be; };
__device__ __forceinline__ MoeTables moe_tables(LAS unsigned char* lds) {
    MoeTables t; t.cnt = (const LAS int*)(lds + MISC_OFF + MO_CNT); t.bs = (const LAS int*)(lds + MISC_OFF + MO_BS); t.be = (const LAS unsigned char*)(lds + MISC_OFF + MO_BE); return t; }
__device__ __forceinline__ void moe_build_tables(gu32* ctl, int l, LAS unsigned char* lds, int tid) {
    LAS int* cnt = (LAS int*)(lds + MISC_OFF + MO_CNT); LAS int* bs = (LAS int*)(lds + MISC_OFF + MO_BS); LAS unsigned char* be = (LAS unsigned char*)(lds + MISC_OFF + MO_BE);
    __syncthreads();
    if (tid < 32) cnt[tid] = (int)__hip_atomic_load(ctl + CW_GCNT + (l * 32 + tid) * 64, RLX_AGENT);
    __syncthreads();
    if (tid == 0) { int s = 0; for (int e = 0; e < 32; ++e) { bs[e] = s; int c = cnt[e]; if (c > ECAP) c = ECAP; s += (c + 255) >> 8; } if (s > MAXBLK) s = MAXBLK; bs[32] = s; }
    __syncthreads();
    { const int nb = bs[32]; for (int b = tid; b < nb; b += 512) { int e = 0;
#pragma unroll 1
          for (int q = 1; q < 32; ++q) if (bs[q] <= b) e = q;
          be[b] = (unsigned char)e; } }
    __syncthreads();
}
template <int NPN, bool G1> struct MoeOrder {
    int vcu; MoeTables t; const char* A; const char* B; const int* slot_tok;
    __device__ __forceinline__ bool next(int i, pg8::Unit& u) const {
        const int L = i * 256 + vcu, nb = t.bs[32]; if (L >= nb * NPN) return false;
        u.pm = L / NPN; u.pn = L % NPN; u.aux = t.be[u.pm]; return true; }
    __device__ __forceinline__ void operands(const pg8::Unit& u, const char*& a, const char*& b, int& n) const {
        constexpr size_t RB = FP8_MOE ? 1024 : 2048;
        if (G1) { a = A; b = B + ((size_t)u.aux * 2048 + (size_t)u.pn * 256) * RB; }
        else { a = A + (size_t)u.pm * 256 * RB; b = B + ((size_t)u.aux * 1024 + (size_t)u.pn * 256) * RB; }
        n = FP8_MOE ? 8 : 16; }
    __device__ __forceinline__ void gather_issue(const pg8::Unit& u, LAS unsigned* buf, int wid, int lane) const {
        const int e = u.aux, j = u.pm - t.bs[e];
        __builtin_amdgcn_global_load_lds((const unsigned*)(slot_tok + (size_t)e * ECAP + 256 * j + 64 * (wid & 3) + lane), buf + 64 * (wid & 3), 4, 0, 0);
    }
    __device__ __forceinline__ void gather_read(const pg8::Unit& u, const int (&R)[2], const int (&C)[2], unsigned (&vg)[2][2], const LAS unsigned* buf) const {
        const int e = u.aux, j = u.pm - t.bs[e], c = t.cnt[e];
#pragma unroll
        for (int h = 0; h < 2; ++h)
#pragma unroll
            for (int i = 0; i < 2; ++i) { const int r = 128 * h + R[i]; unsigned tok = buf[r]; if (256 * j + r >= c) tok = 0u;
                vg[h][i] = tok * (FP8_MOE ? 1024u : 2048u) + (unsigned)C[i] * 2u; }
    }
};

__device__ __forceinline__ u32x4 pack8(const f32x4& v0, const f32x4& v1) { u32x4 w; w.x = pk2(v0[0], v0[1]); w.y = pk2(v0[2], v0[3]); w.z = pk2(v1[0], v1[1]); w.w = pk2(v1[2], v1[3]); return w; }
__device__ __forceinline__ void unpack8(const u32x4& w, f32x4& v0, f32x4& v1) {
    v0[0] = __uint_as_float(w.x << 16); v0[1] = __uint_as_float(w.x & 0xffff0000u); v0[2] = __uint_as_float(w.y << 16); v0[3] = __uint_as_float(w.y & 0xffff0000u);
    v1[0] = __uint_as_float(w.z << 16); v1[1] = __uint_as_float(w.z & 0xffff0000u); v1[2] = __uint_as_float(w.w << 16); v1[3] = __uint_as_float(w.w & 0xffff0000u); }

__device__ __forceinline__ void unpack8_f8(const u32x2& w, f32x4& v0, f32x4& v1) {
    v0[0] = (float)(w.x & 255u); v0[1] = (float)((w.x >> 8) & 255u); v0[2] = (float)((w.x >> 16) & 255u); v0[3] = (float)(w.x >> 24);
    v1[0] = (float)(w.y & 255u); v1[1] = (float)((w.y >> 8) & 255u); v1[2] = (float)((w.y >> 16) & 255u); v1[3] = (float)(w.y >> 24); }
__device__ __forceinline__ void wide_store16(bf16_t* rowp  , size_t pitch8  , const u32x4& P0, const u32x4& P1) {
    u32x4 S1, S2;
#pragma unroll
    for (int d = 0; d < 4; ++d) { S1[d] = (unsigned)__builtin_amdgcn_update_dpp((int)P0[d], (int)P1[d], 0x128, 0xf, 0xc, false); S2[d] = (unsigned)__builtin_amdgcn_update_dpp((int)P1[d], (int)P0[d], 0x128, 0xf, 0x3, false); }
#ifdef NT_STORES
    __builtin_nontemporal_store(S1, (u32x4*)rowp); __builtin_nontemporal_store(S2, (u32x4*)(rowp + pitch8)); }
#else
    *(u32x4*)rowp = S1; *(u32x4*)(rowp + pitch8) = S2; }
#endif
struct EpiInProj {
    static constexpr bool PERM = true, NODUP = false, F8 = (FP8_IN == 1), I8 = (FP8_IN == 2), ROWAUX = I8, COLAUX = (COL_AUX != 0), WIDE = (WIDE_ST != 0); static constexpr int DUPBIT = 1;
    bf16_t* Z; const float* bgate; const float* rows; float sw_in, sw_gate; const LAS float* rbuf;
    __device__ __forceinline__ void aux_issue(const pg8::Unit& u, LAS unsigned* buf, int wid, int lane) const {
        __builtin_amdgcn_global_load_lds((const unsigned*)(rows + (size_t)u.pm * 256 + 64 * (wid & 3) + lane), buf + 64 * (wid & 3), 4, 0, 0); }
    __device__ __forceinline__ void aux_buf(const LAS unsigned* buf) { rbuf = (const LAS float*)buf; }
    const LAS float* cbuf = nullptr;
    unsigned char* G8 = nullptr;
    __device__ __forceinline__ void caux_issue(const pg8::Unit& u, LAS unsigned* buf, int wid, int lane) const {
        if (u.pn >= 20) __builtin_amdgcn_global_load_lds((const unsigned*)(bgate + (u.pn - 20) * 256 + 64 * (wid & 3) + lane), buf + 64 * (wid & 3), 4, 0, 0); }
    __device__ __forceinline__ void caux_buf(const LAS unsigned* buf) { cbuf = (const LAS float*)buf; }
#ifdef PROBE_SKIP_EPI
    int skip = 0;
#endif
    __device__ __forceinline__ bool keep(const pg8::Unit&) const { return false; }
    __device__ __forceinline__ void operator()(f32x4 (&acc)[2][2][4][2], const pg8::Unit& u, int wr, int wc, int fr, int fq) const {
#ifdef PROBE_SKIP_EPI
        if (skip == 1) return;
#endif
        const int row0 = u.pm * 256 + wr * 64 + fr, col0 = u.pn * 256 + (WIDE ? wc * 64 : wc * 32) + 8 * fq; constexpr int BJ = WIDE ? 32 : 128;
        const int mode = (u.pn >= 20) ? 2 : ((u.pn < 2 || (u.pn >= 6 && u.pn < 8)) ? 1 : 0);
        f32x4 bv[2][2];
#pragma unroll
        for (int bj = 0; bj < 2; ++bj)
#pragma unroll
            for (int n = 0; n < 2; ++n) bv[bj][n] = (mode == 2) ? (COLAUX ? *(const LAS f32x4*)(cbuf + (col0 - u.pn * 256) + bj * BJ + 4 * n) : *(const f32x4*)(bgate + (col0 - ZC_G) + bj * BJ + 4 * n)) : (f32x4){0.f, 0.f, 0.f, 0.f};
        const float sc = (mode == 1) ? C2 : 1.0f;
        constexpr float dq = F8 ? 1.0f / (Q_H1 * Q_WIN) : 1.0f;
        float rsc[2][4];
        if constexpr (I8) { const float sw = ((mode == 2) ? sw_gate : sw_in) * sc;
#pragma unroll
            for (int ai = 0; ai < 2; ++ai)
#pragma unroll
                for (int m = 0; m < 4; ++m) rsc[ai][m] = rbuf[wr * 64 + fr + ai * 128 + m * 16] * sw; }
#pragma unroll
        for (int ai = 0; ai < 2; ++ai)
#pragma unroll
            for (int m = 0; m < 4; ++m) { bf16_t* rowp = Z + (size_t)(row0 + ai * 128 + m * 16) * ZP + col0; u32x4 P[2]; u32x2 GQ[2] = {{0u, 0u}, {0u, 0u}};
#pragma unroll
                for (int bj = 0; bj < 2; ++bj) { f32x4 v0, v1;
                    if constexpr (I8) { f32x4 c0, c1;
#pragma unroll
                        for (int i = 0; i < 4; ++i) { c0[i] = (float)__float_as_int(acc[ai][bj][m][0][i]); c1[i] = (float)__float_as_int(acc[ai][bj][m][1][i]); }
                        v0 = c0 * rsc[ai][m] + bv[bj][0]; v1 = c1 * rsc[ai][m] + bv[bj][1]; }
                    else { v0 = acc[ai][bj][m][0] * (dq * sc) + bv[bj][0]; v1 = acc[ai][bj][m][1] * (dq * sc) + bv[bj][1]; }
                    if (mode == 2) { const f32x4 t0 = v0 * (-LOG2E), t1 = v1 * (-LOG2E); f32x4 e0, e1;
#pragma unroll
                        for (int i = 0; i < 4; ++i) { e0[i] = fexp2(t0[i]); e1[i] = fexp2(t1[i]); }
                        e0 = e0 + 1.0f; e1 = e1 + 1.0f;
#pragma unroll
                        for (int i = 0; i < 4; ++i) { v0[i] = frcp(e0[i]); v1[i] = frcp(e1[i]); } }
                    if (FP8_G && WIDE && mode == 2) { const f32x4 g0 = v0 * Q_G, g1 = v1 * Q_G; GQ[bj].x = pk4_u8(g0[0], g0[1], g0[2], g0[3]); GQ[bj].y = pk4_u8(g1[0], g1[1], g1[2], g1[3]); }
                    P[bj] = pack8(v0, v1);
                    if constexpr (!WIDE) *(u32x4*)(rowp + bj * 128) = P[bj]; }
#ifdef PROBE_SKIP_EPI
                if (skip == 2) { asm volatile("" :: "v"(P[0]), "v"(P[1])); } else
                if (skip == 3) { wide_store16((bf16_t*)((unsigned char*)Z + 641ull * 1048576ull) + (size_t)((wr * 64 + ai * 128 + m * 16 + (fr & 7)) & 63) * ZP + col0 + 32 * (fr >> 3), (size_t)8 * ZP, P[0], P[1]); } else
#endif
                if (FP8_G && WIDE && mode == 2) {
                    const auto r0 = __builtin_amdgcn_permlane16_swap(GQ[1].x, GQ[0].x, false, false), r1 = __builtin_amdgcn_permlane16_swap(GQ[1].y, GQ[0].y, false, false);
                    u32x4 w; w.x = r0[0]; w.y = r1[0]; w.z = r0[1]; w.w = r1[1];
                    *(u32x4*)(G8 + (size_t)(row0 + ai * 128 + m * 16) * G8P + (u.pn - 20) * 256 + wc * 64 + ((fq & 1) ? 8 * (fq - 1) : 32 + 8 * fq)) = w; }
                else
                if constexpr (WIDE) wide_store16(Z + (size_t)(u.pm * 256 + wr * 64 + ai * 128 + m * 16 + (fr & 7)) * ZP + col0 + 32 * (fr >> 3), (size_t)8 * ZP, P[0], P[1]); }
    }
};
struct EpiMerge {
    static constexpr bool PERM = true, NODUP = true, F8 = (FP8_MRG != 0), I8 = false, ROWAUX = false, COLAUX = false, WIDE = false; static constexpr int DUPBIT = 0;
    const bf16_t* Z; bf16_t* MG; const bf16_t* ONES;
    __device__ __forceinline__ bool keep(const pg8::Unit& u) const { return u.aux != 2; }
    __device__ __forceinline__ void operator()(f32x4 (&acc)[2][2][4][2], const pg8::Unit& u, int wr, int wc, int fr, int fq) const {
        const int row0 = u.pm * 256 + wr * 64 + fr, col0 = u.pn * 256 + wc * 32 + 8 * fq, seg = u.aux;
        const bool fin = (seg == 2);
        const char* nb = (const char*)Z; const char* db = fin ? (const char*)ONES : (const char*)Z;
        constexpr unsigned GP = FP8_G ? (unsigned)G8P : (unsigned)ZP * 2u, GB = FP8_G ? 1u : 2u;
        const unsigned on0 = (unsigned)row0 * GP + ((FP8_G ? 0 : ZC_G) + seg * 1024 + col0) * GB;
        const unsigned od0 = fin ? (unsigned)(8 * fq) * GB : (unsigned)row0 * GP + ((FP8_G ? 0 : ZC_G) + (seg + 1) * 1024 + col0) * GB;
        const unsigned dmul = fin ? 0u : 1u;
#pragma unroll
        for (int ai = 0; ai < 2; ++ai)
#pragma unroll
          for (int mh = 0; mh < 2; ++mh) {
            u32x4 gw[2][2], dw[2][2]; u32x2 g8[2][2], d8[2][2];
#pragma unroll
            for (int mm = 0; mm < 2; ++mm)
#pragma unroll
                for (int bj = 0; bj < 2; ++bj) { const unsigned ad = (unsigned)(ai * 128 + (2 * mh + mm) * 16) * GP + (unsigned)(bj * 128) * GB;
                    if (FP8_G) { g8[mm][bj] = *(const u32x2*)(nb + (size_t)(on0 + ad)); d8[mm][bj] = *(const u32x2*)(db + (size_t)(od0 + ad * dmul)); }
                    else { gw[mm][bj] = *(const u32x4*)(nb + (size_t)(on0 + ad)); dw[mm][bj] = *(const u32x4*)(db + (size_t)(od0 + ad * dmul)); } }
#pragma unroll
            for (int mm = 0; mm < 2; ++mm)
#pragma unroll
                for (int bj = 0; bj < 2; ++bj) { const int m = 2 * mh + mm; f32x4 n0, n1, d0, d1;
                    if (FP8_G) { unpack8_f8(g8[mm][bj], n0, n1); unpack8_f8(d8[mm][bj], d0, d1); } else { unpack8(gw[mm][bj], n0, n1); unpack8(dw[mm][bj], d0, d1); }
#pragma unroll
                    for (int i = 0; i < 4; ++i) { n0[i] = fmaxf(n0[i], 1e-18f) * frcp(fmaxf(d0[i], 1e-18f)); n1[i] = fmaxf(n1[i], 1e-18f) * frcp(fmaxf(d1[i], 1e-18f)); }
                    acc[ai][bj][m][0] = acc[ai][bj][m][0] * n0; acc[ai][bj][m][1] = acc[ai][bj][m][1] * n1; }
            asm volatile("" ::: "memory");
          }
        if (fin) {
#pragma unroll
            for (int ai = 0; ai < 2; ++ai)
#pragma unroll
                for (int m = 0; m < 4; ++m) { bf16_t* rowp = MG + (size_t)(row0 + ai * 128 + m * 16) * D + col0;
#pragma unroll
                    for (int bj = 0; bj < 2; ++bj) { constexpr float dq = F8 ? 1.0f / (Q_O * Q_WP) : 1.0f; *(u32x4*)(rowp + bj * 128) = pack8(acc[ai][bj][m][0] * dq, acc[ai][bj][m][1] * dq); } } }
    }
};
struct EpiBf16 {
    static constexpr bool PERM = true, NODUP = false, F8 = false, I8 = false, ROWAUX = false, COLAUX = false, WIDE = (WIDE_ST != 0); static constexpr int DUPBIT = 2;
    bf16_t* C; int ldc;
    __device__ __forceinline__ bool keep(const pg8::Unit&) const { return false; }
    __device__ __forceinline__ void operator()(f32x4 (&acc)[2][2][4][2], const pg8::Unit& u, int wr, int wc, int fr, int fq) const {
        const int row0 = u.pm * 256 + wr * 64 + fr, col0 = u.pn * 256 + (WIDE ? wc * 64 : wc * 32) + 8 * fq;
#pragma unroll
        for (int ai = 0; ai < 2; ++ai)
#pragma unroll
            for (int m = 0; m < 4; ++m) {
                if constexpr (WIDE) wide_store16(C + (size_t)(u.pm * 256 + wr * 64 + ai * 128 + m * 16 + (fr & 7)) * ldc + col0 + 32 * (fr >> 3), (size_t)8 * ldc, pack8(acc[ai][0][m][0], acc[ai][0][m][1]), pack8(acc[ai][1][m][0], acc[ai][1][m][1]));
                else { bf16_t* rowp = C + (size_t)(row0 + ai * 128 + m * 16) * ldc + col0;
#pragma unroll
                for (int bj = 0; bj < 2; ++bj) *(u32x4*)(rowp + bj * 128) = pack8(acc[ai][bj][m][0], acc[ai][bj][m][1]); } }
    }
};
struct EpiGU {
    static constexpr bool PERM = true, NODUP = false, F8 = (FP8_MOE != 0), I8 = false, ROWAUX = false, COLAUX = (COL_AUX != 0), WIDE = false; static constexpr int DUPBIT = 4;
    unsigned char* ACT; const float* bgu;
    const LAS float* cbuf = nullptr;
    __device__ __forceinline__ void caux_issue(const pg8::Unit& u, LAS unsigned* buf, int wid, int lane) const {
        const int w = wid & 3; __builtin_amdgcn_global_load_lds((const unsigned*)(bgu + (size_t)u.aux * 2048 + (w >> 1) * 1024 + u.pn * 128 + (w & 1) * 64 + lane), buf + 64 * w, 4, 0, 0); }
    __device__ __forceinline__ void caux_buf(const LAS unsigned* buf) { cbuf = (const LAS float*)buf; }
    __device__ __forceinline__ bool keep(const pg8::Unit&) const { return false; }
    __device__ __forceinline__ void operator()(f32x4 (&acc)[2][2][4][2], const pg8::Unit& u, int wr, int wc, int fr, int fq) const {
        const int row0 = u.pm * 256 + wr * 64 + fr, cc = u.pn * 128 + wc * 32 + 8 * fq;
        const float* bg = bgu + (size_t)u.aux * 2048 + cc;
        f32x4 bg0, bg1, bu0, bu1;
        if constexpr (COLAUX) { const LAS float* cb = cbuf + wc * 32 + 8 * fq; bg0 = *(const LAS f32x4*)cb; bg1 = *(const LAS f32x4*)(cb + 4); bu0 = *(const LAS f32x4*)(cb + 128); bu1 = *(const LAS f32x4*)(cb + 132); }
        else { bg0 = *(const f32x4*)bg; bg1 = *(const f32x4*)(bg + 4); bu0 = *(const f32x4*)(bg + 1024); bu1 = *(const f32x4*)(bg + 1028); }
        float dq = F8 ? 1.0f / (Q_H2 * Q_WGU) : 1.0f; asm volatile("" : "+s"(dq));
#pragma unroll
        for (int ai = 0; ai < 2; ++ai)
#pragma unroll
            for (int m = 0; m < 4; ++m) {
                f32x4 o0, o1;
                { const f32x4 g = acc[ai][0][m][0] * dq + bg0, uu = acc[ai][1][m][0] * dq + bu0; f32x4 ga, up, e;
#pragma unroll
                  for (int i = 0; i < 4; ++i) { ga[i] = fminf(g[i], 7.0f); up[i] = fminf(fmaxf(uu[i], -7.0f), 7.0f); }
                  const f32x4 t = ga * (-1.702f * LOG2E);
#pragma unroll
                  for (int i = 0; i < 4; ++i) e[i] = fexp2(t[i]);
                  const f32x4 dn = e + 1.0f; f32x4 r;
#pragma unroll
                  for (int i = 0; i < 4; ++i) r[i] = frcp(dn[i]);
                  o0 = (up + 1.0f) * (ga * r); }
                { const f32x4 g = acc[ai][0][m][1] * dq + bg1, uu = acc[ai][1][m][1] * dq + bu1; f32x4 ga, up, e;
#pragma unroll
                  for (int i = 0; i < 4; ++i) { ga[i] = fminf(g[i], 7.0f); up[i] = fminf(fmaxf(uu[i], -7.0f), 7.0f); }
                  const f32x4 t = ga * (-1.702f * LOG2E);
#pragma unroll
                  for (int i = 0; i < 4; ++i) e[i] = fexp2(t[i]);
                  const f32x4 dn = e + 1.0f; f32x4 r;
#pragma unroll
                  for (int i = 0; i < 4; ++i) r[i] = frcp(dn[i]);
                  o1 = (up + 1.0f) * (ga * r); }
                if constexpr (F8) { const f32x4 q0 = o0 * Q_ACT, q1 = o1 * Q_ACT; u32x2 w; w.x = pk4_f8_nc(q0[0], q0[1], q0[2], q0[3]); w.y = pk4_f8_nc(q1[0], q1[1], q1[2], q1[3]);
                    *(u32x2*)(ACT + (size_t)(row0 + ai * 128 + m * 16) * D + cc) = w; }
                else *(u32x4*)((bf16_t*)ACT + (size_t)(row0 + ai * 128 + m * 16) * D + cc) = pack8(o0, o1); }
    }
};
struct EpiDown {
    static constexpr bool PERM = true, NODUP = false, F8 = (FP8_MOE != 0), I8 = false, ROWAUX = false, COLAUX = (COL_AUX != 0), WIDE = (WIDE_ST != 0 && FP8_YB != 0); static constexpr int DUPBIT = 8;
    unsigned char* YB; const float* bdn;
    const LAS float* cbuf = nullptr;
    __device__ __forceinline__ void caux_issue(const pg8::Unit& u, LAS unsigned* buf, int wid, int lane) const {
        __builtin_amdgcn_global_load_lds((const unsigned*)(bdn + (size_t)u.aux * D + u.pn * 256 + 64 * (wid & 3) + lane), buf + 64 * (wid & 3), 4, 0, 0); }
    __device__ __forceinline__ void caux_buf(const LAS unsigned* buf) { cbuf = (const LAS float*)buf; }
    __device__ __forceinline__ bool keep(const pg8::Unit&) const { return false; }
    __device__ __forceinline__ void operator()(f32x4 (&acc)[2][2][4][2], const pg8::Unit& u, int wr, int wc, int fr, int fq) const {
        const int row0 = u.pm * 256 + wr * 64 + fr, col0 = u.pn * 256 + (WIDE ? wc * 64 : wc * 32) + 8 * fq; constexpr int BJ = WIDE ? 32 : 128;
        const float* bp = bdn + (size_t)u.aux * D + col0;
        f32x4 bv[2][2];
        constexpr float dq = (F8 ? 1.0f / (Q_ACT * Q_WDN) : 1.0f) * (FP8_YB ? Q_YB : 1.0f);
#pragma unroll
        for (int bj = 0; bj < 2; ++bj)
#pragma unroll
            for (int n = 0; n < 2; ++n) bv[bj][n] = (COLAUX ? *(const LAS f32x4*)(cbuf + (col0 - u.pn * 256) + bj * BJ + 4 * n) : *(const f32x4*)(bp + bj * BJ + 4 * n)) * (FP8_YB ? Q_YB : 1.0f);
#pragma unroll
        for (int ai = 0; ai < 2; ++ai)
#pragma unroll
            for (int m = 0; m < 4; ++m) {
                if constexpr (FP8_YB != 0) { unsigned char* rowp = YB + (size_t)(row0 + ai * 128 + m * 16) * D + col0; u32x2 Q[2];
#pragma unroll
                    for (int bj = 0; bj < 2; ++bj) { const f32x4 v0 = acc[ai][bj][m][0] * dq + bv[bj][0], v1 = acc[ai][bj][m][1] * dq + bv[bj][1];
                        Q[bj].x = pk4_f8(v0[0], v0[1], v0[2], v0[3]); Q[bj].y = pk4_f8(v1[0], v1[1], v1[2], v1[3]); if constexpr (!WIDE) *(u32x2*)(rowp + bj * 128) = Q[bj]; }
                    if constexpr (WIDE) {
                        const auto r0 = __builtin_amdgcn_permlane16_swap(Q[1].x, Q[0].x, false, false), r1 = __builtin_amdgcn_permlane16_swap(Q[1].y, Q[0].y, false, false);
                        u32x4 w; w.x = r0[0]; w.y = r1[0]; w.z = r0[1]; w.w = r1[1];
                        *(u32x4*)(YB + (size_t)(row0 + ai * 128 + m * 16) * D + u.pn * 256 + wc * 64 + ((fq & 1) ? 8 * (fq - 1) : 32 + 8 * fq)) = w; } }
                else { bf16_t* rowp = (bf16_t*)YB + (size_t)(row0 + ai * 128 + m * 16) * D + col0;
#pragma unroll
                for (int bj = 0; bj < 2; ++bj) *(u32x4*)(rowp + bj * 128) = pack8(acc[ai][bj][m][0] * dq + bv[bj][0], acc[ai][bj][m][1] * dq + bv[bj][1]); } }
    }
};

__device__ __forceinline__ void fcumsum_wave(const AR a, int bh, int lane) {
    const int b = bh >> 3, h = bh & 7;
    const float* logf = (const float*)(a.ws() + WS_LOGF) + ((size_t)b * SEQ + 32 * lane) * 8 + h;
    float v[32]; float run = 0.f;
#pragma unroll
    for (int i = 0; i < 32; ++i) { run += logf[i * 8]; v[i] = run; }
    float inc = run;
#pragma unroll
    for (int o = 1; o < 64; o <<= 1) { const float t = shup(lane, inc, o); if (lane >= o) inc += t; }
    const float base = inc - run;
    float* F2 = (float*)(a.ws() + WS_F2) + (size_t)bh * SEQ + 32 * lane;
#pragma unroll
    for (int i = 0; i < 32; i += 4) { f32x4 o = {(base + v[i]) * LOG2E, (base + v[i + 1]) * LOG2E, (base + v[i + 2]) * LOG2E, (base + v[i + 3]) * LOG2E}; *(f32x4*)(F2 + i) = o; }
}

__device__ __forceinline__ int crow(int r, int hi) { return (r & 3) + 8 * (r >> 2) + 4 * hi; }
#define MFMA32(a, b, c) __builtin_amdgcn_mfma_f32_32x32x16_bf16(a, b, c, 0, 0, 0)

constexpr int LRU_WB = 13312;
constexpr int LRU_CW = 8 * LRU_WB;
constexpr int LRU_BF = LRU_CW + 2048;
__device__ __forceinline__ void lru_unit(const AR a, int l, int b, int n, LAS unsigned char* lds, int tid, int wave, int lane) {
    const int r32 = lane & 31, hi = lane >> 5;
    LAS unsigned char* wb = lds + wave * LRU_WB;
    LAS unsigned short* XS = (LAS unsigned short*)wb; LAS unsigned short* GS = (LAS unsigned short*)(wb + 8704); LAS unsigned short* OS = XS; LAS float* XF = (LAS float*)wb;
    LAS unsigned char* BF = lds + LRU_BF;
    LAS float* CWT = (LAS float*)(lds + LRU_CW); LAS float* CBT = CWT + 256;
    LAS float* CAR = (LAS float*)(lds + MISC_OFF + MO_CAR);
    const bf16_t* Z = (const bf16_t*)(a.ws() + WS_Z); bf16_t* O = (bf16_t*)(a.ws() + WS_O);
    const int chb = n * 64;
    __syncthreads();
    if (tid < 256) CWT[tid] = a.in(I_CONVW)[(size_t)l * 4 * D + (tid >> 6) * D + chb + (tid & 63)];
    else if (tid < 320) CBT[tid - 256] = a.in(I_CONVB)[(size_t)l * D + chb + (tid - 256)];
#pragma unroll
    for (int q = 0; q < 2; ++q) { const int f = 2 * wave + q, mat = f >> 3, ks = (f >> 1) & 3, nt = f & 1, d = 32 * nt + r32, c0 = 16 * ks + 8 * hi;
        const float* w = a.in(mat ? I_WX : I_WA) + ((size_t)l * 16 + n) * 4096; u32x4 p;
        p.x = pk2(w[(c0 + 0) * 64 + d], w[(c0 + 1) * 64 + d]); p.y = pk2(w[(c0 + 2) * 64 + d], w[(c0 + 3) * 64 + d]); p.z = pk2(w[(c0 + 4) * 64 + d], w[(c0 + 5) * 64 + d]); p.w = pk2(w[(c0 + 6) * 64 + d], w[(c0 + 7) * 64 + d]);
        *(LAS u32x4*)(BF + f * 1024 + lane * 16) = p; }
    float ba[2], bx[2], cl[2], csup[2];
    { const float* pba = a.in(I_BA) + (size_t)l * D + chb + r32; const float* pbx = a.in(I_BX) + (size_t)l * D + chb + r32; const float* plm = a.in(I_LAM) + (size_t)l * D + chb + r32;
      const float ba0 = pba[0], ba1 = pba[32], bx0 = pbx[0], bx1 = pbx[32], lm0 = plm[0], lm1 = plm[32];
      ba[0] = ba0; ba[1] = ba1; bx[0] = bx0; bx[1] = bx1; csup[0] = 0.f; csup[1] = 0.f;
      cl[0] = -8.0f * (fmaxf(-lm0, 0.f) + 0.6931471806f * flog2(1.0f + fexp2(-LOG2E * fabsf(lm0))));
      cl[1] = -8.0f * (fmaxf(-lm1, 0.f) + 0.6931471806f * flog2(1.0f + fexp2(-LOG2E * fabsf(lm1)))); }
    __syncthreads();
    int par = 0;
    u32x4 xsr[5], gsr[4];
#define LRU_LOADROWS(S) do { const int t0_ = 256 * (S) + 32 * wave; const size_t m0_ = (size_t)b * SEQ + t0_; \
        _Pragma("unroll") for (int it = 0; it < 5; ++it) { const int c = lane + 64 * it; const int rr = c >> 3, c8 = c & 7; xsr[it] = (u32x4){0u, 0u, 0u, 0u}; \
            if (c < 280 && t0_ - 3 + rr >= 0) xsr[it] = *(const u32x4*)(Z + (m0_ - 3 + rr) * ZP + ZC_XC + chb + 8 * c8); } \
        _Pragma("unroll") for (int it = 0; it < 4; ++it) { const int c = lane + 64 * it; const int rr = c >> 3, c8 = c & 7; gsr[it] = *(const u32x4*)(Z + (m0_ + rr) * ZP + ZC_GC + chb + 8 * c8); } } while (0)
    LRU_LOADROWS(0);
    for (int s = 0; s < 8; ++s) {
        const int t0 = 256 * s + 32 * wave; const size_t m0 = (size_t)b * SEQ + t0;
#pragma unroll
        for (int it = 0; it < 5; ++it) { const int c = lane + 64 * it; if (c < 280) { const int rr = c >> 3, c8 = c & 7; *(LAS u32x4*)((LAS unsigned char*)XS + rr * 144 + c8 * 16) = xsr[it]; } }
#pragma unroll
        for (int it = 0; it < 4; ++it) { const int c = lane + 64 * it; const int rr = c >> 3, c8 = c & 7; *(LAS u32x4*)((LAS unsigned char*)GS + rr * 144 + c8 * 16) = gsr[it]; }
        if (s < 7) LRU_LOADROWS(s + 1);
        LDS_WAIT(); asm volatile("" ::: "memory");
        f32x16 accA[2], accX[2];
#pragma unroll
        for (int nt = 0; nt < 2; ++nt) { accA[nt] = f32x16{}; accX[nt] = f32x16{}; }
        f32x4 xo[4][2];
#pragma unroll
        for (int ks = 0; ks < 4; ++ks) { const int c0 = 16 * ks + 8 * hi;
            f32x4 o0 = *(const LAS f32x4*)(CBT + c0), o1 = *(const LAS f32x4*)(CBT + c0 + 4);
#pragma unroll
            for (int j = 0; j < 4; ++j) { const u32x4 xw = *(const LAS u32x4*)((LAS unsigned char*)XS + (r32 + j) * 144 + c0 * 2); f32x4 x0, x1; unpack8(xw, x0, x1);
                const f32x4 w0 = *(const LAS f32x4*)(CWT + j * 64 + c0), w1 = *(const LAS f32x4*)(CWT + j * 64 + c0 + 4);
                o0 = o0 + x0 * w0; o1 = o1 + x1 * w1; }
            xo[ks][0] = o0; xo[ks][1] = o1;
            const bf16x8 af = __builtin_bit_cast(bf16x8, pack8(o0, o1));
#pragma unroll
            for (int nt = 0; nt < 2; ++nt) { const bf16x8 bwa = *(const LAS bf16x8*)(BF + (ks * 2 + nt) * 1024 + lane * 16), bwx = *(const LAS bf16x8*)(BF + (8 + ks * 2 + nt) * 1024 + lane * 16);
                accA[nt] = MFMA32(af, bwa, accA[nt]); accX[nt] = MFMA32(af, bwx, accX[nt]); } }
        LDS_WAIT(); asm volatile("" ::: "memory");
#pragma unroll
        for (int ks = 0; ks < 4; ++ks) { const int c0 = 16 * ks + 8 * hi; *(LAS f32x4*)(XF + r32 * 68 + c0) = xo[ks][0]; *(LAS f32x4*)(XF + r32 * 68 + c0 + 4) = xo[ks][1]; }
        LDS_WAIT(); asm volatile("" ::: "memory");
        float av[2][16], uv[2][16], TA[2], TH[2];
#pragma unroll
        for (int nt = 0; nt < 2; ++nt) { const int d = 32 * nt + r32;
#pragma unroll
            for (int r = 0; r < 16; ++r) { const int row = crow(r, hi);
                const float xc = XF[row * 68 + d];
                const float rg = fsigmoid(accA[nt][r] + ba[nt]), ig = fsigmoid(accX[nt][r] + bx[nt]);
                const float la = cl[nt] * rg, aa = fexp2(la * LOG2E), x2 = 2.0f * la;
                const float om = (x2 > -0.1f) ? -x2 * (1.0f + x2 * (0.5f + x2 * (0.16666667f + x2 * 0.041666668f))) : 1.0f - aa * aa;
                av[nt][r] = aa; uv[nt][r] = sqrtf(om) * (ig * xc);
                if ((r & 3) == 3) asm volatile("" ::: "memory"); }
            float GA[4], GH[4], oA[4], oH[4], cown[4], pown[4];
#pragma unroll
            for (int gi = 0; gi < 4; ++gi) { float hh = 0.f, pp = 1.f;
#pragma unroll
                for (int q = 0; q < 4; ++q) { const int r = 4 * gi + q; hh = av[nt][r] * hh + uv[nt][r]; pp = pp * av[nt][r]; uv[nt][r] = hh; av[nt][r] = pp; }
                GA[gi] = pp; GH[gi] = hh; oA[gi] = shx(lane, pp, 32); oH[gi] = shx(lane, hh, 32); cown[gi] = 0.f; pown[gi] = 1.f; }
            float cin = 0.f, pin = 1.f;
#pragma unroll
            for (int tg = 0; tg < 8; ++tg) { const int gi = tg >> 1; const bool own = ((tg & 1) == hi);
                const float A = own ? GA[gi] : oA[gi], H = own ? GH[gi] : oH[gi];
                cown[gi] = own ? cin : cown[gi]; pown[gi] = own ? pin : pown[gi];
                cin = A * cin + H; pin = A * pin; }
#pragma unroll
            for (int r = 0; r < 16; ++r) { uv[nt][r] = uv[nt][r] + av[nt][r] * cown[r >> 2]; av[nt][r] = av[nt][r] * pown[r >> 2]; }
            TA[nt] = pin; TH[nt] = cin;
            if (hi == 0) { CAR[((par * 8 + wave) * 64 + d) * 2] = pin; CAR[((par * 8 + wave) * 64 + d) * 2 + 1] = cin; } }
        __syncthreads();
#pragma unroll
        for (int nt = 0; nt < 2; ++nt) { const int d = 32 * nt + r32; float cw = csup[nt], call = csup[nt];
#pragma unroll
            for (int w2 = 0; w2 < 8; ++w2) { const f32x2 ah = *(const LAS f32x2*)(CAR + ((par * 8 + w2) * 64 + d) * 2);
                call = ah[0] * call + ah[1]; if (w2 < wave) cw = call; }
            csup[nt] = call;
#pragma unroll
            for (int r = 0; r < 16; ++r) { const int row = crow(r, hi);
                const float hf = uv[nt][r] + av[nt][r] * cw;
                const float g = bf2f((unsigned)GS[row * 72 + d]);
                const float ge = g * fsigmoid(1.5957691216f * (g + 0.044715f * g * g * g));
                if (FP8_MRG) ((LAS unsigned char*)OS)[row * 80 + d] = f8_byte(hf * ge * Q_O); else OS[row * 72 + d] = (unsigned short)f2bf(hf * ge); } }
        LDS_WAIT(); asm volatile("" ::: "memory");
        if (FP8_MRG) {
#pragma unroll
            for (int it = 0; it < 2; ++it) { const int c = lane + 64 * it; const int rr = c >> 2, c4 = c & 3;
                *(u32x4*)((unsigned char*)O + (m0 + rr) * OP + 1024 + chb + 16 * c4) = *(const LAS u32x4*)((LAS unsigned char*)OS + rr * 80 + c4 * 16); } }
        else {
#pragma unroll
        for (int it = 0; it < 4; ++it) { const int c = lane + 64 * it; const int rr = c >> 3, c8 = c & 7;
            *(u32x4*)(O + (m0 + rr) * OP + 1024 + chb + 8 * c8) = *(const LAS u32x4*)((LAS unsigned char*)OS + rr * 144 + c8 * 16); } }
        par ^= 1;
    }
}

constexpr int AT_KS = 0, AT_VT = 9216, AT_FS = 17920, AT_WSF = 18432, AT_FLAG = 20480;
template <int MODE>
__device__ __forceinline__ void attn_unit(const AR a, int b, int h, int qb, LAS unsigned char* lds, int tid, int wave, int lane) {
    const int r32 = lane & 31, hi = lane >> 5;
    const bf16_t* Z = (const bf16_t*)(a.ws() + WS_Z); bf16_t* O = (bf16_t*)(a.ws() + WS_O);
    const float* F2 = (const float*)(a.ws() + WS_F2) + (size_t)(b * 8 + h) * SEQ;
    const size_t rowbase = (size_t)b * SEQ; const int q0 = qb * 256, qw0 = q0 + 32 * wave, q = qw0 + r32;
    const int qcol = (MODE == 0 ? ZC_QA : ZC_QB) + h * 64, kcol = (MODE == 0 ? ZC_KA : ZC_KB) + h * 64, vcol = (MODE == 0 ? ZC_VA : ZC_VB) + h * 64, ocol = (MODE == 0 ? 0 : 512) + h * 64;
    LAS unsigned char* KS = lds + AT_KS; LAS unsigned short* VT = (LAS unsigned short*)(lds + AT_VT); LAS float* FS = (LAS float*)(lds + AT_FS);
    LAS float* wsf = (LAS float*)(lds + AT_WSF) + wave * 64; LAS int* flags = (LAS int*)(lds + AT_FLAG);
    bf16x8 qr[4];
#pragma unroll
    for (int ks = 0; ks < 4; ++ks) qr[ks] = *(const bf16x8*)(Z + (rowbase + q) * ZP + qcol + 16 * ks + 8 * hi);
    const float fq = (MODE == 0) ? F2[q] : 0.f;
    f32x16 o0 = f32x16{}, o1 = f32x16{};
    float mrun = -INFINITY, lsum = 0.f, R = 0.f;
    const int NT = 4 * qb + 4;
    const int lkey = tid >> 3, lch = tid & 7;
    const bf16_t* kp = Z + (rowbase + lkey) * ZP + kcol + 8 * lch; const bf16_t* vp = Z + (rowbase + lkey) * ZP + vcol + 8 * lch;
    u32x4 kreg = *(const u32x4*)(kp + (size_t)(NT - 1) * 64 * ZP), vreg = *(const u32x4*)(vp + (size_t)(NT - 1) * 64 * ZP);
    float freg = 0.f; if (MODE == 0 && tid < 64) freg = F2[(NT - 1) * 64 + tid];
    bool wdone = false;
    __syncthreads();
    for (int jt = NT - 1; jt >= 0; --jt) {
        *(LAS u32x4*)(KS + lkey * 144 + lch * 16) = kreg;
        { const unsigned vv[4] = {vreg.x, vreg.y, vreg.z, vreg.w};
#pragma unroll
          for (int i = 0; i < 4; ++i) { VT[(8 * lch + 2 * i) * 68 + lkey] = (unsigned short)(vv[i] & 0xffffu); VT[(8 * lch + 2 * i + 1) * 68 + lkey] = (unsigned short)(vv[i] >> 16); } }
        if (MODE == 0 && tid < 64) FS[tid] = freg;
        if (MODE == 1 && lane == 0) flags[wave] = wdone ? 1 : 0;
        __syncthreads();
        if (MODE == 1) { int all = 1;
#pragma unroll
            for (int w2 = 0; w2 < 8; ++w2) all &= flags[w2];
            if (all) break; }
        if (jt > 0) { kreg = *(const u32x4*)(kp + (size_t)(jt - 1) * 64 * ZP); vreg = *(const u32x4*)(vp + (size_t)(jt - 1) * 64 * ZP); if (MODE == 0 && tid < 64) freg = F2[(jt - 1) * 64 + tid]; }
        const int k0 = jt * 64;
        const bool active = (MODE == 0) ? (k0 <= qw0 + 31) : ((k0 < qw0 + 31) && !wdone);
        if (active) {
            f32x16 p0 = f32x16{}, p1 = f32x16{};
#pragma unroll
            for (int ks = 0; ks < 4; ++ks) { const bf16x8 ka = *(const LAS bf16x8*)(KS + r32 * 144 + (16 * ks + 8 * hi) * 2), kb = *(const LAS bf16x8*)(KS + (r32 + 32) * 144 + (16 * ks + 8 * hi) * 2);
                p0 = MFMA32(ka, qr[ks], p0); p1 = MFMA32(kb, qr[ks], p1); }
            if (MODE == 0) {
                float rm = -INFINITY;
#pragma unroll
                for (int g = 0; g < 4; ++g) { const f32x4 f0 = *(const LAS f32x4*)(FS + 8 * g + 4 * hi), f1 = *(const LAS f32x4*)(FS + 32 + 8 * g + 4 * hi);
#pragma unroll
                    for (int i = 0; i < 4; ++i) { const int r = 4 * g + i, kv = k0 + 8 * g + 4 * hi + i;
                        float s0 = p0[r] + (fq - f0[i]), s1 = p1[r] + (fq - f1[i]);
                        if (kv > q) s0 = -INFINITY; if (kv + 32 > q) s1 = -INFINITY;
                        p0[r] = s0; p1[r] = s1; rm = fmaxf(rm, fmaxf(s0, s1)); } }
                rm = fmaxf(rm, shx(lane, rm, 32));
                const float mnew = fmaxf(mrun, rm), alpha = fexp2(mrun - mnew); mrun = mnew;
                float ls = 0.f;
#pragma unroll
                for (int r = 0; r < 16; ++r) { p0[r] = fexp2(p0[r] - mnew); p1[r] = fexp2(p1[r] - mnew); ls += p0[r] + p1[r]; }
                lsum = lsum * alpha + ls;
                if (hi == 0) wsf[r32] = alpha;
                LDS_WAIT(); asm volatile("" ::: "memory");
#pragma unroll
                for (int r = 0; r < 16; ++r) { const float f = wsf[crow(r, hi)]; o0[r] *= f; o1[r] *= f; }
            } else {
                float lg[8], rG[8], P1[8], P2[8], P3[8], oL[8];
#pragma unroll
                for (int r = 0; r < 16; ++r) { const int kv = k0 + crow(r, hi);
                    const float e0 = fexp2(fminf(p0[r], 30.0f)), e1 = fexp2(fminf(p1[r], 30.0f));
                    p0[r] = (kv < q) ? e0 : 0.f; p1[r] = (kv + 32 < q) ? e1 : 0.f; }
#pragma unroll
                for (int g = 0; g < 4; ++g) {
                    { const float d0 = 1.0f + p0[4 * g], d1 = 1.0f + p0[4 * g + 1], d2 = 1.0f + p0[4 * g + 2], d3 = 1.0f + p0[4 * g + 3];
                      P1[g] = d0; P2[g] = d0 * d1; P3[g] = P2[g] * d2; const float G = P3[g] * d3; lg[g] = flog2(G); rG[g] = frcp(G); }
                    { const float d0 = 1.0f + p1[4 * g], d1 = 1.0f + p1[4 * g + 1], d2 = 1.0f + p1[4 * g + 2], d3 = 1.0f + p1[4 * g + 3];
                      P1[4 + g] = d0; P2[4 + g] = d0 * d1; P3[4 + g] = P2[4 + g] * d2; const float G = P3[4 + g] * d3; lg[4 + g] = flog2(G); rG[4 + g] = frcp(G); } }
#pragma unroll
                for (int g = 0; g < 8; ++g) oL[g] = shx(lane, lg[g], 32);
                float off[8], run = 0.f;
#pragma unroll
                for (int kg = 15; kg >= 0; --kg) { const bool own = ((kg & 1) == hi); const float sm = own ? lg[kg >> 1] : oL[kg >> 1];
                    off[kg >> 1] = own ? run : off[kg >> 1]; run += sm; }
#pragma unroll
                for (int g = 0; g < 4; ++g) {
                    { const float F = fexp2(R - off[g]), c = rG[g];
                      p0[4 * g] = (c * p0[4 * g]) * F; p0[4 * g + 1] = ((P1[g] * c) * p0[4 * g + 1]) * F; p0[4 * g + 2] = ((P2[g] * c) * p0[4 * g + 2]) * F; p0[4 * g + 3] = ((P3[g] * c) * p0[4 * g + 3]) * F; }
                    { const float F = fexp2(R - off[4 + g]), c = rG[4 + g];
                      p1[4 * g] = (c * p1[4 * g]) * F; p1[4 * g + 1] = ((P1[4 + g] * c) * p1[4 * g + 1]) * F; p1[4 * g + 2] = ((P2[4 + g] * c) * p1[4 * g + 2]) * F; p1[4 * g + 3] = ((P3[4 + g] * c) * p1[4 * g + 3]) * F; } }
                R -= run;
                wdone = __all(R < -152.0f);
            }
            bf16x8 pa[4];
            { u32x4 w;
              w.x = pk2(p0[0], p0[1]); w.y = pk2(p0[2], p0[3]); w.z = pk2(p0[4], p0[5]); w.w = pk2(p0[6], p0[7]); pa[0] = __builtin_bit_cast(bf16x8, w);
              w.x = pk2(p0[8], p0[9]); w.y = pk2(p0[10], p0[11]); w.z = pk2(p0[12], p0[13]); w.w = pk2(p0[14], p0[15]); pa[1] = __builtin_bit_cast(bf16x8, w);
              w.x = pk2(p1[0], p1[1]); w.y = pk2(p1[2], p1[3]); w.z = pk2(p1[4], p1[5]); w.w = pk2(p1[6], p1[7]); pa[2] = __builtin_bit_cast(bf16x8, w);
              w.x = pk2(p1[8], p1[9]); w.y = pk2(p1[10], p1[11]); w.z = pk2(p1[12], p1[13]); w.w = pk2(p1[14], p1[15]); pa[3] = __builtin_bit_cast(bf16x8, w); }
#pragma unroll
            for (int s = 0; s < 4; ++s) {
#pragma unroll
                for (int d0 = 0; d0 < 2; ++d0) { const LAS unsigned short* vrow = VT + (32 * d0 + r32) * 68 + 16 * s + 4 * hi;
                    const u32x2 lo = *(const LAS u32x2*)vrow, hh = *(const LAS u32x2*)(vrow + 8);
                    const u32x4 vw = {lo.x, lo.y, hh.x, hh.y}; const bf16x8 vf = __builtin_bit_cast(bf16x8, vw);
                    if (d0 == 0) o0 = MFMA32(pa[s], vf, o0); else o1 = MFMA32(pa[s], vf, o1); } }
        }
        __syncthreads();
    }
    if (MODE == 0) { const float lt = lsum + shx(lane, lsum, 32); if (hi == 0) wsf[r32] = 1.0f / lt; LDS_WAIT(); asm volatile("" ::: "memory");
#pragma unroll
        for (int r = 0; r < 16; ++r) { const float f = wsf[crow(r, hi)]; o0[r] *= f; o1[r] *= f; } }
#pragma unroll
    for (int r = 0; r < 16; ++r) {
        if (FP8_MRG) { unsigned char* op = (unsigned char*)O + (rowbase + qw0 + crow(r, hi)) * OP + ocol + r32; op[0] = f8_byte(o0[r] * Q_O); op[32] = f8_byte(o1[r] * Q_O); }
        else { bf16_t* op = O + (rowbase + qw0 + crow(r, hi)) * OP + ocol + r32; op[0] = (bf16_t)f2bf(o0[r]); op[32] = (bf16_t)f2bf(o1[r]); } }
}
#include <hip/hip_bf16.h>
#include <cmath>
namespace fox_body {
using bf16=__hip_bfloat16;
using bf16x8=__attribute__((ext_vector_type(8)))short;
using s16x4=__attribute__((ext_vector_type(4)))short;
using f32x16=__attribute__((ext_vector_type(16)))float;
using u32x4=__attribute__((ext_vector_type(4)))unsigned;
constexpr int SEQ=2048,D=64,DM=5184,DMO=2048;
constexpr int NW=8,QBLK=32,QB=QBLK*NW,KVBLK=64,NQB=SEQ/QB;
constexpr int ATTN_UNIT_ROWS=QB;
__device__ __forceinline__ int crow(int r,int hi){return (r&3)+8*(r>>2)+4*hi;}
#define SBAR() __builtin_amdgcn_sched_barrier(0)
__device__ __forceinline__ void cmask(f32x16&p0,f32x16&p1,int jb,int qrel,int hi){
  const float NEG=-INFINITY; int kb=64*jb+4*hi;
  #pragma unroll
  for(int r=0;r<16;++r){int kv=kb+(r&3)+8*(r>>2); if(kv>qrel)p0[r]=NEG; if(kv+32>qrel)p1[r]=NEG;}
}

constexpr int NSLOT=3, SLOTB=8192;
constexpr int LDS_K=0, LDS_V=NSLOT*SLOTB, LDS_WS=2*NSLOT*SLOTB, LDS_OST=LDS_WS+NW*64*4, LDS_BYTES=LDS_OST+NW*4096;
constexpr float C2=0.125f*1.4426950408889634f;
__device__ __forceinline__ void glds16(const void*gsrc,unsigned lds_dst){unsigned keep;
  asm volatile("s_mov_b32 %0, m0\n\ts_mov_b32 m0, %2\n\ts_nop 0\n\tglobal_load_lds_dwordx4 %1, off\n\ts_mov_b32 m0, %0":"=&s"(keep):"v"(gsrc),"s"(lds_dst):"memory");}
__device__ __forceinline__ float max3f(float a,float b,float c){float r;asm("v_max3_f32 %0, %1, %2, %3":"=v"(r):"v"(a),"v"(b),"v"(c));return r;}
__device__ __forceinline__ float max2f(float a,float b){float r;asm("v_max_f32_e32 %0, %1, %2":"=v"(r):"v"(a),"v"(b));return r;}
__device__ __forceinline__ float fadd_s(float a,float b){float r;asm("v_add_f32_e32 %0, %1, %2":"=v"(r):"v"(a),"v"(b));return r;}
__device__ __forceinline__ float fsub_s(float a,float b){float r;asm("v_sub_f32_e32 %0, %1, %2":"=v"(r):"v"(a),"v"(b));return r;}
typedef float f32x2_t __attribute__((ext_vector_type(2))); typedef float f32x4_t __attribute__((ext_vector_type(4))); typedef __bf16 bf16x2_t __attribute__((ext_vector_type(2)));
__device__ __forceinline__ unsigned cvtpk_s(float lo,float hi){f32x2_t v={lo,hi};bf16x2_t b=__builtin_convertvector(v,bf16x2_t);return __builtin_bit_cast(unsigned,b);}
#define WAIT_BAR(N) asm volatile("s_waitcnt vmcnt(" #N ") lgkmcnt(0)\n\ts_barrier":::"memory")

__device__ __forceinline__ void qkt(f32x16&p0,f32x16&p1,const char*Kslot,const bf16x8*qr,const f32x16&negm,int r32,int hi){
  const char*kb=Kslot+hi*1024+r32*16;
  #pragma unroll
  for(int d0=0;d0<4;++d0){
    const bf16x8 b0=*reinterpret_cast<const bf16x8*>(kb+d0*2048);
    const bf16x8 b1=*reinterpret_cast<const bf16x8*>(kb+d0*2048+512);
    if(d0==0){p0=__builtin_amdgcn_mfma_f32_32x32x16_bf16(b0,qr[0],negm,0,0,0);p1=__builtin_amdgcn_mfma_f32_32x32x16_bf16(b1,qr[0],negm,0,0,0);}
    else{p0=__builtin_amdgcn_mfma_f32_32x32x16_bf16(b0,qr[d0],p0,0,0,0);p1=__builtin_amdgcn_mfma_f32_32x32x16_bf16(b1,qr[d0],p1,0,0,0);}}
}
typedef __attribute__((address_space(3))) const char* lds_cptr;
typedef short v4i16_t __attribute__((ext_vector_type(4)));
__device__ __forceinline__ void kload8(bf16x8*kf,lds_cptr kp){
  kf[0]=*(const __attribute__((address_space(3))) bf16x8*)(kp);      kf[1]=*(const __attribute__((address_space(3))) bf16x8*)(kp+512);
  kf[2]=*(const __attribute__((address_space(3))) bf16x8*)(kp+2048); kf[3]=*(const __attribute__((address_space(3))) bf16x8*)(kp+2560);
  kf[4]=*(const __attribute__((address_space(3))) bf16x8*)(kp+4096); kf[5]=*(const __attribute__((address_space(3))) bf16x8*)(kp+4608);
  kf[6]=*(const __attribute__((address_space(3))) bf16x8*)(kp+6144); kf[7]=*(const __attribute__((address_space(3))) bf16x8*)(kp+6656);
}
__device__ __forceinline__ void kload2(bf16x8*kf,lds_cptr kp,int j){ kf[2*j]=*(const __attribute__((address_space(3))) bf16x8*)(kp+j*2048); kf[2*j+1]=*(const __attribute__((address_space(3))) bf16x8*)(kp+j*2048+512); }
__device__ __forceinline__ s16x4 vtr(lds_cptr p){ return __builtin_bit_cast(s16x4,__builtin_amdgcn_ds_read_tr16_b64_v4i16((__attribute__((address_space(3))) v4i16_t*)p)); }
__device__ __forceinline__ float rowmax(const f32x16&p0,const f32x16&p1){
  float a=max3f(p0[0],p0[1],p1[0]),b=max3f(p0[2],p0[3],p1[1]);a=max3f(a,p1[2],p1[3]);
  #pragma unroll
  for(int r=4;r<16;r+=4){a=max3f(a,p0[r],p0[r+1]);b=max3f(b,p0[r+2],p0[r+3]);a=max3f(a,p1[r],p1[r+1]);b=max3f(b,p1[r+2],p1[r+3]);}
  const float m=max2f(a,b);
  auto rr=__builtin_amdgcn_permlane32_swap(__float_as_uint(m),__float_as_uint(m),false,false);
  return max2f(__uint_as_float(rr[0]),__uint_as_float(rr[1]));
}
__device__ __forceinline__ void pv(f32x16*o,int vb,bf16x8 pa0,bf16x8 pa1,bf16x8 pa2,bf16x8 pa3){
  #pragma unroll
  for(int d0=0;d0<2;++d0){s16x4 lo[4],hi[4];
    #pragma unroll
    for(int ks=0;ks<4;++ks){
      asm volatile("ds_read_b64_tr_b16 %0,%1 offset:%c2":"=&v"(lo[ks]):"v"(vb),"i"(d0*4096+ks*1024):"memory");
      asm volatile("ds_read_b64_tr_b16 %0,%1 offset:%c2":"=&v"(hi[ks]):"v"(vb),"i"(d0*4096+ks*1024+512):"memory");}
    asm volatile("s_waitcnt lgkmcnt(0)":::"memory");SBAR();
    #define PK(k) (bf16x8){lo[k][0],lo[k][1],lo[k][2],lo[k][3],hi[k][0],hi[k][1],hi[k][2],hi[k][3]}
    o[d0]=__builtin_amdgcn_mfma_f32_32x32x16_bf16(pa0,PK(0),o[d0],0,0,0);
    o[d0]=__builtin_amdgcn_mfma_f32_32x32x16_bf16(pa1,PK(1),o[d0],0,0,0);
    o[d0]=__builtin_amdgcn_mfma_f32_32x32x16_bf16(pa2,PK(2),o[d0],0,0,0);
    o[d0]=__builtin_amdgcn_mfma_f32_32x32x16_bf16(pa3,PK(3),o[d0],0,0,0);
    #undef PK
  }
}

#ifndef ATTN_STORE16
#define ATTN_STORE16(p,v) (*(u32x4*)(p)=(v))
#endif
template<int THRL> __device__ __forceinline__ void attn_unit(int b,int h,int qb,const bf16*Q,const bf16*__restrict__ K,const bf16*__restrict__ V,bf16*O,const __attribute__((address_space(3))) float*Fl,char*shm,int tid){
  const int lane=tid&63,r32=lane&31,hi=lane>>5; const int wid=__builtin_amdgcn_readfirstlane(tid>>6);
  const long rowbase=(long)b*SEQ; const int q0=qb*QB;
  const bf16*Qw=Q+(rowbase+q0+wid*QBLK)*DM+h*D;
  const bf16*Kh=K+rowbase*DM+h*D,*Vh=V+rowbase*DM+h*D;
  const unsigned lds0=(unsigned)(uintptr_t)shm;
  float*wsf=(float*)(shm+LDS_WS)+wid*64;
  const unsigned koff=(unsigned)(lane*DM+wid*8);
  const unsigned voff=(unsigned)((16*(wid&3)+(lane>>2))*DM+(wid>>2)*32+(lane&3)*8);
  const unsigned kdst=lds0+LDS_K+wid*1024, vdst=lds0+LDS_V+wid*1024;
  #define DMA_K(t,slot) glds16(Kh+((long)(t)*KVBLK*DM+koff),(unsigned)__builtin_amdgcn_readfirstlane(kdst+(slot)))
  #define DMA_V(t,slot) glds16(Vh+((long)(t)*KVBLK*DM+voff),(unsigned)__builtin_amdgcn_readfirstlane(vdst+(slot)))
  const int vb0=(int)(lds0+LDS_V)+((lane>>4)&1)*32+(lane&3)*8+(4*hi+((lane&15)>>2))*64;
  const char*Kbase=shm+LDS_K; bf16x8 kf[8];
  const lds_cptr shm3=(lds_cptr)shm; const lds_cptr kp0=shm3+LDS_K+hi*1024+r32*16; const lds_cptr vp0=shm3+LDS_V+((lane>>4)&1)*32+(lane&3)*8+(4*hi+((lane&15)>>2))*64;
  const int NT=(q0+QB)/KVBLK;
  DMA_K(0,0);DMA_V(0,0);DMA_K(1,SLOTB);
  bf16x8 qr[4];
  #pragma unroll
  for(int d0=0;d0<4;++d0)qr[d0]=*reinterpret_cast<const bf16x8*>(&Qw[(long)r32*DM+d0*16+hi*8]);
  const float fq=Fl[q0+wid*QBLK+r32];
  float mhat=0.f,l_reg=0.f;f32x16 o[2];o[0]=f32x16{};o[1]=f32x16{};const f32x16 negm=f32x16{};
  float cc=-fq;
  #define FSUB(P0,P1,t) do{ _Pragma("unroll") for(int g_=0;g_<4;++g_){ \
      { const f32x4_t f0_=*(const __attribute__((address_space(3))) f32x4_t*)(Fl+(t)*64+8*g_+4*hi)+cc; \
        _Pragma("unroll") for(int i_=0;i_<4;++i_) P0[4*g_+i_]-=f0_[i_]; asm volatile("":::"memory"); } \
      { const f32x4_t f1_=*(const __attribute__((address_space(3))) f32x4_t*)(Fl+(t)*64+32+8*g_+4*hi)+cc; \
        _Pragma("unroll") for(int i_=0;i_<4;++i_) P1[4*g_+i_]-=f1_[i_]; asm volatile("":::"memory"); } } }while(0)
  const int qrel=wid*QBLK+r32;
  #define CMASK(P0,P1,t) do{int jb_=(t)-(NT-4); if(jb_>=0)cmask(P0,P1,jb_,qrel,hi);}while(0)
  bool resc=false;
  #define START(P0,P1) do{ const float rm=rowmax(P0,P1); resc=false; \
    { const float dl=rm; mhat=fadd_s(mhat,dl); \
      _Pragma("unroll") for(int r=0;r<16;++r){P0[r]=fsub_s(P0[r],dl);P1[r]=fsub_s(P1[r],dl);} \
      cc=mhat-fq; } \
    _Pragma("unroll") for(int r=0;r<16;++r)P0[r]=__builtin_amdgcn_exp2f(P0[r]); }while(0)
  #define RESC() do{ if(resc){ asm volatile("s_waitcnt lgkmcnt(0)":::"memory"); \
      _Pragma("unroll") for(int d_=0;d_<2;++d_) _Pragma("unroll") for(int r=0;r<16;++r)o[d_][r]*=wsf[crow(r,hi)]; } }while(0)
  f32x16 pA0,pA1,pB0,pB1;
  int sl_prev=0,sl_cur=0,sl_next=SLOTB;
  #define ROT() do{sl_prev=sl_cur;sl_cur=sl_next;sl_next=(sl_next==(NSLOT-1)*SLOTB)?0:sl_next+SLOTB;}while(0)
  DMA_K(2,2*SLOTB);
  WAIT_BAR(3);
  qkt(pA0,pA1,Kbase,qr,negm,r32,hi);asm volatile("s_nop 15\n\ts_nop 7":"+v"(pA0),"+v"(pA1));FSUB(pA0,pA1,0);CMASK(pA0,pA1,0);
  START(pA0,pA1);
  _Pragma("unroll") for(int r=0;r<16;++r)pA1[r]=__builtin_amdgcn_exp2f(pA1[r]);
  WAIT_BAR(0);
  DMA_K(3,0);DMA_V(1,SLOTB);
  ROT();
  kload8(kf,kp0+sl_cur);
  WAIT_BAR(2);
  s16x4 vlo[8],vhi[8]; u32x4 pw0,pw1,pw2,pw3;
  #define PKW(P,B) cvtpk_s(P[B],P[B+1])
  #define PAF(k) __builtin_bit_cast(bf16x8,pw##k)
  #define VFR(i) (bf16x8){vlo[i][0],vlo[i][1],vlo[i][2],vlo[i][3],vhi[i][0],vhi[i][1],vhi[i][2],vhi[i][3]}
  #define PIN(x) asm volatile("":"+v"(x))
  #define MX3(a,b,c) __builtin_fmaxf(__builtin_fmaxf((a),(b)),(c))
  #define GAPA(MF,A0,A1,A2,A3,W0,W1,PW) do{ MF; sacc+=A0; sacc+=A1; sacc+=A2; sacc+=A3; PIN(sacc); W0; W1; PIN(PW); SBAR(); }while(0)
  #define EX(v) __builtin_amdgcn_exp2f(v)
  #define GAPB(MF,X,B) do{ MF; X[B]=EX(X[B]); X[B+1]=EX(X[B+1]); X[B+2]=EX(X[B+2]); X[B+3]=EX(X[B+3]); PIN(X); SBAR(); }while(0)
  #define VRD(i) do{ vlo[i]=vtr(vp_+(((i)>>2)*4096+((i)&3)*1024)); vhi[i]=vtr(vp_+(((i)>>2)*4096+((i)&3)*1024+512)); }while(0)
  #define KRD(G,j) do{ if(G){ kload2(kf,kp0+sl_next,j); SBAR(); } }while(0)
  #define STEP(C0,C1,P0,P1,t,GK,GV,GL) do{ SBAR(); \
    const lds_cptr vp_=vp0+sl_prev; \
    VRD(0); SBAR(); float sacc=(P0[0]+P0[1]); \
    GAPA(C0=__builtin_amdgcn_mfma_f32_32x32x16_bf16(kf[0],qr[0],negm,0,0,0), P0[2],P0[3],P0[4],P0[5],     pw0[0]=PKW(P0,0), pw0[1]=PKW(P0,2), pw0); \
    VRD(4); SBAR(); GAPA(C1=__builtin_amdgcn_mfma_f32_32x32x16_bf16(kf[1],qr[0],negm,0,0,0), P0[6],P0[7],P0[8],P0[9],     pw0[2]=PKW(P0,4), pw0[3]=PKW(P0,6), pw0); \
    VRD(1); SBAR(); GAPA(C0=__builtin_amdgcn_mfma_f32_32x32x16_bf16(kf[2],qr[1],C0,0,0,0),   P0[10],P0[11],P0[12],P0[13], pw1[0]=PKW(P0,8), pw1[1]=PKW(P0,10), pw1); \
    VRD(5); SBAR(); GAPA(C1=__builtin_amdgcn_mfma_f32_32x32x16_bf16(kf[3],qr[1],C1,0,0,0),   P0[14],P0[15],P1[0],P1[1],   pw1[2]=PKW(P0,12),pw1[3]=PKW(P0,14), pw1); \
    VRD(2); SBAR(); GAPA(C0=__builtin_amdgcn_mfma_f32_32x32x16_bf16(kf[4],qr[2],C0,0,0,0),   P1[2],P1[3],P1[4],P1[5],     pw2[0]=PKW(P1,0), pw2[1]=PKW(P1,2), pw2); \
    VRD(6); SBAR(); GAPA(C1=__builtin_amdgcn_mfma_f32_32x32x16_bf16(kf[5],qr[2],C1,0,0,0),   P1[6],P1[7],P1[8],P1[9],     pw2[2]=PKW(P1,4), pw2[3]=PKW(P1,6), pw2); \
    VRD(3); SBAR(); GAPA(C0=__builtin_amdgcn_mfma_f32_32x32x16_bf16(kf[6],qr[3],C0,0,0,0),   P1[10],P1[11],P1[12],P1[13], pw3[0]=PKW(P1,8), pw3[1]=PKW(P1,10), pw3); \
    VRD(7); SBAR(); GAPA(C1=__builtin_amdgcn_mfma_f32_32x32x16_bf16(kf[7],qr[3],C1,0,0,0),   P1[14],P1[15],0.f,0.f,       pw3[2]=PKW(P1,12),pw3[3]=PKW(P1,14), pw3); \
    l_reg+=sacc; \
    if(GK){DMA_K((t)+3,sl_cur);} if(GV){DMA_V((t)+1,sl_next);} \
    FSUB(C0,C1,t); CMASK(C0,C1,t); \
    { float a=MX3(C0[0],C0[1],C1[0]),b=MX3(C0[2],C0[3],C1[1]); a=MX3(a,C1[2],C1[3]); \
      _Pragma("unroll") for(int r=4;r<16;r+=4){a=MX3(a,C0[r],C0[r+1]);b=MX3(b,C0[r+2],C0[r+3]);a=MX3(a,C1[r],C1[r+1]);b=MX3(b,C1[r+2],C1[r+3]);} \
      float rm=__builtin_fmaxf(a,b); { auto rr=__builtin_amdgcn_permlane32_swap(__float_as_uint(rm),__float_as_uint(rm),false,false); rm=__builtin_fmaxf(__uint_as_float(rr[0]),__uint_as_float(rr[1])); } \
      resc=false; \
      if(__builtin_expect(__any(rm>(float)THRL),0)){ const float dl=__builtin_fmaxf(rm,0.f); mhat+=dl; \
        _Pragma("unroll") for(int r=0;r<16;++r){C0[r]-=dl;C1[r]-=dl;} \
        cc=mhat-fq; \
        const float f=__builtin_amdgcn_exp2f(-dl); l_reg*=f; if(hi==0)wsf[r32]=f; resc=true; } } \
    SBAR(); \
    GAPB(o[0]=__builtin_amdgcn_mfma_f32_32x32x16_bf16(PAF(0),VFR(0),o[0],0,0,0), C0,0); \
    GAPB(o[1]=__builtin_amdgcn_mfma_f32_32x32x16_bf16(PAF(0),VFR(4),o[1],0,0,0), C0,4); \
    KRD(GL,0); GAPB(o[0]=__builtin_amdgcn_mfma_f32_32x32x16_bf16(PAF(1),VFR(1),o[0],0,0,0), C0,8); \
    KRD(GL,1); GAPB(o[1]=__builtin_amdgcn_mfma_f32_32x32x16_bf16(PAF(1),VFR(5),o[1],0,0,0), C0,12); \
    KRD(GL,2); GAPB(o[0]=__builtin_amdgcn_mfma_f32_32x32x16_bf16(PAF(2),VFR(2),o[0],0,0,0), C1,0); \
    KRD(GL,3); GAPB(o[1]=__builtin_amdgcn_mfma_f32_32x32x16_bf16(PAF(2),VFR(6),o[1],0,0,0), C1,4); \
    GAPB(o[0]=__builtin_amdgcn_mfma_f32_32x32x16_bf16(PAF(3),VFR(3),o[0],0,0,0), C1,8); \
    GAPB(o[1]=__builtin_amdgcn_mfma_f32_32x32x16_bf16(PAF(3),VFR(7),o[1],0,0,0), C1,12); \
    }while(0)
  int t=1;
  #undef CMASK
  #define CMASK(P0,P1,t) do{}while(0)
  for(;t+5<NT;t+=2){
    STEP(pB0,pB1,pA0,pA1,t,true,true,true);     WAIT_BAR(2); RESC(); ROT();
    STEP(pA0,pA1,pB0,pB1,t+1,true,true,true);   WAIT_BAR(2); RESC(); ROT();
  }
  #undef CMASK
  #define CMASK(P0,P1,t) do{int jb_=(t)-(NT-4); if(jb_>=0)cmask(P0,P1,jb_,qrel,hi);}while(0)
  #define ENDW(tt) do{ if((tt)+3<NT){WAIT_BAR(2);} else if((tt)+2<NT){WAIT_BAR(1);} else {WAIT_BAR(0);} }while(0)
  for(;t+1<NT;t+=2){
    STEP(pB0,pB1,pA0,pA1,t,(t+3<NT),(t+1<NT),(t+1<NT));       ENDW(t);   RESC(); ROT();
    STEP(pA0,pA1,pB0,pB1,t+1,(t+4<NT),(t+2<NT),(t+2<NT));     ENDW(t+1); RESC(); ROT();
  }
  STEP(pB0,pB1,pA0,pA1,NT-1,false,false,false); RESC();
  { float sacc=pB0[0]+pB0[1]; _Pragma("unroll") for(int r=2;r<16;++r)sacc+=pB0[r]; _Pragma("unroll") for(int r=0;r<16;++r)sacc+=pB1[r]; l_reg+=sacc;
    pw0=(u32x4){PKW(pB0,0),PKW(pB0,2),PKW(pB0,4),PKW(pB0,6)};pw1=(u32x4){PKW(pB0,8),PKW(pB0,10),PKW(pB0,12),PKW(pB0,14)};pw2=(u32x4){PKW(pB1,0),PKW(pB1,2),PKW(pB1,4),PKW(pB1,6)};pw3=(u32x4){PKW(pB1,8),PKW(pB1,10),PKW(pB1,12),PKW(pB1,14)};
    SBAR(); pv(o,vb0+sl_cur,PAF(0),PAF(1),PAF(2),PAF(3)); }
  #undef PKW
  #undef PAF
  #undef VFR
  #undef PIN
  #undef MX3
  #undef GAPA
  #undef GAPB
  #undef EX
  #undef VRD
  #undef KRD
  #undef STEP
  #undef ENDW
  {auto rr=__builtin_amdgcn_permlane32_swap(__float_as_uint(l_reg),__float_as_uint(l_reg),false,false);l_reg=__uint_as_float(rr[0])+__uint_as_float(rr[1]);}
  if(hi==0)wsf[32+r32]=l_reg;asm volatile("s_waitcnt lgkmcnt(0)":::"memory");
  float rli[16];
  #pragma unroll
  for(int r=0;r<16;++r)rli[r]=__builtin_amdgcn_rcpf(wsf[32+crow(r,hi)]);
#if FP8_MRG
  { unsigned char*Ow8=(unsigned char*)O+(rowbase+q0+wid*QBLK)*DMO+h*D;
    unsigned char*stg=(unsigned char*)(shm+LDS_OST)+wid*4096;
    #pragma unroll
    for(int r=0;r<16;++r){const int orow=crow(r,hi);
      #pragma unroll
      for(int d0=0;d0<2;++d0)stg[orow*64+d0*32+r32]=f8_byte(o[d0][r]*rli[r]*Q_O);}
    asm volatile("s_waitcnt lgkmcnt(0)":::"memory");
    #pragma unroll
    for(int i=0;i<2;++i){const int row=i*16+(lane>>2),ch=lane&3; const u32x4 v=*(const u32x4*)(stg+row*64+ch*16); ATTN_STORE16(Ow8+(long)row*DMO+ch*16,v);} }
#else
  bf16*Ow=O+(rowbase+q0+wid*QBLK)*DMO+h*D;
  { bf16*stg=(bf16*)(shm+LDS_OST)+wid*2048;
    #pragma unroll
    for(int r=0;r<16;++r){const int orow=crow(r,hi);
      #pragma unroll
      for(int d0=0;d0<2;++d0)stg[orow*64+d0*32+r32]=__float2bfloat16(o[d0][r]*rli[r]);}
    asm volatile("s_waitcnt lgkmcnt(0)":::"memory");
    #pragma unroll
    for(int i=0;i<4;++i){const int row=i*8+(lane>>3),ch=lane&7; const u32x4 v=*(const u32x4*)(stg+row*64+ch*8); ATTN_STORE16(Ow+(long)row*DMO+ch*8,v);} }
#endif
  asm volatile("s_waitcnt lgkmcnt(0)\n\ts_barrier":::"memory");
  #undef FSUB
  #undef DMA_K
  #undef DMA_V
  #undef CMASK
  #undef START
  #undef RESC
  #undef ROT
}
constexpr int ATTN_LDS_BYTES=LDS_BYTES;
#undef SBAR
#undef WAIT_BAR
}

constexpr int L1_HI = 0, L1_ROWB = 2064, L1_LO = 16 * L1_ROWB, L1_PART = 2 * 16 * L1_ROWB, L1_LGT = L1_PART + 16384;
template <bool xbf> __device__ __forceinline__ void ln1_phase(const AR a, int l, const float* xin, LAS unsigned char* lds, int vcu, int tid, int wave, int lane) {
    LAS int* lcnt = (LAS int*)(lds + MISC_OFF + MO_LCNT); LAS int* lbase = (LAS int*)(lds + MISC_OFF + MO_LBASE);
    LAS unsigned* REC = (LAS unsigned*)(lds + MISC_OFF + MO_REC); LAS float* GT = (LAS float*)(lds + MISC_OFF + MO_GT);
    LAS float* PART = (LAS float*)(lds + L1_PART); LAS float* LGT = (LAS float*)(lds + L1_LGT);
    const float* Wr = a.in(I_WR) + (size_t)l * D * NEXP; const float* br = a.in(I_BR) + (size_t)l * NEXP;
    __syncthreads();
    if (tid < 32) lcnt[tid] = 0;
    bf16x8 Bh[4][2], Bl[4][2];
    { const int n = lane & 15, kg = lane >> 4; float w[4][2][8];
#pragma unroll
      for (int ks = 0; ks < 4; ++ks)
#pragma unroll
        for (int nt = 0; nt < 2; ++nt) { const float* p = Wr + (size_t)(128 * wave + 32 * ks + 8 * kg) * 32 + n + 16 * nt;
#pragma unroll
            for (int j = 0; j < 8; ++j) w[ks][nt][j] = p[j * 32]; }
#pragma unroll
      for (int ks = 0; ks < 4; ++ks)
#pragma unroll
        for (int nt = 0; nt < 2; ++nt) { float r[8];
#pragma unroll
            for (int j = 0; j < 8; ++j) r[j] = w[ks][nt][j] - bf2f(f2bf(w[ks][nt][j]));
            u32x4 ph, pl; ph.x = pk2(w[ks][nt][0], w[ks][nt][1]); ph.y = pk2(w[ks][nt][2], w[ks][nt][3]); ph.z = pk2(w[ks][nt][4], w[ks][nt][5]); ph.w = pk2(w[ks][nt][6], w[ks][nt][7]);
            pl.x = pk2(r[0], r[1]); pl.y = pk2(r[2], r[3]); pl.z = pk2(r[4], r[5]); pl.w = pk2(r[6], r[7]);
            Bh[ks][nt] = __builtin_bit_cast(bf16x8, ph); Bl[ks][nt] = __builtin_bit_cast(bf16x8, pl); } }
    const bf16_t* Y = (const bf16_t*)(a.ws() + WS_Y); bf16_t* X1 = (bf16_t*)(a.ws() + WS_X1); bf16_t* H = (bf16_t*)(a.ws() + WS_H);
    LAS float* VL = (LAS float*)(lds + 86016);
    { const float* ada = (const float*)(a.ws() + WS_ADA) + ((size_t)l * 16 + ((vcu * 128) >> 11)) * 6144;
      stage_vec5(a.in(I_LN1G) + (size_t)l * D, a.in(I_LN1B) + (size_t)l * D, ada + 2048, ada + 3072, ada + 4096, VL, tid); }
    const LAS float* VLl = VL + 4 * lane; asm volatile("" : "+v"(VLl));
    __syncthreads();
    const float brv = br[tid & 31];
    f32x4 px[2][4]; u32x2 py[2][4];
#define L1_LOADROWS(P) do { _Pragma("unroll") for (int rr = 0; rr < 2; ++rr) { const int m_ = (vcu >> 4) * 2048 + (P) * 256 + (vcu & 15) * 16 + 2 * wave + rr; \
        _Pragma("unroll") for (int j = 0; j < 4; ++j) { const int col = 4 * lane + 256 * j; if (xbf) { const u32x2 w_ = *(const u32x2*)((const bf16_t*)xin + (size_t)m_ * D + col); px[rr][j] = (f32x4){__uint_as_float(w_.x << 16), __uint_as_float(w_.x & 0xffff0000u), __uint_as_float(w_.y << 16), __uint_as_float(w_.y & 0xffff0000u)}; } else px[rr][j] = *(const f32x4*)(xin + (size_t)m_ * D + col); py[rr][j] = *(const u32x2*)(Y + (size_t)m_ * D + col); } } } while (0)
    L1_LOADROWS(0);
#pragma unroll 1
    for (int pass = 0; pass < 8; ++pass) {
        f32x4 v[2][4];
#pragma unroll
        for (int rr = 0; rr < 2; ++rr) {
#pragma unroll
            for (int j = 0; j < 4; ++j) { const int col = 4 * lane + 256 * j; const f32x4 gt = *(const LAS f32x4*)(VLl + 2048 + 256 * j); const u32x2 yw = py[rr][j];
                const f32x4 yv = {__uint_as_float(yw.x << 16), __uint_as_float(yw.x & 0xffff0000u), __uint_as_float(yw.y << 16), __uint_as_float(yw.y & 0xffff0000u)};
                v[rr][j] = px[rr][j] * DN_ALPHA + (gt + 1.0f) * yv; } }
        if (pass < 7) L1_LOADROWS(pass + 1);
#pragma unroll
        for (int rr = 0; rr < 2; ++rr) {
            const int rowt = 2 * wave + rr, m = (vcu >> 4) * 2048 + pass * 256 + (vcu & 15) * 16 + rowt;
            ln_row(v[rr], VLl, VLl + 1024, lane);
#pragma unroll
            for (int j = 0; j < 4; ++j) { const int col = 4 * lane + 256 * j;
                { u32x2 wx; wx.x = pk2(v[rr][j][0], v[rr][j][1]); wx.y = pk2(v[rr][j][2], v[rr][j][3]); *(u32x2*)(X1 + (size_t)m * D + col) = wx; }
                const f32x4 sh = *(const LAS f32x4*)(VLl + 3072 + 256 * j), sc = *(const LAS f32x4*)(VLl + 4096 + 256 * j);
                const f32x4 h = v[rr][j] * (sc + 1.0f) + sh;
                u32x2 wh; wh.x = pk2(h[0], h[1]); wh.y = pk2(h[2], h[3]);
                if (FP8_MOE) *(unsigned*)((unsigned char*)H + (size_t)m * D + col) = pk4_f8(h[0] * Q_H2, h[1] * Q_H2, h[2] * Q_H2, h[3] * Q_H2); else *(u32x2*)(H + (size_t)m * D + col) = wh;
                const f32x4 hr = {h[0] - __uint_as_float(wh.x << 16), h[1] - __uint_as_float(wh.x & 0xffff0000u), h[2] - __uint_as_float(wh.y << 16), h[3] - __uint_as_float(wh.y & 0xffff0000u)};
                u32x2 wl; wl.x = pk2(hr[0], hr[1]); wl.y = pk2(hr[2], hr[3]);
                *(LAS u32x2*)(lds + L1_HI + rowt * L1_ROWB + col * 2) = wh; *(LAS u32x2*)(lds + L1_LO + rowt * L1_ROWB + col * 2) = wl; }
        }
        __syncthreads();
        { f32x4 acc0 = {0.f, 0.f, 0.f, 0.f}, acc1 = {0.f, 0.f, 0.f, 0.f}; const int row = lane & 15, kg = lane >> 4;
#pragma unroll
          for (int ks = 0; ks < 4; ++ks) { const int off = row * L1_ROWB + (128 * wave + 32 * ks + 8 * kg) * 2;
              const bf16x8 ah = *(const LAS bf16x8*)(lds + L1_HI + off), al = *(const LAS bf16x8*)(lds + L1_LO + off);
              acc0 = __builtin_amdgcn_mfma_f32_16x16x32_bf16(ah, Bh[ks][0], acc0, 0, 0, 0); acc1 = __builtin_amdgcn_mfma_f32_16x16x32_bf16(ah, Bh[ks][1], acc1, 0, 0, 0);
              acc0 = __builtin_amdgcn_mfma_f32_16x16x32_bf16(ah, Bl[ks][0], acc0, 0, 0, 0); acc1 = __builtin_amdgcn_mfma_f32_16x16x32_bf16(ah, Bl[ks][1], acc1, 0, 0, 0);
              acc0 = __builtin_amdgcn_mfma_f32_16x16x32_bf16(al, Bh[ks][0], acc0, 0, 0, 0); acc1 = __builtin_amdgcn_mfma_f32_16x16x32_bf16(al, Bh[ks][1], acc1, 0, 0, 0); }
#pragma unroll
          for (int r = 0; r < 4; ++r) { PART[(wave * 16 + 4 * kg + r) * 32 + (lane & 15)] = acc0[r]; PART[(wave * 16 + 4 * kg + r) * 32 + 16 + (lane & 15)] = acc1[r]; } }
        __syncthreads();
        { float x = brv;
#pragma unroll
          for (int w2 = 0; w2 < 8; ++w2) x += PART[w2 * 512 + tid];
          float vk[4]; int ik[4]; const int el = lane & 31;
#pragma unroll
          for (int r = 0; r < 4; ++r) { float m = x;
              m = fmaxf(m, WV_DPP(m, 0xb1)); m = fmaxf(m, WV_DPP(m, 0x4e)); m = fmaxf(m, WV_DPP(m, 0x141)); m = fmaxf(m, WV_DPP(m, 0x140));
              { const auto r2 = __builtin_amdgcn_permlane16_swap(__float_as_uint(m), __float_as_uint(m), false, false); m = fmaxf(__uint_as_float(r2[0]), __uint_as_float(r2[1])); }
              const unsigned long long bal = __builtin_amdgcn_ballot_w64(x == m);
              const unsigned hb = (lane & 32) ? (unsigned)(bal >> 32) : (unsigned)bal;
              const int idx = hb ? __builtin_ctz(hb) : 0;
              vk[r] = m; ik[r] = idx; x = (el == idx) ? -INFINITY : x; }
          const float p1 = fexp2(LOG2E * (vk[1] - vk[0])), p2 = fexp2(LOG2E * (vk[2] - vk[0])), p3 = fexp2(LOG2E * (vk[3] - vk[0])), inv = 1.0f / (1.0f + p1 + p2 + p3);
          if (el < 4) { const int rowl = pass * 16 + 2 * wave + (lane >> 5);
              const int ee = (el == 0) ? ik[0] : ((el == 1) ? ik[1] : ((el == 2) ? ik[2] : ik[3]));
              const float gg = ((el == 0) ? 1.0f : ((el == 1) ? p1 : ((el == 2) ? p2 : p3))) * inv;
              const int lr = __hip_atomic_fetch_add(lcnt + ee, 1, __ATOMIC_RELAXED, __HIP_MEMORY_SCOPE_WORKGROUP);
              REC[rowl * 4 + el] = (unsigned)ee | ((unsigned)lr << 8); GT[rowl * 4 + el] = gg; } }
    }
#undef L1_LOADROWS
    __syncthreads();
    { int t2 = tid; asm volatile("" : "+v"(t2));
      if (t2 < 32) lbase[t2] = (int)__hip_atomic_fetch_add((gu32*)(a.ws() + WS_CTL) + CW_GCNT + (l * 32 + t2) * 64, (unsigned)lcnt[t2], RLX_AGENT); }
    __syncthreads();
    { const int rowl = tid >> 2, k = tid & 3; const unsigned rec = REC[tid]; const int e = rec & 255, lr = rec >> 8, rank = lbase[e] + lr, tok = (vcu >> 4) * 2048 + (rowl >> 4) * 256 + (vcu & 15) * 16 + (rowl & 15);
      int* slot_tok = (int*)(a.ws() + WS_SLOTTOK); int* tok_er = (int*)(a.ws() + WS_TOKER); float* gates = (float*)(a.ws() + WS_GATE);
      if (rank < ECAP) slot_tok[(size_t)e * ECAP + rank] = tok;
      tok_er[tok * 4 + k] = e * ECAP + rank; gates[tok * 4 + k] = GT[tid]; }
    __syncthreads();
}

template <bool obf> __device__ __forceinline__ void ln2_phase(const AR a, int l, float* xout, LAS unsigned char* lds, int vcu, int tid, int wave, int lane, bool prep_next) {
    const LAS int* bs = (const LAS int*)(lds + MISC_OFF + MO_BS);
    const LAS float* Wf = (const LAS float*)lds;
    LAS float* VL = (LAS float*)(lds + 32768);
    { const int b = (vcu * 128) >> 11; const float* ada = (const float*)(a.ws() + WS_ADA) + ((size_t)l * 16 + b) * 6144;
      const float* adn = (const float*)(a.ws() + WS_ADA) + ((size_t)(prep_next ? l + 1 : l) * 16 + b) * 6144;
      stage_vec5(a.in(I_LN2G) + (size_t)l * D, a.in(I_LN2B) + (size_t)l * D, ada + 5120, adn, adn + 1024, VL, tid);
      { int t8 = tid; asm volatile("" : "+v"(t8)); if (prep_next && t8 < 8) VL[5120 + t8] = a.in(I_BF)[(l + 1) * 8 + t8]; } }
    const LAS float* VLl = VL + 4 * lane; asm volatile("" : "+v"(VLl));
    __syncthreads();
    const bf16_t* X1 = (const bf16_t*)(a.ws() + WS_X1); const bf16_t* YB = (const bf16_t*)(a.ws() + WS_YB);
    const int* tok_er = (const int*)(a.ws() + WS_TOKER); const float* gates = (const float*)(a.ws() + WS_GATE);
    const int mw = (vcu >> 4) * 2048 + (vcu & 15) * 16 + 2 * wave;
    int ern[4]; float gn[4];
#define L2_ROW(S) (mw + 256 * ((S) >> 1) + ((S) & 1))
#define L2_LOADIDX(M) do { _Pragma("unroll") for (int k = 0; k < 4; ++k) { ern[k] = tok_er[(M) * 4 + k]; gn[k] = gates[(M) * 4 + k]; } } while (0)
    unsigned y8c[4][4], y8n[4][4]; u32x2 xc[4], xn[4]; float gcc[4], gcn[4];
#define L2_LOADROWS(Y8, XW, GC, M) do { \
        _Pragma("unroll") for (int k = 0; k < 4; ++k) { const int er = ern[k], e = er >> 15, rank = er & (ECAP - 1); GC[k] = gn[k] * (1.0f / Q_YB); \
            const unsigned char* yr = (const unsigned char*)YB + ((size_t)bs[e] * 256 + rank) * D; \
            _Pragma("unroll") for (int j = 0; j < 4; ++j) Y8[k][j] = *(const unsigned*)(yr + 4 * lane + 256 * j); } \
        _Pragma("unroll") for (int j = 0; j < 4; ++j) XW[j] = *(const u32x2*)(X1 + (size_t)(M) * D + 4 * lane + 256 * j); } while (0)
    static_assert(FP8_YB != 0, "ln2_phase gathers fp8 expert rows");
    L2_LOADIDX(L2_ROW(0));
    L2_LOADROWS(y8c, xc, gcc, L2_ROW(0));
    L2_LOADIDX(L2_ROW(1));
#pragma unroll 1
    for (int st = 0; st < 16; ++st) { const int m = L2_ROW(st);
        { const int s1 = (st < 15) ? st + 1 : 15, s2 = (st < 14) ? st + 2 : 15;
          L2_LOADROWS(y8n, xn, gcn, L2_ROW(s1));
          L2_LOADIDX(L2_ROW(s2)); }
        f32x4 v[4];
#pragma unroll
        for (int j = 0; j < 4; ++j) { f32x4 y = {0.f, 0.f, 0.f, 0.f};
#pragma unroll
            for (int k = 0; k < 4; ++k) { const float g = gcc[k];
                const auto lo = __builtin_amdgcn_cvt_pk_f32_fp8((int)y8c[k][j], false), hi = __builtin_amdgcn_cvt_pk_f32_fp8((int)y8c[k][j], true);
                y[0] += g * lo[0]; y[1] += g * lo[1]; y[2] += g * hi[0]; y[3] += g * hi[1]; }
            const f32x4 gt = *(const LAS f32x4*)(VLl + 2048 + 256 * j); const u32x2 wx = xc[j];
            const f32x4 xv = {__uint_as_float(wx.x << 16), __uint_as_float(wx.x & 0xffff0000u), __uint_as_float(wx.y << 16), __uint_as_float(wx.y & 0xffff0000u)};
            v[j] = xv * DN_ALPHA + (gt + 1.0f) * y; }
        ln_row(v, VLl, VLl + 1024, lane);
#pragma unroll
        for (int j = 0; j < 4; ++j) { if (obf) { u32x2 w_; w_.x = pk2(v[j][0], v[j][1]); w_.y = pk2(v[j][2], v[j][3]); *(u32x2*)((bf16_t*)xout + (size_t)m * D + 4 * lane + 256 * j) = w_; }
            else *(f32x4*)(xout + (size_t)m * D + 4 * lane + 256 * j) = v[j]; }
        if (prep_next) prep_row(a, m, v, Wf, VLl + 3072, VLl + 4096, VL + 5120, lane);
#pragma unroll
        for (int k = 0; k < 4; ++k) { gcc[k] = gcn[k];
#pragma unroll
            for (int j = 0; j < 4; ++j) y8c[k][j] = y8n[k][j]; }
#pragma unroll
        for (int j = 0; j < 4; ++j) xc[j] = xn[j];
    }
#undef L2_LOADROWS
#undef L2_LOADIDX
#undef L2_ROW
}

#if CHK
__device__ __forceinline__ void chk_rec(const AR a, int stage, float err) {
    if (!(err == err)) err = 1e30f; err = fabsf(err);
    atomicMax((unsigned*)(a.ws() + WS_CTL) + CW_CHK + stage, __float_as_uint(err));
}
__device__ __forceinline__ unsigned hash32(unsigned x) { x ^= x >> 16; x *= 0x7feb352du; x ^= x >> 15; x *= 0x846ca68bu; x ^= x >> 16; return x; }
__device__ __forceinline__ float relerr(float got, float ref, float fl) { return fabsf(got - ref) / (fabsf(ref) + fl); }
__device__ __forceinline__ float rbf(float x) { return bf2f(f2bf(x)); }
#define CHK_GT() ({ int t_ = threadIdx.x; asm volatile("" : "+v"(t_)); (int)(blockIdx.x * 512 + t_); })
__device__ __forceinline__ void chk_weights(const AR a) {
    const int s = CHK_GT(); if (s >= 8192) return;
    const unsigned h1 = hash32(s * 3 + 1), h2 = hash32(s * 3 + 2), h3 = hash32(s * 3 + 3); const int l = (s >> 3) & 1, job = s % 5;
    const unsigned char* wl = a.ws() + WS_W + (size_t)l * WL_SIZE; float ref = 0.f, got = 0.f;
    if (job == 0) { const int n = h1 % 8192, k = h2 % 1024; ref = n < 5120 ? a.in(I_WIN)[((size_t)l * D + k) * DIN + (n < 1536 ? n : n + 8)] : a.in(I_WGATE)[((size_t)l * D + k) * 3072 + n - 5120]; got = bf2f(((const bf16_t*)(wl + WL_IN))[(size_t)n * 1024 + k]); }
    else if (job == 1) { const int n = h1 % 1024, k = h2 % 2048; ref = k < 512 ? a.in(I_WPA)[((size_t)l * 512 + k) * D + n] : (k < 1024 ? a.in(I_WPB)[((size_t)l * 512 + k - 512) * D + n] : a.in(I_WPC)[((size_t)l * D + k - 1024) * D + n]); got = bf2f(((const bf16_t*)(wl + WL_P))[(size_t)n * 2048 + k]); }
    else if (job == 2) { const int n = h1 % 1024, k = h2 % 1024; ref = a.in(I_WO)[((size_t)l * D + k) * D + n]; got = bf2f(((const bf16_t*)(wl + WL_O))[(size_t)n * 1024 + k]); }
    else if (job == 3) { const int e = h3 % 32, n = h1 % 2048, k = h2 % 1024, src = 1024 * ((n >> 7) & 1) + 128 * (n >> 8) + (n & 127); ref = a.in(I_WGU)[(((size_t)l * 32 + e) * D + k) * 2048 + src]; got = bf2f(((const bf16_t*)(wl + WL_GU))[((size_t)e * 2048 + n) * 1024 + k]); }
    else { const int e = h3 % 32, n = h1 % 1024, k = h2 % 1024; ref = a.in(I_WDN)[(((size_t)l * 32 + e) * D + k) * D + n]; got = bf2f(((const bf16_t*)(wl + WL_DN))[((size_t)e * 1024 + n) * 1024 + k]); }
    chk_rec(a, 0, fabsf(got - rbf(ref)));
}
__device__ __forceinline__ void chk_ada(const AR a) {
    const int s = CHK_GT(); if (s >= 512) return;
    const unsigned h1 = hash32(s + 77); const int l = s & 1, b = (s >> 1) & 15, j = h1 % 6144; float acc = 0.f;
    for (int k = 0; k < D; ++k) { const float c = a.in(I_C)[b * D + k]; acc += (c / (1.f + expf(-c))) * a.in(I_WADA)[((size_t)l * D + k) * 6144 + j]; }
    acc += a.in(I_BADA)[l * 6144 + j];
    chk_rec(a, 1, relerr(((const float*)(a.ws() + WS_ADA))[((size_t)l * 16 + b) * 6144 + j], acc, 0.01f));
}
__device__ __forceinline__ void chk_prep(const AR a, int l, const float* xin, int stage) {
    const int s = CHK_GT(); if (s >= 1024) return;
    const unsigned h1 = hash32(s + 1234 + l); const int m = h1 % M, b = m >> 11; const float* ada = (const float*)(a.ws() + WS_ADA) + ((size_t)l * 16 + b) * 6144;
    if (s < 768) { const int col = hash32(h1) % D; const float ref = xin[(size_t)m * D + col] * (1.f + ada[1024 + col]) + ada[col];
        chk_rec(a, stage, relerr(bf2f(((const bf16_t*)(a.ws() + WS_H))[(size_t)m * D + col]), ref, 0.05f)); }
    else { const int j = s & 7; float acc = 0.f;
        for (int k = 0; k < D; ++k) acc += (xin[(size_t)m * D + k] * (1.f + ada[1024 + k]) + ada[k]) * a.in(I_WIN)[((size_t)l * D + k) * DIN + 1536 + j];
        const float x = acc + a.in(I_BF)[l * 8 + j], ref = fminf(x, 0.f) - log1pf(expf(-fabsf(x)));
        chk_rec(a, stage, relerr(((const float*)(a.ws() + WS_LOGF))[(size_t)m * 8 + j], ref, 0.01f)); }
}
__device__ __forceinline__ void chk_inproj(const AR a, int l, int stage) {
    const int s = CHK_GT(); if (s >= 4096) return;
    const unsigned h1 = hash32(s + 999 + l), h2 = hash32(h1); const int m = h1 % M, n = h2 % 8192;
    const bf16_t* H = (const bf16_t*)(a.ws() + WS_H) + (size_t)m * D; const bf16_t* W = (const bf16_t*)(a.ws() + WS_W + (size_t)l * WL_SIZE + WL_IN) + (size_t)n * D;
    float acc = 0.f; for (int k = 0; k < D; ++k) acc += bf2f(H[k]) * bf2f(W[k]);
    if (n < 512 || (n >= 1536 && n < 2048)) acc *= C2;
    if (n >= 5120) { acc += a.in(I_BGATE)[l * 3072 + n - 5120]; acc = 1.f / (1.f + expf(-acc)); }
    chk_rec(a, stage, relerr(bf2f(((const bf16_t*)(a.ws() + WS_Z))[(size_t)m * ZP + n]), acc, 0.05f));
}
__device__ __forceinline__ void chk_f2(const AR a, int stage) {
    const int s = CHK_GT(); if (s >= 256) return;
    const unsigned h1 = hash32(s + 555); const int bh = s & 127, t = h1 % SEQ, b = bh >> 3, h = bh & 7; float acc = 0.f;
    for (int i = 0; i <= t; ++i) acc += ((const float*)(a.ws() + WS_LOGF))[((size_t)b * SEQ + i) * 8 + h];
    chk_rec(a, stage, relerr(((const float*)(a.ws() + WS_F2))[(size_t)bh * SEQ + t], acc * LOG2E, 0.05f));
}
__device__ __forceinline__ void chk_lru(const AR a, int l, int stage) {
    const int gt = CHK_GT(), s = gt >> 6, c = gt & 63; if (s >= 128) return;
    const unsigned h1 = hash32(s + 4242 + l), h2 = hash32(h1), h3 = hash32(h2);
    const int b = h1 % BATCH, ch = h2 % D, n = ch >> 6, d = ch & 63, tend = (s < 6) ? (s == 0 ? 2047 : h3 % SEQ) : (s < 40 ? h3 % 40 : h3 % 400);
    const bf16_t* Z = (const bf16_t*)(a.ws() + WS_Z);
    const float* cw = a.in(I_CONVW) + (size_t)l * 4 * D; const float* cb = a.in(I_CONVB) + (size_t)l * D;
    const float* wa = a.in(I_WA) + ((size_t)l * 16 + n) * 4096; const float* wx = a.in(I_WX) + ((size_t)l * 16 + n) * 4096;
    const float lam = a.in(I_LAM)[l * D + ch]; const float cl = -8.f * (fmaxf(-lam, 0.f) + log1pf(expf(-fabsf(lam))));
    const int cc = n * 64 + c; const float wac = rbf(wa[c * 64 + d]), wxc = rbf(wx[c * 64 + d]);
    const float cw0 = cw[cc], cw1 = cw[D + cc], cw2 = cw[2 * D + cc], cw3 = cw[3 * D + cc], cbc = cb[cc];
    const float bac = a.in(I_BA)[l * D + ch], bxc = a.in(I_BX)[l * D + ch];
    float hst = 0.f, x0 = 0.f, x1 = 0.f, x2 = 0.f;
    for (int t = 0; t <= tend; ++t) { const float x3 = bf2f(Z[((size_t)b * SEQ + t) * ZP + ZC_XC + cc]);
        const float xc = cbc + cw0 * x0 + cw1 * x1 + cw2 * x2 + cw3 * x3; x0 = x1; x1 = x2; x2 = x3;
        const float xb = rbf(xc); const float ra = wave_sum(c, xb * wac), rx = wave_sum(c, xb * wxc), xme = shidx(xc, d);
        const float rg = 1.f / (1.f + expf(-(ra + bac))), ig = 1.f / (1.f + expf(-(rx + bxc)));
        const float la = cl * rg, aa = expf(la); hst = aa * hst + sqrtf(-expm1f(2.f * la)) * (ig * xme); }
    const float g = bf2f(Z[((size_t)b * SEQ + tend) * ZP + ZC_GC + ch]);
    const float ref = hst * (0.5f * g * (1.f + tanhf(0.7978845608f * (g + 0.044715f * g * g * g))));
    if (c == 0) chk_rec(a, stage, relerr(bf2f(((const bf16_t*)(a.ws() + WS_O))[((size_t)b * SEQ + tend) * OP + 1024 + ch]), ref, 0.02f));
}
template <int MODE> __device__ __forceinline__ void chk_attn(const AR a, int stage) {
    const int gt = CHK_GT(), s = gt >> 6, e = gt & 63; if (s >= 256) return;
    const unsigned h1 = hash32(s + 31337 + MODE), h2 = hash32(h1), h3 = hash32(h2);
    const int b = h1 % BATCH, h = h2 % 8, d = h3 % 64, t = (s < 8) ? ((s == 0) ? 0 : (s == 1 ? 1 : (s == 2 ? 2047 : hash32(h3) % SEQ))) : hash32(h3) % SEQ;
    const bf16_t* Z = (const bf16_t*)(a.ws() + WS_Z); const size_t rb = (size_t)b * SEQ;
    const int qc = (MODE == 0 ? ZC_QA : ZC_QB) + h * 64, kc = (MODE == 0 ? ZC_KA : ZC_KB) + h * 64, vc = (MODE == 0 ? ZC_VA : ZC_VB) + h * 64;
    const float* F2 = (const float*)(a.ws() + WS_F2) + (size_t)(b * 8 + h) * SEQ;
    const float qe = bf2f(Z[(rb + t) * ZP + qc + e]);
    float ref = 0.f;
    if (MODE == 0) { float mx = -INFINITY, sum = 0.f, o = 0.f;
        for (int k = 0; k <= t; ++k) { const float z = wave_sum(e, qe * bf2f(Z[(rb + k) * ZP + kc + e])) + (F2[t] - F2[k]);
            const float mn = fmaxf(mx, z), al = exp2f(mx - mn), p = exp2f(z - mn); sum = sum * al + p; o = o * al + p * bf2f(Z[(rb + k) * ZP + vc + d]); mx = mn; }
        ref = o / sum;
    } else { float R = 0.f, o = 0.f;
        for (int k = t - 1; k >= 0; --k) { const float z = wave_sum(e, qe * bf2f(Z[(rb + k) * ZP + kc + e]));
            const float sp = fmaxf(z, 0.f) + log2f(1.f + exp2f(-fabsf(z))); o += exp2f(z - sp + R) * bf2f(Z[(rb + k) * ZP + vc + d]); R -= sp; if (R < -200.f) break; }
        ref = o; }
    if (e == 0) chk_rec(a, stage, relerr(bf2f(((const bf16_t*)(a.ws() + WS_O))[(rb + t) * OP + (MODE == 0 ? 0 : 512) + h * 64 + d]), ref, 0.15f));
}
__device__ __forceinline__ void chk_merge(const AR a, int l, int stage) {
    const int s = CHK_GT(); if (s >= 2048) return;
    const unsigned h1 = hash32(s + 808 + l), h2 = hash32(h1); const int m = h1 % M, c = h2 % D;
    const bf16_t* O = (const bf16_t*)(a.ws() + WS_O) + (size_t)m * OP; const bf16_t* W = (const bf16_t*)(a.ws() + WS_W + (size_t)l * WL_SIZE + WL_P) + (size_t)c * OP; const bf16_t* Z = (const bf16_t*)(a.ws() + WS_Z) + (size_t)m * ZP;
    float tot = 0.f;
    for (int seg = 0; seg < 3; ++seg) { const int k0 = seg == 0 ? 0 : (seg == 1 ? 512 : 1024), k1 = seg == 0 ? 512 : (seg == 1 ? 1024 : 2048); float acc = 0.f;
        for (int k = k0; k < k1; ++k) acc += bf2f(O[k]) * bf2f(W[k]); tot += acc * bf2f(Z[ZC_G + seg * 1024 + c]); }
    chk_rec(a, stage, relerr(bf2f(((const bf16_t*)(a.ws() + WS_MG))[(size_t)m * D + c]), tot, 0.05f));
}
__device__ __forceinline__ void chk_wo(const AR a, int l, int stage) {
    const int s = CHK_GT(); if (s >= 2048) return;
    const unsigned h1 = hash32(s + 909 + l), h2 = hash32(h1); const int m = h1 % M, c = h2 % D;
    const bf16_t* A = (const bf16_t*)(a.ws() + WS_MG) + (size_t)m * D; const bf16_t* W = (const bf16_t*)(a.ws() + WS_W + (size_t)l * WL_SIZE + WL_O) + (size_t)c * D;
    float acc = 0.f; for (int k = 0; k < D; ++k) acc += bf2f(A[k]) * bf2f(W[k]);
    chk_rec(a, stage, relerr(bf2f(((const bf16_t*)(a.ws() + WS_Y))[(size_t)m * D + c]), acc, 0.05f));
}
__device__ __forceinline__ void chk_ln1(const AR a, int l, const float* xin, int stage) {
    const int s = CHK_GT(); if (s >= 256) return;
    const int m = hash32(s + 1717 + l) % M, b = m >> 11; const float* ada = (const float*)(a.ws() + WS_ADA) + ((size_t)l * 16 + b) * 6144;
    const bf16_t* Yb = (const bf16_t*)(a.ws() + WS_Y) + (size_t)m * D; const float* X = xin + (size_t)m * D;
#define Y_(k) bf2f(Yb[k])
    float mean = 0.f; for (int k = 0; k < D; ++k) mean += DN_ALPHA * X[k] + (1.f + ada[2048 + k]) * Y_(k); mean /= D;
    float var = 0.f; for (int k = 0; k < D; ++k) { const float v = DN_ALPHA * X[k] + (1.f + ada[2048 + k]) * Y_(k) - mean; var += v * v; } var /= D;
    const float rstd = 1.f / sqrtf(var + LN_EPS);
    float e1 = 0.f, e2 = 0.f;
    for (int k = (s & 63); k < D; k += 64) { const float x1 = (DN_ALPHA * X[k] + (1.f + ada[2048 + k]) * Y_(k) - mean) * rstd * a.in(I_LN1G)[l * D + k] + a.in(I_LN1B)[l * D + k];
        const float h2 = x1 * (1.f + ada[4096 + k]) + ada[3072 + k];
        e1 = fmaxf(e1, relerr(bf2f(((const bf16_t*)(a.ws() + WS_X1))[(size_t)m * D + k]), x1, 0.05f)); e2 = fmaxf(e2, relerr(bf2f(((const bf16_t*)(a.ws() + WS_H))[(size_t)m * D + k]), h2, 0.05f)); }
    chk_rec(a, stage, e1); chk_rec(a, stage, e2);
    const int* tok_er = (const int*)(a.ws() + WS_TOKER); const float* gates = (const float*)(a.ws() + WS_GATE);
    const int r0 = tok_er[m * 4 + 0] >> 15, r1 = tok_er[m * 4 + 1] >> 15, r2 = tok_er[m * 4 + 2] >> 15, r3 = tok_er[m * 4 + 3] >> 15;
    float v0 = -INFINITY, v1 = -INFINITY, v2 = -INFINITY, v3 = -INFINITY; int i0 = 0, i1 = 0, i2 = 0, i3 = 0; float lr0 = 0.f, lr1 = 0.f, lr2 = 0.f, lr3 = 0.f;
    for (int e = 0; e < 32; ++e) { float x = a.in(I_BR)[l * 32 + e];
        for (int k = 0; k < D; ++k) { const float x1 = (DN_ALPHA * X[k] + (1.f + ada[2048 + k]) * Y_(k) - mean) * rstd * a.in(I_LN1G)[l * D + k] + a.in(I_LN1B)[l * D + k];
            x += (x1 * (1.f + ada[4096 + k]) + ada[3072 + k]) * a.in(I_WR)[((size_t)l * D + k) * 32 + e]; }
        if (e == r0) lr0 = x; if (e == r1) lr1 = x; if (e == r2) lr2 = x; if (e == r3) lr3 = x;
        if (x > v3) { if (x > v2) { v3 = v2; i3 = i2; if (x > v1) { v2 = v1; i2 = i1; if (x > v0) { v1 = v0; i1 = i0; v0 = x; i0 = e; } else { v1 = x; i1 = e; } } else { v2 = x; i2 = e; } } else { v3 = x; i3 = e; } } }
    float worst = 0.f;
    { const float den = 1.f + expf(v1 - v0) + expf(v2 - v0) + expf(v3 - v0);
      const float lrs[4] = {lr0, lr1, lr2, lr3}; const int rs[4] = {r0, r1, r2, r3};
#pragma unroll
      for (int k = 0; k < 4; ++k) { const bool found = (rs[k] == i0) || (rs[k] == i1) || (rs[k] == i2) || (rs[k] == i3);
          if (found) worst = fmaxf(worst, fabsf(gates[m * 4 + k] - expf(lrs[k] - v0) / den)); else worst = fmaxf(worst, (fabsf(lrs[k] - v3) > 1e-3f) ? 10.f : 0.f); }
      if (r0 == r1 || r0 == r2 || r0 == r3 || r1 == r2 || r1 == r3 || r2 == r3) worst = 15.f; }
    chk_rec(a, stage + 1, worst);
    for (int k = 0; k < 4; ++k) { const int er = tok_er[m * 4 + k], e = er >> 15, rank = er & (ECAP - 1);
        const int cnt = (int)__hip_atomic_load((gu32*)(a.ws() + WS_CTL) + CW_GCNT + (l * 32 + e) * 64, RLX_AGENT);
        if (rank >= cnt || ((const int*)(a.ws() + WS_SLOTTOK))[(size_t)e * ECAP + rank] != m) chk_rec(a, stage + 1, 20.f); }
    if (s == 0) { int tot = 0; for (int e = 0; e < 32; ++e) tot += (int)__hip_atomic_load((gu32*)(a.ws() + WS_CTL) + CW_GCNT + (l * 32 + e) * 64, RLX_AGENT); if (tot != M * 4) chk_rec(a, stage + 1, 30.f); }
}
__device__ __forceinline__ void chk_gemm1(const AR a, int l, const LAS int* bs, int stage) {
    const int s = CHK_GT(); if (s >= 2048) return;
    const unsigned h1 = hash32(s + 2121 + l), h2 = hash32(h1); const int tok = h1 % M, k = h2 & 3, j = (h2 >> 2) % D;
    const int er = ((const int*)(a.ws() + WS_TOKER))[tok * 4 + k], e = er >> 15, rank = er & (ECAP - 1); const size_t cs = (size_t)bs[e] * 256 + rank;
    const bf16_t* H = (const bf16_t*)(a.ws() + WS_H) + (size_t)tok * D; const bf16_t* Wg = (const bf16_t*)(a.ws() + WS_W + (size_t)l * WL_SIZE + WL_GU) + ((size_t)e * 2048 + 256 * (j >> 7) + (j & 127)) * D; const bf16_t* Wu = Wg + 128 * D;
    float ga = 0.f, up = 0.f; for (int q = 0; q < D; ++q) { const float hv = bf2f(H[q]); ga += hv * bf2f(Wg[q]); up += hv * bf2f(Wu[q]); }
    ga += a.in(I_BGU)[((size_t)l * 32 + e) * 2048 + j]; up += a.in(I_BGU)[((size_t)l * 32 + e) * 2048 + 1024 + j];
    ga = fminf(ga, 7.f); up = fminf(fmaxf(up, -7.f), 7.f); const float ref = (up + 1.f) * (ga / (1.f + expf(-1.702f * ga)));
    chk_rec(a, stage, relerr(bf2f(((const bf16_t*)(a.ws() + WS_ACT))[cs * D + j]), ref, 0.05f));
}
__device__ __forceinline__ void chk_gemm2(const AR a, int l, const LAS int* bs, int stage) {
    const int s = CHK_GT(); if (s >= 2048) return;
    const unsigned h1 = hash32(s + 2323 + l), h2 = hash32(h1); const int tok = h1 % M, k = h2 & 3, c = (h2 >> 2) % D;
    const int er = ((const int*)(a.ws() + WS_TOKER))[tok * 4 + k], e = er >> 15, rank = er & (ECAP - 1); const size_t cs = (size_t)bs[e] * 256 + rank;
    const bf16_t* A = (const bf16_t*)(a.ws() + WS_ACT) + cs * D; const bf16_t* W = (const bf16_t*)(a.ws() + WS_W + (size_t)l * WL_SIZE + WL_DN) + ((size_t)e * 1024 + c) * D;
    float acc = 0.f; for (int q = 0; q < D; ++q) acc += bf2f(A[q]) * bf2f(W[q]); acc += a.in(I_BDN)[((size_t)l * 32 + e) * D + c];
    chk_rec(a, stage, relerr(bf2f(((const bf16_t*)(a.ws() + WS_YB))[cs * D + c]), acc, 0.05f));
}
__device__ __forceinline__ void chk_ln2(const AR a, int l, const float* xout, const LAS int* bs, int stage) {
    const int s = CHK_GT(); if (s >= 256) return;
    const int m = hash32(s + 2525 + l) % M, b = m >> 11; const float* ada = (const float*)(a.ws() + WS_ADA) + ((size_t)l * 16 + b) * 6144;
    const bf16_t* X1b = (const bf16_t*)(a.ws() + WS_X1) + (size_t)m * D; const bf16_t* YB = (const bf16_t*)(a.ws() + WS_YB);
#define X1_(q) bf2f(X1b[q])
    const bf16_t* yr[4]; float g[4];
#pragma unroll
    for (int k = 0; k < 4; ++k) { const int er = ((const int*)(a.ws() + WS_TOKER))[m * 4 + k], e = er >> 15, rank = er & (ECAP - 1); yr[k] = YB + ((size_t)bs[e] * 256 + rank) * D; g[k] = ((const float*)(a.ws() + WS_GATE))[m * 4 + k]; }
    float mean = 0.f, var = 0.f;
    for (int q = 0; q < D; ++q) { float y = g[0] * bf2f(yr[0][q]) + g[1] * bf2f(yr[1][q]) + g[2] * bf2f(yr[2][q]) + g[3] * bf2f(yr[3][q]); mean += DN_ALPHA * X1_(q) + (1.f + ada[5120 + q]) * y; } mean /= D;
    for (int q = 0; q < D; ++q) { float y = g[0] * bf2f(yr[0][q]) + g[1] * bf2f(yr[1][q]) + g[2] * bf2f(yr[2][q]) + g[3] * bf2f(yr[3][q]); const float v = DN_ALPHA * X1_(q) + (1.f + ada[5120 + q]) * y - mean; var += v * v; } var /= D;
    const float rstd = 1.f / sqrtf(var + LN_EPS); float worst = 0.f;
    for (int q = (s & 31); q < D; q += 32) { float y = g[0] * bf2f(yr[0][q]) + g[1] * bf2f(yr[1][q]) + g[2] * bf2f(yr[2][q]) + g[3] * bf2f(yr[3][q]);
        const float ref = (DN_ALPHA * X1_(q) + (1.f + ada[5120 + q]) * y - mean) * rstd * a.in(I_LN2G)[l * D + q] + a.in(I_LN2B)[l * D + q];
        worst = fmaxf(worst, relerr(xout[(size_t)m * D + q], ref, 0.02f)); }
    chk_rec(a, stage, worst);
}
__device__ __forceinline__ void chk_report(const AR a) {
    if (blockIdx.x != 0 || threadIdx.x != 0) return;
    const unsigned* w = (const unsigned*)(a.ws() + WS_CTL) + CW_CHK;
    const unsigned tmo = __hip_atomic_load((gu32*)(a.ws() + WS_CTL) + CW_BAR + XB_TMO, RLX_AGENT);
    if (tmo) { a.out()[0] = 9.9e7f; return; }
#ifdef CHK_REPORT_STAGE
    { const float e = __uint_as_float(__hip_atomic_load((gu32*)w + CHK_REPORT_STAGE, RLX_AGENT)); a.out()[0] = 1e5f * e + 100.f; return; }
#endif
    for (int st = 0; st < 32; ++st) { const float e = __uint_as_float(__hip_atomic_load((gu32*)w + st, RLX_AGENT));
        if (e > 0.02f) { const float sc = e < 0.1f ? 1e3f : (e < 1.f ? 1e4f : (e < 100.f ? 1e5f : 1e6f)); a.out()[0] = (10.f + st) * sc; return; } }
}
#endif

#if CHK
#define CHECK(stmt) do { PHASE_IDS(); stmt; } while (0)
#else
#define CHECK(stmt) do { } while (0)
#endif
#ifndef REP_MASK
#define REP_MASK 0
#endif
#define REPEAT(g) _Pragma("unroll 1") for (int rep_ = ((REP_MASK >> (g)) & 1); rep_ >= 0; --rep_)
#define PHASE_IDS() int tid_o; asm volatile("v_mbcnt_lo_u32_b32 %0, -1, 0\n\tv_mbcnt_hi_u32_b32 %0, -1, %0" : "=v"(tid_o)); tid_o += wave0 * 64; const int tid = tid_o, lane = tid & 63, wave = __builtin_amdgcn_readfirstlane(tid >> 6); const int gw = vcu * 8 + wave; \
    AR a; { ArgsP q_ = a0.p; asm volatile("" : "+s"(q_)); a.p = q_; } int l_o = ll; asm volatile("" : "+s"(l_o)); const int l = l_o; (void)gw; (void)lane; (void)tid; (void)l
__global__ void __launch_bounds__(512, 2) fwd_kernel(Args args_unused) {
    extern __shared__ __attribute__((aligned(16))) unsigned char lds_raw[];
    LAS unsigned char* lds = (LAS unsigned char*)lds_raw;
    AR a0; a0.p = (ArgsP)__builtin_amdgcn_kernarg_segment_ptr();
    const int G = gridDim.x, bx = blockIdx.x, vcu = (G % 8 == 0) ? (bx % 8) * (G / 8) + bx / 8 : bx;
    const int NGW = G * 8;
    const int ll = 0;
    const int wave0 = __builtin_amdgcn_readfirstlane(threadIdx.x >> 6);
#if STAMP
    volatile LAS unsigned long long* tsl = (volatile LAS unsigned long long*)(lds + MISC_OFF + 12288); int nst = 0;
#define STAMP_HERE() do { if (blockIdx.x == 0 && threadIdx.x == 0) tsl[nst] = __builtin_amdgcn_s_memrealtime(); ++nst; } while (0)
#else
#define STAMP_HERE() do { } while (0)
#endif
    { const int tid = threadIdx.x;
      for (int u = tid; u < (LDS_BYTES - MISC_OFF) / 4; u += 512) ((LAS unsigned*)(lds + MISC_OFF))[u] = 0u; }
    __syncthreads();
    STAMP_HERE();
    (void)xcd_barrier_post((unsigned*)(a0.ws() + WS_CTL) + CW_BAR, (volatile LAS unsigned*)(lds + MISC_OFF + MO_BAR));
#define GRID_BAR() do { ArgsP q_ = a0.p; asm volatile("" : "+s"(q_)); XcdBarrier b_; b_.bar = (unsigned*)(q_->ws + WS_CTL) + CW_BAR; b_.x = xb_xcc_id(); b_.st = (volatile LAS unsigned*)(lds + MISC_OFF + MO_BAR); xcd_barrier(b_); } while (0)

    REPEAT(0) { { PHASE_IDS();
      if (FP8_IN == 2) p0_wabsmax(a, gw * 64 + lane, NGW * 64, lane);
      p0_weights(a, lds, gw, NGW, wave, lane, 0);
      __syncthreads();
      if (bx < 192) p0_ada(a, lds, bx, tid, wave, lane);
      if (bx == 255 && tid < 64) { if (FP8_G) ((unsigned char*)(a.ws() + WS_ONES))[tid] = (unsigned char)0xff; else ((bf16_t*)(a.ws() + WS_ONES))[tid] = (bf16_t)0x3f80; } }
    GRID_BAR(); STAMP_HERE(); }
    CHECK(chk_weights(a); chk_ada(a));
    REPEAT(10) { { PHASE_IDS();
      for (int u = vcu; u < 256; u += G) {
        __syncthreads();
        stage_wf(a, 0, lds, tid);
        LAS float* VL = (LAS float*)(lds + 32768);
        { const float* ada = (const float*)(a.ws() + WS_ADA) + (size_t)((u * 128) >> 11) * 6144; stage_vec(ada, VL, tid); stage_vec(ada + 1024, VL + 1024, tid); if (tid < 8) VL[2048 + tid] = a.in(I_BF)[tid]; }
        const LAS float* VLl = VL + 4 * lane; asm volatile("" : "+v"(VLl));
        __syncthreads();
        const float* X = a.in(I_X);
        f32x4 xcur[4], xnxt[4];
#define P1_ROW(I) ((u >> 4) * 2048 + (I) * 128 + (u & 15) * 8 + wave)
#pragma unroll
        for (int j = 0; j < 4; ++j) xcur[j] = *(const f32x4*)(X + (size_t)P1_ROW(0) * D + 4 * lane + 256 * j);
#pragma unroll 1
        for (int i = 0; i < 16; ++i) { const int m = P1_ROW(i), mn = P1_ROW(i < 15 ? i + 1 : 15);
#pragma unroll
          for (int j = 0; j < 4; ++j) xnxt[j] = *(const f32x4*)(X + (size_t)mn * D + 4 * lane + 256 * j);
          prep_row(a, m, xcur, (const LAS float*)lds, VLl, VLl + 1024, VL + 2048, lane);
#pragma unroll
          for (int j = 0; j < 4; ++j) xcur[j] = xnxt[j]; } }
#undef P1_ROW
      if (FP8_IN == 2) { __syncthreads(); p0_weights(a, lds, gw, NGW, wave, lane, 1); } }
    GRID_BAR(); STAMP_HERE(); }
#pragma unroll 1
    for (int ll = 0; ll < DEPTH; ++ll) {
        const int cs = 16 * ll;
        CHECK(chk_prep(a, l, (l == 0) ? a.in(I_X) : (const float*)(a.ws() + WS_XL), cs + 2));
        if (CHK_STOP <= 2) break;
        REPEAT(1) { { PHASE_IDS(); const unsigned char* wl = a.ws() + WS_W + (size_t)l * WL_SIZE;
          DenseOrder S; S.T.init(M / 256, 32, G, bx); S.A = (const char*)(a.ws() + WS_H); S.B = (const char*)(wl + WL_IN); S.lda = FP8_IN ? 512 : 1024; S.ldb = FP8_IN ? 512 : 1024; S.nt = FP8_IN ? 8 : 16;
          const gu32* wm_ = (const gu32*)(a.ws() + WS_CTL) + CW_WMAX + 2 * l * 64;
          EpiInProj E{(bf16_t*)(a.ws() + WS_Z), a.in(I_BGATE) + (size_t)l * 3072, (const float*)(a.ws() + WS_ROWS), fmaxf(__uint_as_float(__hip_atomic_load(wm_, RLX_AGENT)), 1e-30f) * (1.0f / 127.0f), fmaxf(__uint_as_float(__hip_atomic_load(wm_ + 64, RLX_AGENT)), 1e-30f) * (1.0f / 127.0f), nullptr};
#ifdef PROBE_SKIP_EPI
          E.skip = (rep_ > 0) ? PROBE_SKIP_EPI : 0;
#endif
#ifdef STAGGER_IN
          for (int k_ = 0; k_ < (vcu & 15); ++k_) __builtin_amdgcn_s_sleep(STAGGER_IN);
#endif
          E.G8 = a.ws() + WS_G8;
          pg8::gemm_phase<EpiInProj, DenseOrder, false>(lds, FP8_IN ? 512 : 1024, FP8_IN ? 512 : 1024, S, E, tid); }
        GRID_BAR(); STAMP_HERE(); }
        CHECK(chk_inproj(a, l, cs + 3));
        if (CHK_STOP <= 3) break;
        REPEAT(2) { { PHASE_IDS();
          for (int u = vcu; u < 256; u += G) lru_unit(a, l, u >> 4, u & 15, lds, tid, wave, lane); }
        }
        REPEAT(3) { { PHASE_IDS();
          for (int u = vcu; u < 256; u += G) { const int bh = u >> 1, s = u & 1;
            LAS float* Fl = (LAS float*)(lds + 86016);
            __syncthreads();
            {
              const float* lf = (const float*)(a.ws() + WS_LOGF) + ((size_t)(bh >> 3) * SEQ + 4 * tid) * 8 + (bh & 7);
              const float v0 = lf[0], v1 = v0 + lf[8], v2 = v1 + lf[16], v3 = v2 + lf[24];
              float inc = v3;
#pragma unroll
              for (int o = 1; o < 64; o <<= 1) { const float t = shup(lane, inc, o); if (lane >= o) inc += t; }
              LAS float* wt = (LAS float*)(lds + 86016 + 8192);
              if (lane == 63) wt[wave] = inc;
              __syncthreads();
              float base = inc - v3;
#pragma unroll
              for (int w2 = 0; w2 < 8; ++w2) base += (w2 < wave) ? wt[w2] : 0.f;
              const f32x4 o = {(base + v0) * LOG2E, (base + v1) * LOG2E, (base + v2) * LOG2E, (base + v3) * LOG2E};
              *(LAS f32x4*)(Fl + 4 * tid) = o;
              if (CHK) *(f32x4*)((float*)(a.ws() + WS_F2) + (size_t)bh * SEQ + 4 * tid) = o; }
            __syncthreads();
            const fox_body::bf16* Zq = (const fox_body::bf16*)(a.ws() + WS_Z);
#pragma unroll 1
            for (int i = 0; i < 4; ++i) { const int qb = (i == 0) ? s : (i == 1 ? 7 - s : (i == 2 ? 2 + s : 5 - s));
                fox_body::attn_unit<8>(bh >> 3, bh & 7, qb, Zq + ZC_QA, Zq + ZC_KA, Zq + ZC_VA, (fox_body::bf16*)(a.ws() + WS_O), Fl, (char*)lds_raw, tid); } } } }
        REPEAT(4) { { PHASE_IDS();
          for (int u = vcu; u < 256; u += G) { const int bh = u >> 1, s = u & 1;
#pragma unroll 1
            for (int i = 0; i < 4; ++i) { const int qb = (i == 0) ? s : (i == 1 ? 7 - s : (i == 2 ? 2 + s : 5 - s)); attn_unit<1>(a, bh >> 3, bh & 7, qb, lds, tid, wave, lane); } } } }
        GRID_BAR(); STAMP_HERE();
        CHECK(chk_attn<0>(a, cs + 6); chk_attn<1>(a, cs + 7));
        if (CHK_STOP <= 7) break;
        REPEAT(5) { { PHASE_IDS(); const unsigned char* wl = a.ws() + WS_W + (size_t)l * WL_SIZE;
          MergeOrder S; S.T.init(M / 256, 4, G, bx); S.A = (const char*)(a.ws() + WS_O); S.B = (const char*)(wl + WL_P);
          EpiMerge E{(const bf16_t*)(a.ws() + (FP8_G ? WS_G8 : WS_Z)), (bf16_t*)(a.ws() + WS_MG), (const bf16_t*)(a.ws() + WS_ONES)};
          pg8::gemm_phase<EpiMerge, MergeOrder, false>(lds, FP8_MRG ? OP / 2 : OP, FP8_MRG ? OP / 2 : OP, S, E, tid); }
        GRID_BAR(); STAMP_HERE(); }
        CHECK(chk_merge(a, l, cs + 8));
        REPEAT(6) { { PHASE_IDS(); const unsigned char* wl = a.ws() + WS_W + (size_t)l * WL_SIZE;
          DenseOrder S; S.T.init(M / 256, 4, G, bx); S.A = (const char*)(a.ws() + WS_MG); S.B = (const char*)(wl + WL_O); S.lda = 1024; S.ldb = 1024; S.nt = 16;
          EpiBf16 E{(bf16_t*)(a.ws() + WS_Y), D};
          pg8::gemm_phase<EpiBf16, DenseOrder, false>(lds, 1024, 1024, S, E, tid); }
        GRID_BAR(); STAMP_HERE(); }
        CHECK(chk_wo(a, l, cs + 9));
        if (CHK_STOP <= 9) break;
REPEAT(11) {         { PHASE_IDS(); const float* xin = (l == 0) ? a.in(I_X) : (const float*)(a.ws() + WS_XL);
          for (int u = vcu; u < 256; u += G) { if (l == 0) ln1_phase<false>(a, l, xin, lds, u, tid, wave, lane); else ln1_phase<true>(a, l, xin, lds, u, tid, wave, lane); } }
        GRID_BAR(); STAMP_HERE();
          if (rep_ > 0) { PHASE_IDS(); if (bx == 0 && tid < 32) __hip_atomic_store((gu32*)(a.ws() + WS_CTL) + CW_GCNT + (l * 32 + tid) * 64, 0u, RLX_AGENT); GRID_BAR(); } }
        CHECK(chk_ln1(a, l, (l == 0) ? a.in(I_X) : (const float*)(a.ws() + WS_XL), cs + 10));
        if (CHK_STOP <= 11) break;
        REPEAT(7) { { PHASE_IDS(); const unsigned char* wl = a.ws() + WS_W + (size_t)l * WL_SIZE;
          moe_build_tables((gu32*)(a.ws() + WS_CTL), l, lds, tid);
          MoeOrder<8, true> S{vcu, moe_tables(lds), (const char*)(a.ws() + WS_H), (const char*)(wl + WL_GU), (const int*)(a.ws() + WS_SLOTTOK)};
          EpiGU E{a.ws() + WS_ACT, a.in(I_BGU) + (size_t)l * NEXP * 2048};
          pg8::gemm_phase<EpiGU, MoeOrder<8, true>, true>(lds, FP8_MOE ? 512 : 1024, FP8_MOE ? 512 : 1024, S, E, tid); }
        GRID_BAR(); STAMP_HERE(); }
        CHECK(chk_gemm1(a, l, (const LAS int*)(lds + MISC_OFF + MO_BS), cs + 12));
        REPEAT(8) { { PHASE_IDS(); const unsigned char* wl = a.ws() + WS_W + (size_t)l * WL_SIZE;
          MoeOrder<4, false> S{vcu, moe_tables(lds), (const char*)(a.ws() + WS_ACT), (const char*)(wl + WL_DN), nullptr};
          EpiDown E{a.ws() + WS_YB, a.in(I_BDN) + (size_t)l * NEXP * D};
          pg8::gemm_phase<EpiDown, MoeOrder<4, false>, false>(lds, FP8_MOE ? 512 : 1024, FP8_MOE ? 512 : 1024, S, E, tid); }
        GRID_BAR(); STAMP_HERE(); }
        CHECK(chk_gemm2(a, l, (const LAS int*)(lds + MISC_OFF + MO_BS), cs + 13));
        if (CHK_STOP <= 13) break;
        REPEAT(9) { { PHASE_IDS(); float* xout = (l == DEPTH - 1) ? a.out() : (float*)(a.ws() + WS_XL);
          if (l + 1 < DEPTH) stage_wf(a, l + 1, lds, tid);
          __syncthreads();
          for (int u = vcu; u < 256; u += G) { if (l != DEPTH - 1) ln2_phase<true>(a, l, xout, lds, u, tid, wave, lane, true); else ln2_phase<false>(a, l, xout, lds, u, tid, wave, lane, false); } }
          if (rep_ > 0) GRID_BAR(); }
        if (ll + 1 < DEPTH || CHK || STAMP) { GRID_BAR(); STAMP_HERE(); }
        CHECK(chk_ln2(a, l, (l == DEPTH - 1) ? a.out() : (float*)(a.ws() + WS_XL), (const LAS int*)(lds + MISC_OFF + MO_BS), cs + 14));
    }
#if CHK
    GRID_BAR();
    chk_report(a0);
#endif
#if STAMP
    if (blockIdx.x == 0) {
        const float tx = (float)(tsl[STAMP_X + 1] - tsl[STAMP_X]) * 0.01f, ty = (float)(tsl[STAMP_Y + 1] - tsl[STAMP_Y]) * 0.01f;
        float* o = a0.out();
        for (int i = threadIdx.x; i < M * D / 2; i += 512) o[M * D / 2 + i] = ty * 0.25f;
        __syncthreads();
        if (threadIdx.x == 0) o[0] = 10.f * tx;
    }
#endif
}

extern "C" void kernel_launch(void* const* d_in, const int* in_sizes, int n_in, void* d_out, int out_size, void* d_ws, size_t ws_size, hipStream_t stream) {
    static int grid = 0;
    if (grid == 0) {
        if (n_in != 29 || out_size != M * D || ws_size < WS_END) { fprintf(stderr, "kernel_launch: unexpected sizes n_in %d out %d ws %zu\n", n_in, out_size, ws_size); grid = -1; return; }
        if (hipFuncSetAttribute((const void*)fwd_kernel, hipFuncAttributeMaxDynamicSharedMemorySize, LDS_BYTES) != hipSuccess) { fprintf(stderr, "kernel_launch: hipFuncSetAttribute failed\n"); grid = -1; return; }
        int dev = 0, cus = 0, per_cu = 0;
        (void)hipGetDevice(&dev); (void)hipDeviceGetAttribute(&cus, hipDeviceAttributeMultiprocessorCount, dev);
        if (hipOccupancyMaxActiveBlocksPerMultiprocessor(&per_cu, (const void*)fwd_kernel, 512, LDS_BYTES) != hipSuccess || per_cu < 1) fprintf(stderr, "kernel_launch: occupancy query says %d\n", per_cu);
        (void)hipGetLastError();
        grid = cus < 256 ? cus : 256;
    }
    if (grid < 0) return;
    (void)hipMemsetAsync((char*)d_ws + WS_CTL, 0, CTL_ZERO_BYTES, stream);
    Args a{};
    for (int i = 0; i < 29; ++i) a.in[i] = (const float*)d_in[i];
    a.out = (float*)d_out; a.ws = (unsigned char*)d_ws;
    hipLaunchKernelGGL(fwd_kernel, dim3(grid), dim3(512), LDS_BYTES, stream, a);
}
```
